# Optimizing an MI355X kernel written in HIP

```python
import jax
import jax.numpy as jnp
from jax import lax
import numpy as np

D_MODEL = 1024
BATCH = 16
SEQ = 4096
DEPTH = 2

GRID_W = 64
CTX_LEN = 256
BRANCH_W = 512
N_BRANCH = 3
GLA_H = 4
GLA_DK = 64
GLA_DV = 128
GLA_LR = 16
GLA_TAU = 16.0
GLA_CHUNK = 64
ATT_H = 4
ATT_KV = 2
ATT_G = ATT_H // ATT_KV
ATT_HD = 128
Q_BLOCK = 128
ROPE_THETA = 10000.0
RWKV_H = 8
RWKV_HD = 64
RWKV_W_LR = 64
RWKV_A_LR = 64
RWKV_DECAY_SCALE = 0.6065306597
NORM_EPS = 1e-6
GN_EPS = 64e-5
L2_EPS = 1e-12
F32 = jnp.float32

GLA_COLS = (GLA_H * GLA_DK, GLA_H * GLA_DK, GLA_H * GLA_DV, BRANCH_W, GLA_LR, GLA_LR)
ATT_COLS = (ATT_H * ATT_HD, ATT_KV * ATT_HD, ATT_KV * ATT_HD, BRANCH_W)
RWKV_COLS = (BRANCH_W, BRANCH_W, BRANCH_W, BRANCH_W, RWKV_W_LR, RWKV_W_LR, RWKV_A_LR, RWKV_A_LR)
MERGE_COLS = (D_MODEL, D_MODEL, D_MODEL)
GROUP_COLS = (sum(GLA_COLS), sum(ATT_COLS), sum(RWKV_COLS), sum(MERGE_COLS))
D_IN = sum(GROUP_COLS)

kernel_name = 'hybrid_gla_gqa_rwkv7_prefix_dit'


def _offsets(sizes):
    out, acc = [], 0
    for s in sizes:
        out.append((acc, acc + s))
        acc += s
    return out


def _split(p, sizes):
    return [p[..., a:b] for a, b in _offsets(sizes)]


def _project(h, w, sizes):
    return [h @ w[:, a:b] for a, b in _offsets(sizes)]


def rms_norm(x, g):
    xf = x.astype(F32)
    y = xf * lax.rsqrt(jnp.mean(xf * xf, -1, keepdims=True) + NORM_EPS)
    return (y * g.astype(F32)).astype(x.dtype)


def head_layer_norm(y, g, b):
    mu = jnp.mean(y, -1, keepdims=True)
    d = y - mu
    var = jnp.mean(d * d, -1, keepdims=True)
    return d * lax.rsqrt(var + GN_EPS) * g + b


def modulation(cond, w_mod, b_mod):
    m = jax.nn.silu(cond) @ w_mod + b_mod
    return jnp.split(m, 3, axis=-1)


def centred_shift(p, mu):
    pad = jnp.pad(p, ((0, 0), (1, 1), (0, 0)))
    nb = 0.5 * (pad[:, :-2] + pad[:, 2:])
    return p + mu * (nb - p)


def axial_rope(t, row_pos, col_pos):
    half = ATT_HD // 2
    quarter = half // 2
    inv = ROPE_THETA ** (-jnp.arange(quarter, dtype=F32) / quarter)
    tf = t.astype(F32)

    def rot(u, pos):
        ang = pos[:, None] * inv[None, :]
        cos = jnp.cos(ang)[None, :, None, :]
        sin = jnp.sin(ang)[None, :, None, :]
        u1, u2 = u[..., :quarter], u[..., quarter:]
        return jnp.concatenate([u1 * cos - u2 * sin, u2 * cos + u1 * sin], -1)

    return jnp.concatenate([rot(tf[..., :half], row_pos), rot(tf[..., half:], col_pos)], -1).astype(t.dtype)


def gla_chunked(q, k, v, g, s0):
    b, h, t, dk = q.shape
    dv = v.shape[-1]
    n = t // GLA_CHUNK
    q = q.reshape(b, h, n, GLA_CHUNK, dk)
    k = k.reshape(b, h, n, GLA_CHUNK, dk)
    v = v.reshape(b, h, n, GLA_CHUNK, dv)
    g_cum = jnp.cumsum(g.reshape(b, h, n, GLA_CHUNK, dk), axis=3)
    g_last = g_cum[:, :, :, -1:, :]
    q_dec = q * jnp.exp(g_cum)
    k_inv = k * jnp.exp(-g_cum)
    k_tail = k * jnp.exp(g_last - g_cum)
    lower = jnp.tril(jnp.ones((GLA_CHUNK, GLA_CHUNK), bool))
    a = jnp.where(lower, jnp.einsum('bhncd,bhnsd->bhncs', q_dec, k_inv), 0.0)
    o = jnp.einsum('bhncs,bhnse->bhnce', a, v)
    u = jnp.einsum('bhncd,bhnce->bhnde', k_tail, v)
    decay = jnp.exp(g_last[:, :, :, 0, :])

    def step(s, inp):
        d_n, u_n = inp
        return d_n[..., None] * s + u_n, s

    s_fin, s_in = lax.scan(step, s0, (jnp.moveaxis(decay, 2, 0), jnp.moveaxis(u, 2, 0)))
    o = o + jnp.einsum('bhncd,nbhde->bhnce', q_dec, s_in)
    return o.reshape(b, h, t, dv), s_fin


def gla_prep(p, wup_f, b_f, wup_b, b_b):
    q, k, v, gate, wd_f, wd_b = _split(p.astype(F32), GLA_COLS)
    b, t, _ = q.shape

    def heads(z, d):
        return z.reshape(b, t, GLA_H, d).transpose(0, 2, 1, 3)

    g_f = jax.nn.log_sigmoid(wd_f @ wup_f + b_f) / GLA_TAU
    g_b = jax.nn.log_sigmoid(wd_b @ wup_b + b_b) / GLA_TAU
    return (heads(q * GLA_DK ** -0.5, GLA_DK), heads(k, GLA_DK), heads(v, GLA_DV),
            heads(g_f, GLA_DK), heads(g_b, GLA_DK), gate)


def gla_out(o, gate, g_norm, dtype):
    o = o.transpose(0, 2, 1, 3)
    b, t = o.shape[:2]
    o = rms_norm(o, g_norm).reshape(b, t, GLA_H * GLA_DV)
    return (o * jax.nn.silu(gate)).astype(dtype)


def gla_branch(p_lat, p_ctx, wup_f, b_f, wup_b, b_b, g_norm, need_ctx):
    ql, kl, vl, gfl, gbl, gate_l = gla_prep(p_lat, wup_f, b_f, wup_b, b_b)
    qc, kc, vc, gfc, gbc, gate_c = gla_prep(p_ctx, wup_f, b_f, wup_b, b_b)
    s0 = jnp.zeros((ql.shape[0], GLA_H, GLA_DK, GLA_DV), F32)

    def fl(z):
        return z[:, :, ::-1]

    oc_f, sc_f = gla_chunked(qc, kc, vc, gfc, s0)
    oc_b, sc_b = gla_chunked(fl(qc), fl(kc), fl(vc), fl(gbc), s0)
    ol_f, _ = gla_chunked(ql, kl, vl, gfl, sc_f)
    ol_b, _ = gla_chunked(fl(ql), fl(kl), fl(vl), fl(gbl), sc_b)
    y_lat = gla_out(ol_f + fl(ol_b), gate_l, g_norm, p_lat.dtype)
    y_ctx = gla_out(oc_f + fl(oc_b), gate_c, g_norm, p_ctx.dtype) if need_ctx else None
    return y_lat, y_ctx


def attn_prep(p, qn_g, kn_g):
    q, k, v, gate = _split(p, ATT_COLS)
    b, t, _ = q.shape
    q = rms_norm(q.reshape(b, t, ATT_H, ATT_HD), qn_g)
    k = rms_norm(k.reshape(b, t, ATT_KV, ATT_HD), kn_g)
    return q, k, v.reshape(b, t, ATT_KV, ATT_HD), gate


def attend(qg, k, v):
    s = jnp.einsum('bqkgd,bskd->bkgqs', qg, k) * (ATT_HD ** -0.5)
    pr = jax.nn.softmax(s.astype(F32), axis=-1).astype(v.dtype)
    return jnp.einsum('bkgqs,bskd->bqkgd', pr, v)


def attn_branch(p_lat, p_ctx, qn_g, kn_g, row_pos, col_pos, need_ctx):
    ql, kl, vl, gate_l = attn_prep(p_lat, qn_g, kn_g)
    qc, kc, vc, gate_c = attn_prep(p_ctx, qn_g, kn_g)
    ql = axial_rope(ql, row_pos, col_pos)
    kl = axial_rope(kl, row_pos, col_pos)
    b, t = ql.shape[:2]
    k_all = jnp.concatenate([kl, kc], axis=1)
    v_all = jnp.concatenate([vl, vc], axis=1)
    qg = ql.reshape(b, t // Q_BLOCK, Q_BLOCK, ATT_KV, ATT_G, ATT_HD).swapaxes(0, 1)
    o = lax.map(lambda qb: attend(qb, k_all, v_all), qg)
    o = o.swapaxes(0, 1).reshape(b, t, ATT_H * ATT_HD)
    y_lat = o * jax.nn.silu(gate_l)
    y_ctx = None
    if need_ctx:
        lc = qc.shape[1]
        oc = attend(qc.reshape(b, lc, ATT_KV, ATT_G, ATT_HD), kc, vc).reshape(b, lc, ATT_H * ATT_HD)
        y_ctx = oc * jax.nn.silu(gate_c)
    return y_lat, y_ctx


def rwkv_scan(r, w, k, v, kk, a, s0, reverse):
    xs = tuple(jnp.moveaxis(z, 1, 0) for z in (r, w, k, v, kk, a))

    def step(s, inp):
        r_t, w_t, k_t, v_t, kk_t, a_t = inp
        sa = jnp.einsum('bhvk,bhk->bhv', s, kk_t)
        s = (s * w_t[:, :, None, :] - sa[..., None] * (kk_t * a_t)[:, :, None, :]
             + v_t[..., None] * k_t[:, :, None, :])
        return s, jnp.einsum('bhvk,bhk->bhv', s, r_t)

    s_fin, y = lax.scan(step, s0, xs, reverse=reverse)
    return jnp.moveaxis(y, 0, 1), s_fin


def rwkv_prep(p, mu, w0_f, wup_f, w0_b, wup_b, a0_f, aup_f, a0_b, aup_b, k_k, k_a):
    p = centred_shift(p, mu).astype(F32)
    r, k, v, gate, wd_f, wd_b, ad_f, ad_b = _split(p, RWKV_COLS)
    b, t, _ = r.shape

    def heads(z):
        return z.reshape(b, t, RWKV_H, RWKV_HD)

    def direction(w0, wup, a0, aup, wd, ad):
        w = jnp.exp(-RWKV_DECAY_SCALE * jax.nn.sigmoid(w0 + jnp.tanh(wd) @ wup))
        a = jax.nn.sigmoid(a0 + ad @ aup)
        kd = k * (1.0 + (a - 1.0) * k_a)
        return heads(w), heads(kd), heads(a)

    kk = heads(k * k_k)
    kk = kk * lax.rsqrt(jnp.sum(kk * kk, -1, keepdims=True) + L2_EPS)
    return (heads(r), heads(v), kk, direction(w0_f, wup_f, a0_f, aup_f, wd_f, ad_f),
            direction(w0_b, wup_b, a0_b, aup_b, wd_b, ad_b), gate)


def rwkv_branch(p_lat, p_ctx, mu, w0_f, wup_f, w0_b, wup_b, a0_f, aup_f, a0_b, aup_b,
                k_k, k_a, r_k, ln_g, ln_b, need_ctx):
    prm = (mu, w0_f, wup_f, w0_b, wup_b, a0_f, aup_f, a0_b, aup_b, k_k, k_a)
    rl, vl, kkl, (wfl, kfl, afl), (wbl, kbl, abl), gate_l = rwkv_prep(p_lat, *prm)
    rc, vc, kkc, (wfc, kfc, afc), (wbc, kbc, abc), gate_c = rwkv_prep(p_ctx, *prm)
    s0 = jnp.zeros((rl.shape[0], RWKV_H, RWKV_HD, RWKV_HD), F32)
    yc_f, sc_f = rwkv_scan(rc, wfc, kfc, vc, kkc, afc, s0, False)
    yc_b, sc_b = rwkv_scan(rc, wbc, kbc, vc, kkc, abc, s0, True)
    yl_f, _ = rwkv_scan(rl, wfl, kfl, vl, kkl, afl, sc_f, False)
    yl_b, _ = rwkv_scan(rl, wbl, kbl, vl, kkl, abl, sc_b, True)

    def out(y, r, kf, kb, v, gate, dtype):
        y = head_layer_norm(y, ln_g, ln_b) + jnp.sum(r * (kf + kb) * r_k, -1, keepdims=True) * v
        b, t = y.shape[:2]
        return (y.reshape(b, t, BRANCH_W) * jax.nn.silu(gate)).astype(dtype)

    y_lat = out(yl_f + yl_b, rl, kfl, kbl, vl, gate_l, p_lat.dtype)
    y_ctx = out(yc_f + yc_b, rc, kfc, kbc, vc, gate_c, p_ctx.dtype) if need_ctx else None
    return y_lat, y_ctx


def layer(x, xc, c, c_ctx, row_pos, col_pos, need_ctx, w_mod, b_mod, g_pre, w_in,
          gla_wup_f, gla_b_f, gla_wup_b, gla_b_b, gla_norm, att_qnorm, att_knorm,
          rwkv_mu, rwkv_w0_f, rwkv_wup_f, rwkv_w0_b, rwkv_wup_b, rwkv_a0_f, rwkv_aup_f,
          rwkv_a0_b, rwkv_aup_b, rwkv_kk, rwkv_ka, rwkv_rk, rwkv_ln_g, rwkv_ln_b,
          w_o_gla, w_o_att, w_o_rwkv, w_out, g_post):
    shift, scale, gate = modulation(c, w_mod, b_mod)
    shift_c, scale_c, gate_c = modulation(c_ctx, w_mod, b_mod)
    h = rms_norm(x, g_pre) * (1.0 + scale[:, None]) + shift[:, None]
    hc = rms_norm(xc, g_pre) * (1.0 + scale_c) + shift_c
    gla_l, att_l, rwkv_l, mg_l = _project(h, w_in, GROUP_COLS)
    ctx_parts = _project(hc, w_in, GROUP_COLS if need_ctx else GROUP_COLS[:3])
    gla_c, att_c, rwkv_c = ctx_parts[0], ctx_parts[1], ctx_parts[2]

    y1, y1c = gla_branch(gla_l, gla_c, gla_wup_f, gla_b_f, gla_wup_b, gla_b_b, gla_norm, need_ctx)
    y2, y2c = attn_branch(att_l, att_c, att_qnorm, att_knorm, row_pos, col_pos, need_ctx)
    y3, y3c = rwkv_branch(rwkv_l, rwkv_c, rwkv_mu, rwkv_w0_f, rwkv_wup_f, rwkv_w0_b, rwkv_wup_b,
                          rwkv_a0_f, rwkv_aup_f, rwkv_a0_b, rwkv_aup_b, rwkv_kk, rwkv_ka,
                          rwkv_rk, rwkv_ln_g, rwkv_ln_b, need_ctx)

    def merge(ya, yb, yc, mg):
        g1, g2, g3 = _split(mg, MERGE_COLS)
        m = (jax.nn.sigmoid(g1) * (ya @ w_o_gla) + jax.nn.sigmoid(g2) * (yb @ w_o_att)
             + jax.nn.sigmoid(g3) * (yc @ w_o_rwkv))
        return rms_norm(m @ w_out, g_post)

    x = x + gate[:, None] * merge(y1, y2, y3, mg_l)
    xc_new = xc + gate_c * merge(y1c, y2c, y3c, ctx_parts[3]) if need_ctx else None
    return x, xc_new


def setup_inputs(seed: int = 0) -> dict:
    key = jax.random.key(seed)
    ks = iter(jax.random.split(key, 48))
    L, D = DEPTH, D_MODEL

    def nrm(shape, s):
        return s * jax.random.normal(next(ks), shape, F32)

    return {
        'x': nrm((BATCH, SEQ, D), 1.0),
        'c': nrm((BATCH, D), 1.0),
        'ctx': nrm((BATCH, CTX_LEN, D), 1.0),
        'c_ctx': nrm((D,), 1.0),
        'w_mod': nrm((L, D, 3 * D), 0.5 * D ** -0.5),
        'b_mod': nrm((L, 3 * D), 0.02),
        'g_pre': 1.0 + nrm((L, D), 0.05),
        'w_in': nrm((L, D, D_IN), D ** -0.5),
        'gla_wup_f': nrm((L, GLA_LR, GLA_H * GLA_DK), GLA_LR ** -0.5),
        'gla_b_f': nrm((L, GLA_H * GLA_DK), 0.1),
        'gla_wup_b': nrm((L, GLA_LR, GLA_H * GLA_DK), GLA_LR ** -0.5),
        'gla_b_b': nrm((L, GLA_H * GLA_DK), 0.1),
        'gla_norm': 1.0 + nrm((L, GLA_H, GLA_DV), 0.05),
        'att_qnorm': 1.0 + nrm((L, ATT_HD), 0.05),
        'att_knorm': 1.0 + nrm((L, ATT_HD), 0.05),
        'rwkv_mu': jax.random.uniform(next(ks), (L, GROUP_COLS[2]), F32),
        'rwkv_w0_f': nrm((L, BRANCH_W), 0.5),
        'rwkv_wup_f': nrm((L, RWKV_W_LR, BRANCH_W), 0.5 * RWKV_W_LR ** -0.5),
        'rwkv_w0_b': nrm((L, BRANCH_W), 0.5),
        'rwkv_wup_b': nrm((L, RWKV_W_LR, BRANCH_W), 0.5 * RWKV_W_LR ** -0.5),
        'rwkv_a0_f': nrm((L, BRANCH_W), 0.1),
        'rwkv_aup_f': nrm((L, RWKV_A_LR, BRANCH_W), 0.5 * RWKV_A_LR ** -0.5),
        'rwkv_a0_b': nrm((L, BRANCH_W), 0.1),
        'rwkv_aup_b': nrm((L, RWKV_A_LR, BRANCH_W), 0.5 * RWKV_A_LR ** -0.5),
        'rwkv_kk': 0.85 + nrm((L, BRANCH_W), 0.05),
        'rwkv_ka': 1.0 + nrm((L, BRANCH_W), 0.05),
        'rwkv_rk': nrm((L, RWKV_H, RWKV_HD), 0.1),
        'rwkv_ln_g': 1.0 + nrm((L, RWKV_H, RWKV_HD), 0.05),
        'rwkv_ln_b': nrm((L, RWKV_H, RWKV_HD), 0.02),
        'w_o_gla': nrm((L, BRANCH_W, D), BRANCH_W ** -0.5),
        'w_o_att': nrm((L, BRANCH_W, D), BRANCH_W ** -0.5),
        'w_o_rwkv': nrm((L, BRANCH_W, D), BRANCH_W ** -0.5),
        'w_out': nrm((L, D, D), D ** -0.5),
        'g_post': 1.0 + nrm((L, D), 0.05),
    }


def reference(x, c, ctx, c_ctx, w_mod, b_mod, g_pre, w_in, gla_wup_f, gla_b_f, gla_wup_b,
              gla_b_b, gla_norm, att_qnorm, att_knorm, rwkv_mu, rwkv_w0_f, rwkv_wup_f,
              rwkv_w0_b, rwkv_wup_b, rwkv_a0_f, rwkv_aup_f, rwkv_a0_b, rwkv_aup_b, rwkv_kk,
              rwkv_ka, rwkv_rk, rwkv_ln_g, rwkv_ln_b, w_o_gla, w_o_att, w_o_rwkv, w_out, g_post):
    n_lat = x.shape[1]
    ROWS = n_lat // GRID_W
    row_pos = jnp.repeat(jnp.arange(ROWS, dtype=F32), GRID_W)
    col_pos = jnp.tile(jnp.arange(GRID_W, dtype=F32), ROWS)
    xc = ctx
    for l in range(DEPTH):
        x, xc = layer(x, xc, c, c_ctx, row_pos, col_pos, l < DEPTH - 1,
                      w_mod[l], b_mod[l], g_pre[l], w_in[l],
                      gla_wup_f[l], gla_b_f[l], gla_wup_b[l], gla_b_b[l], gla_norm[l],
                      att_qnorm[l], att_knorm[l],
                      rwkv_mu[l], rwkv_w0_f[l], rwkv_wup_f[l], rwkv_w0_b[l], rwkv_wup_b[l],
                      rwkv_a0_f[l], rwkv_aup_f[l], rwkv_a0_b[l], rwkv_aup_b[l], rwkv_kk[l],
                      rwkv_ka[l], rwkv_rk[l], rwkv_ln_g[l], rwkv_ln_b[l],
                      w_o_gla[l], w_o_att[l], w_o_rwkv[l], w_out[l], g_post[l])
    return x
```

```cpp
#include <hip/hip_runtime.h>
#include <hip/hip_bf16.h>
#include <stdint.h>
#include <cstdio>

typedef unsigned short u16;
using bf16 = __hip_bfloat16;
using bf16x8 = __attribute__((ext_vector_type(8))) short;
using s16x4  = __attribute__((ext_vector_type(4))) short;
using f32x16 = __attribute__((ext_vector_type(16))) float;
using f32x8  = __attribute__((ext_vector_type(8))) float;
using u32x4  = __attribute__((ext_vector_type(4))) unsigned;

constexpr int NB = 16, T = 4096, TC = 256, SB = T + TC;
constexpr int DM = 1024, DIN = 8480, DINP = 8576;
constexpr int GB = 2;
constexpr int RG = GB * SB;
constexpr int NGRP = NB / GB;
constexpr int LDP = DIN;
constexpr int LDY = 1536;
constexpr int C_GQ = 0, C_GK = 256, C_GV = 512, C_GG = 1024, C_GWF = 1536, C_GWB = 1552;
constexpr int C_AQ = 1568, C_AK = 2080, C_AV = 2336, C_AG = 2592;
constexpr int C_RW = 3104;
constexpr int C_MG = 5408;

__device__ __forceinline__ float bf2f(u16 v) { return __uint_as_float(((unsigned)v) << 16); }
__device__ __forceinline__ u16 f2bf(float x) { unsigned u = __float_as_uint(x); u += 0x7fffu + ((u >> 16) & 1u); return (u16)(u >> 16); }
__device__ __forceinline__ float wave_sum(float v) {
#pragma unroll
  for (int m = 32; m >= 1; m >>= 1) v += __shfl_xor(v, m);
  return v;
}
__device__ __forceinline__ float sigmoidf_(float x) { return 1.f / (1.f + __expf(-x)); }
__device__ __forceinline__ float siluf_(float x) { return x / (1.f + __expf(-x)); }

__global__ __launch_bounds__(256) void k_transpose(const float* __restrict__ src, u16* __restrict__ dst, int K, int N) {
  __shared__ float tile[64][65];
  const int n0 = blockIdx.x * 64, k0 = blockIdx.y * 64;
  const int tx = threadIdx.x & 63, ty = threadIdx.x >> 6;
  for (int i = 0; i < 16; ++i) { int k = i * 4 + ty; int n = n0 + tx; tile[k][tx] = (n < N) ? src[(size_t)(k0 + k) * N + n] : 0.f; }
  __syncthreads();
  for (int i = 0; i < 16; ++i) { int n = i * 4 + ty; dst[(size_t)(n0 + n) * K + k0 + tx] = f2bf(tile[tx][n]); }
}

__global__ __launch_bounds__(256) void k_mod(const float* __restrict__ c, const float* __restrict__ cctx, const float* __restrict__ w_mod,
                                             const float* __restrict__ b_mod, float* __restrict__ mod) {
  __shared__ float sc[17][512];
  __shared__ float red[4][17][64];
  const int l = blockIdx.x / 48, cg = blockIdx.x % 48;
  const int tid = threadIdx.x, kg = tid >> 6, jl = tid & 63, j = cg * 64 + jl;
  const float* W = w_mod + (size_t)l * 1024 * 3072;
  float acc[17];
#pragma unroll
  for (int i = 0; i < 17; ++i) acc[i] = 0.f;
  for (int half = 0; half < 2; ++half) {
    __syncthreads();
    for (int e = tid; e < 17 * 512; e += 256) { int i = e >> 9, k = e & 511; float v = (i < 16) ? c[i * 1024 + half * 512 + k] : cctx[half * 512 + k]; sc[i][k] = siluf_(v); }
    __syncthreads();
    for (int kk = 0; kk < 128; ++kk) {
      int k = kg * 128 + kk;
      float w = W[(size_t)(half * 512 + k) * 3072 + j];
#pragma unroll
      for (int i = 0; i < 17; ++i) acc[i] += sc[i][k] * w;
    }
  }
#pragma unroll
  for (int i = 0; i < 17; ++i) red[kg][i][jl] = acc[i];
  __syncthreads();
  for (int e = tid; e < 17 * 64; e += 256) { int i = e >> 6, jj = e & 63;
    float v = red[0][i][jj] + red[1][i][jj] + red[2][i][jj] + red[3][i][jj] + b_mod[l * 3072 + cg * 64 + jj];
    mod[((size_t)l * 17 + i) * 3072 + cg * 64 + jj] = v; }
}

__global__ __launch_bounds__(256) void k_modnorm(const float* __restrict__ xlat, const float* __restrict__ xctx, const float* __restrict__ g_pre,
                                                 const float* __restrict__ mod, u16* __restrict__ hbf, int b0) {
  const int wid = threadIdx.x >> 6, lane = threadIdx.x & 63;
  for (int r = blockIdx.x * 4 + wid; r < RG; r += gridDim.x * 4) {
    const int bl = r / SB, s = r % SB, b = b0 + bl;
    const float* src = (s < T) ? xlat + ((size_t)b * T + s) * DM : xctx + ((size_t)b * TC + (s - T)) * DM;
    const float* md = mod + (size_t)((s < T) ? b : 16) * 3072;
    float4 v[4]; float ss = 0.f;
#pragma unroll
    for (int i = 0; i < 4; ++i) { v[i] = *(const float4*)(src + i * 256 + lane * 4); ss += v[i].x * v[i].x + v[i].y * v[i].y + v[i].z * v[i].z + v[i].w * v[i].w; }
    ss = wave_sum(ss);
    const float rstd = rsqrtf(ss * (1.f / 1024.f) + 1e-6f);
#pragma unroll
    for (int i = 0; i < 4; ++i) {
      const int col = i * 256 + lane * 4;
      float4 g = *(const float4*)(g_pre + col), sc = *(const float4*)(md + 1024 + col), sh = *(const float4*)(md + col);
      ushort4 o;
      o.x = f2bf(v[i].x * rstd * g.x * (1.f + sc.x) + sh.x); o.y = f2bf(v[i].y * rstd * g.y * (1.f + sc.y) + sh.y);
      o.z = f2bf(v[i].z * rstd * g.z * (1.f + sc.z) + sh.z); o.w = f2bf(v[i].w * rstd * g.w * (1.f + sc.w) + sh.w);
      *(ushort4*)(hbf + (size_t)r * DM + col) = o;
    }
  }
}

struct GemmArgs {
  const u16* A; const u16* Bt; u16* Cb; float* Cf; const u16* G; float* m32; u16* mbf;
  int lda, K, N, ldc, ldg, first, last, pad;
};
constexpr int GLS = 72;
constexpr int GEMM_SMEM = 2 * (256 * GLS + 128 * GLS) * 2;
__device__ __forceinline__ int crow(int r, int hi) { return (r & 3) + 8 * (r >> 2) + 4 * hi; }

template <int MODE>
__device__ __forceinline__ void gemm_tile(const GemmArgs& g, int m0, int n0, char* smem) {
  u16* As = (u16*)smem; u16* Bs = As + 2 * 256 * GLS;
  const int tid = threadIdx.x, wid = tid >> 6, lane = tid & 63, r32 = lane & 31, hi = lane >> 5;
  const int wm = wid >> 1, wn = wid & 1;
  f32x16 acc[2][2];
#pragma unroll
  for (int mi = 0; mi < 2; ++mi)
#pragma unroll
    for (int ni = 0; ni < 2; ++ni)
#pragma unroll
      for (int r = 0; r < 16; ++r) acc[mi][ni][r] = 0.f;
  uint4 ra0, ra1, ra2, ra3, rb0, rb1;
  const int nk = g.K / 64;
  const int lrow = tid >> 3, lkc = tid & 7;
  const u16* gA = g.A + (size_t)(m0 + lrow) * g.lda + lkc * 8;
  const u16* gB = g.Bt + (size_t)(n0 + lrow) * g.K + lkc * 8;
  const size_t sA = (size_t)64 * g.lda, sB = (size_t)64 * g.K;
  u16* wA = As + lrow * GLS + lkc * 8; u16* wB = Bs + lrow * GLS + lkc * 8;
#define GLOAD(kt) do { const u16* pa_ = gA + (kt) * 64; const u16* pb_ = gB + (kt) * 64; \
    ra0 = *(const uint4*)(pa_); ra1 = *(const uint4*)(pa_ + sA); ra2 = *(const uint4*)(pa_ + 2 * sA); ra3 = *(const uint4*)(pa_ + 3 * sA); \
    rb0 = *(const uint4*)(pb_); rb1 = *(const uint4*)(pb_ + sB); } while (0)
#define SWRITE(buf) do { u16* qa_ = wA + (buf) * 256 * GLS; u16* qb_ = wB + (buf) * 128 * GLS; \
    *(uint4*)(qa_) = ra0; *(uint4*)(qa_ + 64 * GLS) = ra1; *(uint4*)(qa_ + 128 * GLS) = ra2; *(uint4*)(qa_ + 192 * GLS) = ra3; \
    *(uint4*)(qb_) = rb0; *(uint4*)(qb_ + 64 * GLS) = rb1; } while (0)
  GLOAD(0); SWRITE(0); __syncthreads();
  for (int kt = 0; kt < nk; ++kt) {
    const int buf = kt & 1;
    if (kt + 1 < nk) GLOAD(kt + 1);
    const u16* Ab = As + buf * 256 * GLS + (wm * 64 + r32) * GLS + hi * 8;
    const u16* Bb = Bs + buf * 128 * GLS + (wn * 64 + r32) * GLS + hi * 8;
#pragma unroll
    for (int ks = 0; ks < 4; ++ks) {
      bf16x8 a0 = *(const bf16x8*)(Ab + ks * 16), a1 = *(const bf16x8*)(Ab + 32 * GLS + ks * 16);
      bf16x8 b0 = *(const bf16x8*)(Bb + ks * 16), b1 = *(const bf16x8*)(Bb + 32 * GLS + ks * 16);
      acc[0][0] = __builtin_amdgcn_mfma_f32_32x32x16_bf16(a0, b0, acc[0][0], 0, 0, 0);
      acc[0][1] = __builtin_amdgcn_mfma_f32_32x32x16_bf16(a0, b1, acc[0][1], 0, 0, 0);
      acc[1][0] = __builtin_amdgcn_mfma_f32_32x32x16_bf16(a1, b0, acc[1][0], 0, 0, 0);
      acc[1][1] = __builtin_amdgcn_mfma_f32_32x32x16_bf16(a1, b1, acc[1][1], 0, 0, 0);
    }
    if (kt + 1 < nk) SWRITE(buf ^ 1);
    __syncthreads();
  }
#undef GLOAD
#undef SWRITE
#pragma unroll
  for (int mi = 0; mi < 2; ++mi)
#pragma unroll
    for (int ni = 0; ni < 2; ++ni) {
      const int col = n0 + wn * 64 + ni * 32 + r32;
      if (col < g.N) {
#pragma unroll
        for (int r = 0; r < 16; ++r) {
          const size_t row = (size_t)(m0 + wm * 64 + mi * 32 + crow(r, hi));
          const float v = acc[mi][ni][r];
          if (MODE == 0) g.Cb[row * g.ldc + col] = f2bf(v);
          else if (MODE == 1) g.Cf[row * g.ldc + col] = v;
          else {
            const float gate = sigmoidf_(bf2f(g.G[row * g.ldg + col]));
            float m = gate * v;
            if (!g.first) m += g.m32[row * 1024 + col];
            if (g.last) g.mbf[row * 1024 + col] = f2bf(m); else g.m32[row * 1024 + col] = m;
          }
        }
      }
    }
}
template <int MODE>
__global__ __launch_bounds__(512) void k_gemm(GemmArgs g) {
  extern __shared__ __attribute__((aligned(16))) char smem[];
  gemm_tile<MODE>(g, blockIdx.y * 256, blockIdx.x * 128, smem);
}

__global__ __launch_bounds__(256) void k_attn_prep(u16* __restrict__ P, const float* __restrict__ qn, const float* __restrict__ kn) {
  const int wid = threadIdx.x >> 6, lane = threadIdx.x & 63;
  const int i = lane & 31, half = lane >> 5;
  const float inv = exp2f(-(float)i * (13.287712379549449f / 32.f));
  const int d1 = half * 64 + i, d2 = d1 + 32;
  for (long item = (long)blockIdx.x * 4 + wid; item < (long)RG * 6; item += (long)gridDim.x * 4) {
    const int r = (int)(item / 6), hh = (int)(item % 6), s = r % SB;
    const int col = (hh < 4) ? C_AQ + hh * 128 : C_AK + (hh - 4) * 128;
    const float* gw = (hh < 4) ? qn : kn;
    u16* p = P + (size_t)r * LDP + col;
    float u1 = bf2f(p[d1]), u2 = bf2f(p[d2]);
    const float ss = wave_sum(u1 * u1 + u2 * u2);
    const float rstd = rsqrtf(ss * (1.f / 128.f) + 1e-6f);
    u1 *= rstd * gw[d1]; u2 *= rstd * gw[d2];
    if (s < T) {
      const float pos = half ? (float)(s & 63) : (float)(s >> 6);
      const float ang = pos * inv;
      const float cs = __cosf(ang), sn = __sinf(ang);
      const float o1 = u1 * cs - u2 * sn, o2 = u2 * cs + u1 * sn;
      u1 = o1; u2 = o2;
    }
    p[d1] = f2bf(u1); p[d2] = f2bf(u2);
  }
}

namespace att {
constexpr int D = 128, NW = 8, QBLK = 32, KVBLK = 64;
constexpr float SCALE = 0.088388347648318440f;
constexpr float THR = 8.f;
constexpr int LDQ = LDP, LDK = LDP;
constexpr size_t SHM_V = KVBLK * D * 2, SHM_K = KVBLK * D * 2, SHM_ATTN = 2 * SHM_V + 2 * SHM_K + NW * 64 * 4;
#define KSWZ(row, colB) ((row) * 256 + ((colB) ^ (((row) & 7) << 4)))
#define SBAR() __builtin_amdgcn_sched_barrier(0)
__device__ __forceinline__ unsigned cvtpk(float lo, float hi) {
  unsigned r; asm volatile("v_cvt_pk_bf16_f32 %0, %1, %2" : "=v"(r) : "v"(lo), "v"(hi)); return r;
}
__device__ __forceinline__ bf16x8 ld8(const bf16* p) { return *reinterpret_cast<const bf16x8*>(p); }
__device__ __forceinline__ void partialSM(f32x16& p0, f32x16& p1, float& m_reg, float& mn, float& alpha) {
  constexpr float C = SCALE * 1.4426950408889634f;
  float pmax = p0[0]; for (int r = 1; r < 16; ++r) pmax = fmaxf(pmax, p0[r]); for (int r = 0; r < 16; ++r) pmax = fmaxf(pmax, p1[r]);
  { auto rr = __builtin_amdgcn_permlane32_swap(__float_as_uint(pmax), __float_as_uint(pmax), false, false);
    pmax = fmaxf(__uint_as_float(rr[0]), __uint_as_float(rr[1])); }
  if (__builtin_expect(__all(pmax - m_reg <= THR / SCALE), 1)) { mn = m_reg; alpha = 1.f; }
  else { mn = fmaxf(m_reg, pmax); alpha = __builtin_amdgcn_exp2f((m_reg - mn) * C); m_reg = mn; }
  float mnC = -mn * C;
  for (int r = 0; r < 16; ++r) p0[r] = fmaf(p0[r], C, mnC); for (int r = 0; r < 16; ++r) p1[r] = fmaf(p1[r], C, mnC);
  for (int r = 0; r < 16; ++r) p0[r] = __builtin_amdgcn_exp2f(p0[r]);
}
__device__ __forceinline__ void finishSM(f32x16& p0, f32x16& p1, float alpha, float& l_reg, bf16x8& pa0, bf16x8& pa1, bf16x8& pa2, bf16x8& pa3) {
  for (int r = 0; r < 16; ++r) p1[r] = __builtin_amdgcn_exp2f(p1[r]);
  float ps = 0; for (int r = 0; r < 16; ++r) ps += p0[r]; for (int r = 0; r < 16; ++r) ps += p1[r];
  { auto rr = __builtin_amdgcn_permlane32_swap(__float_as_uint(ps), __float_as_uint(ps), false, false);
    ps = __uint_as_float(rr[0]) + __uint_as_float(rr[1]); }
  l_reg = l_reg * alpha + ps;
#define PK4(P, BASE, OUT) do { unsigned a0 = cvtpk(P[BASE + 0], P[BASE + 1]), a1 = cvtpk(P[BASE + 2], P[BASE + 3]);   \
    unsigned b0 = cvtpk(P[BASE + 4], P[BASE + 5]), b1 = cvtpk(P[BASE + 6], P[BASE + 7]);                              \
    auto r0 = __builtin_amdgcn_permlane32_swap(a0, b0, false, false); auto r1 = __builtin_amdgcn_permlane32_swap(a1, b1, false, false); \
    u32x4 w = {r0[0], r1[0], r0[1], r1[1]}; OUT = *reinterpret_cast<bf16x8*>(&w); } while (0)
  PK4(p0, 0, pa0); PK4(p0, 8, pa1); PK4(p1, 0, pa2); PK4(p1, 8, pa3);
#undef PK4
}
__device__ __forceinline__ void qkt(f32x16& p0, f32x16& p1, const bf16* Ks, const bf16x8* qr, int r32, int hi) {
  p0 = f32x16{}; p1 = f32x16{};
  for (int d0 = 0; d0 < 8; ++d0) { int cb = (d0 * 16 + hi * 8) * 2;
    bf16x8 b0 = *reinterpret_cast<const bf16x8*>((const char*)Ks + KSWZ(r32, cb));
    bf16x8 b1 = *reinterpret_cast<const bf16x8*>((const char*)Ks + KSWZ(32 + r32, cb));
    p0 = __builtin_amdgcn_mfma_f32_32x32x16_bf16(b0, qr[d0], p0, 0, 0, 0);
    p1 = __builtin_amdgcn_mfma_f32_32x32x16_bf16(b1, qr[d0], p1, 0, 0, 0); }
}
__device__ __forceinline__ int v_st(int k, int c) { const int kk = (k & ~0xC) | ((k & 4) << 1) | ((k & 8) >> 1); return ((kk >> 3) * 4 + (c >> 5)) * 512 + ((kk & 7) * 32 + (c & 31)) * 2; }
__device__ __forceinline__ int v_rd_base(int lane) { return ((lane & 3) << 3) | (((lane >> 2) & 3) << 6) | (((lane >> 4) & 1) << 5) | (((lane >> 5) & 1) << 8); }
constexpr int v_rd_off(int d0, int ks, int half) { return d0 * 512 + ks * 4096 + half * 2048; }
template <int OFF> __device__ __forceinline__ s16x4 tr_read(int vb) {
  s16x4 r; asm volatile("ds_read_b64_tr_b16 %0, %1 offset:%2" : "=&v"(r) : "v"(vb), "i"(OFF) : "memory"); return r;
}
template <int D0> __device__ __forceinline__ void pv_one(f32x16& od, int vb, bf16x8 pa0, bf16x8 pa1, bf16x8 pa2, bf16x8 pa3) {
  const s16x4 l0 = tr_read<v_rd_off(D0, 0, 0)>(vb), h0 = tr_read<v_rd_off(D0, 0, 1)>(vb), l1 = tr_read<v_rd_off(D0, 1, 0)>(vb), h1 = tr_read<v_rd_off(D0, 1, 1)>(vb);
  const s16x4 l2 = tr_read<v_rd_off(D0, 2, 0)>(vb), h2 = tr_read<v_rd_off(D0, 2, 1)>(vb), l3 = tr_read<v_rd_off(D0, 3, 0)>(vb), h3 = tr_read<v_rd_off(D0, 3, 1)>(vb);
  asm volatile("s_waitcnt lgkmcnt(0)" ::: "memory"); SBAR();
#define PK(L, H) (bf16x8){L[0], L[1], L[2], L[3], H[0], H[1], H[2], H[3]}
  od = __builtin_amdgcn_mfma_f32_32x32x16_bf16(pa0, PK(l0, h0), od, 0, 0, 0);
  od = __builtin_amdgcn_mfma_f32_32x32x16_bf16(pa1, PK(l1, h1), od, 0, 0, 0);
  od = __builtin_amdgcn_mfma_f32_32x32x16_bf16(pa2, PK(l2, h2), od, 0, 0, 0);
  od = __builtin_amdgcn_mfma_f32_32x32x16_bf16(pa3, PK(l3, h3), od, 0, 0, 0);
#undef PK
}
__device__ __forceinline__ void pv_d0(f32x16* o, int vb, bf16x8 pa0, bf16x8 pa1, bf16x8 pa2, bf16x8 pa3) {
  pv_one<0>(o[0], vb, pa0, pa1, pa2, pa3); pv_one<1>(o[1], vb, pa0, pa1, pa2, pa3); pv_one<2>(o[2], vb, pa0, pa1, pa2, pa3); pv_one<3>(o[3], vb, pa0, pa1, pa2, pa3);
}
__device__ __forceinline__ void attn_dense_body(const bf16* __restrict__ Qb, const bf16* __restrict__ Kh, const bf16* __restrict__ Vh,
                                                const u16* __restrict__ Gb, u16* __restrict__ Yb, int seq, char* lds) {
  const int tid = threadIdx.x, wid = tid >> 6, lane = tid & 63, r32 = lane & 31, hi = lane >> 5;
  bf16* V_lds = (bf16*)lds; bf16* K_lds = (bf16*)(lds + 2 * SHM_V);
  float* ws = (float*)(lds + 2 * SHM_V + 2 * SHM_K) + wid * 64; float* li_l = ws; float* al_l = ws + 32;
  float m_reg = -1e30f, l_reg = 0; f32x16 o[4] = {}; bf16x8 qr[8];
  const bf16* Qw = Qb + (long)(wid * QBLK + r32) * LDQ + hi * 8;
#pragma unroll
  for (int d0 = 0; d0 < 8; ++d0) qr[d0] = ld8(Qw + d0 * 16);
  const int sr = tid >> 4, sc = (tid & 15) * 8, vst0 = v_st(sr, sc), vst1 = v_st(32 + sr, sc);
  const int vb0 = (int)(uintptr_t)V_lds + v_rd_base(lane);
  struct { bf16x8 vs0, vs1, ks0, ks1; } sr_[2];
#define SLOAD(i, k0) do { sr_[i].vs0 = ld8(&Vh[(long)((k0) + sr) * LDK + sc]); sr_[i].vs1 = ld8(&Vh[(long)((k0) + 32 + sr) * LDK + sc]); \
    sr_[i].ks0 = ld8(&Kh[(long)((k0) + sr) * LDK + sc]); sr_[i].ks1 = ld8(&Kh[(long)((k0) + 32 + sr) * LDK + sc]); } while (0)
#define SWRITE(b, i) do { *(bf16x8*)((char*)V_lds + (b) * SHM_V + vst0) = sr_[i].vs0;          \
    *(bf16x8*)((char*)V_lds + (b) * SHM_V + vst1) = sr_[i].vs1; int kc = sc * 2;               \
    *(bf16x8*)((char*)K_lds + (b) * SHM_K + KSWZ(sr, kc)) = sr_[i].ks0;                       \
    *(bf16x8*)((char*)K_lds + (b) * SHM_K + KSWZ(32 + sr, kc)) = sr_[i].ks1; } while (0)
#define SWAIT() do { asm volatile("s_waitcnt vmcnt(4)" ::: "memory"); } while (0)
#define RESC(a) do { if (__any((a) < 1.f)) { if (hi == 0) al_l[r32] = (a); asm volatile("s_waitcnt lgkmcnt(0)" ::: "memory"); \
    for (int d = 0; d < 4; ++d) for (int r = 0; r < 16; ++r) o[d][r] *= al_l[crow(r, hi)]; } } while (0)
  f32x16 pA0, pA1, pB0, pB1; float mnA, mnB, alA, alB; bf16x8 pa0, pa1, pa2, pa3; const int NT = seq / KVBLK;
  constexpr int SE = 0, SO = 1;
  SLOAD(SE, 0); asm volatile("s_waitcnt vmcnt(0)" ::: "memory"); SWRITE(0, SE); __syncthreads();
  qkt(pA0, pA1, K_lds, qr, r32, hi); partialSM(pA0, pA1, m_reg, mnA, alA);
  SLOAD(SO, KVBLK); if (2 < NT) SLOAD(SE, 2 * KVBLK);
  SWAIT(); SWRITE(1, SO); __syncthreads();
  for (int j = 1; j + 1 < NT; j += 2) {
    SBAR(); qkt(pB0, pB1, (bf16*)((char*)K_lds + SHM_K), qr, r32, hi);
    finishSM(pA0, pA1, alA, l_reg, pa0, pa1, pa2, pa3); SBAR();
    SLOAD(SO, (j + 2) * KVBLK); SBAR();
    pv_d0(o, vb0, pa0, pa1, pa2, pa3); partialSM(pB0, pB1, m_reg, mnB, alB);
    __syncthreads(); SWAIT(); SWRITE(0, SE);
    RESC(alB); __syncthreads();
    SBAR(); qkt(pA0, pA1, K_lds, qr, r32, hi);
    finishSM(pB0, pB1, alB, l_reg, pa0, pa1, pa2, pa3); SBAR();
    if (j + 3 < NT) SLOAD(SE, (j + 3) * KVBLK); SBAR();
    pv_d0(o, vb0 + (int)SHM_V, pa0, pa1, pa2, pa3); partialSM(pA0, pA1, m_reg, mnA, alA);
    __syncthreads(); SWAIT(); SWRITE(1, SO);
    RESC(alA); __syncthreads();
  }
  SBAR(); qkt(pB0, pB1, (bf16*)((char*)K_lds + SHM_K), qr, r32, hi);
  finishSM(pA0, pA1, alA, l_reg, pa0, pa1, pa2, pa3); SBAR();
  pv_d0(o, vb0, pa0, pa1, pa2, pa3); partialSM(pB0, pB1, m_reg, mnB, alB);
  __syncthreads(); RESC(alB);
  finishSM(pB0, pB1, alB, l_reg, pa0, pa1, pa2, pa3); SBAR();
  pv_d0(o, vb0 + (int)SHM_V, pa0, pa1, pa2, pa3);
  if (hi == 0) li_l[r32] = l_reg; asm volatile("s_waitcnt lgkmcnt(0)" ::: "memory");
  float rli[16];
#pragma unroll
  for (int r = 0; r < 16; ++r) rli[r] = __builtin_amdgcn_rcpf(li_l[crow(r, hi)]);
#pragma unroll
  for (int r = 0; r < 16; ++r) { const long orow = wid * QBLK + crow(r, hi);
#pragma unroll
    for (int d0 = 0; d0 < 4; ++d0) {
      const float gt = bf2f(Gb[orow * LDQ + d0 * 32 + r32]);
      Yb[orow * LDY + d0 * 32 + r32] = f2bf(o[d0][r] * rli[r] * siluf_(gt));
    } }
  __syncthreads();
#undef SLOAD
#undef SWRITE
#undef SWAIT
#undef RESC
}
}

__global__ __launch_bounds__(512, 1) void k_attn(const u16* __restrict__ P, u16* __restrict__ Y) {
  extern __shared__ __attribute__((aligned(16))) char smem[];
  const int t = blockIdx.x;
  int bl, h, qrow0, krow0, seq;
  if (t < GB * 64) { bl = t / 64; h = (t / 16) & 3; qrow0 = (t & 15) * 256; krow0 = 0; seq = SB; }
  else { const int u = t - GB * 64; bl = u / 4; h = u & 3; qrow0 = T; krow0 = T; seq = TC; }
  const int kvh = h >> 1;
  const size_t qoff = (size_t)(bl * SB + qrow0) * LDP, koff = (size_t)(bl * SB + krow0) * LDP;
  att::attn_dense_body((const bf16*)(P + qoff + C_AQ + h * 128), (const bf16*)(P + koff + C_AK + kvh * 128), (const bf16*)(P + koff + C_AV + kvh * 128),
                       P + qoff + C_AG + h * 128, Y + (size_t)(bl * SB + qrow0) * LDY + 512 + h * 128, seq, smem);
}

__global__ __launch_bounds__(256) void k_gla_prep(const u16* __restrict__ P, const float* __restrict__ wupf, const float* __restrict__ bf_,
                                                  const float* __restrict__ wupb, const float* __restrict__ bb_, float* __restrict__ G) {
  __shared__ float lr[32];
  const int j = threadIdx.x;
  for (int r = blockIdx.x; r < RG; r += gridDim.x) {
    __syncthreads();
    if (j < 32) lr[j] = bf2f(P[(size_t)r * LDP + C_GWF + j]);
    __syncthreads();
    float xf = bf_[j], xb = bb_[j];
#pragma unroll
    for (int i = 0; i < 16; ++i) { xf += lr[i] * wupf[i * 256 + j]; xb += lr[16 + i] * wupb[i * 256 + j]; }
    const float lf = fminf(xf, 0.f) - log1pf(__expf(-fabsf(xf)));
    const float lb = fminf(xb, 0.f) - log1pf(__expf(-fabsf(xb)));
    G[(size_t)r * 512 + j] = lf * (1.f / 16.f);
    G[(size_t)r * 512 + 256 + j] = lb * (1.f / 16.f);
  }
}
__global__ __launch_bounds__(256) void k_gla_state(const u16* __restrict__ P, const float* __restrict__ G, float* __restrict__ Sst) {
  extern __shared__ __attribute__((aligned(16))) char smem[];
  float* kt = (float*)smem; float* vs = kt + 64 * 64; float* gc = vs + 64 * 128;
  const int unit = blockIdx.x, dir = unit & 1, h = (unit >> 1) & 3, bl = unit >> 3;
  const int tid = threadIdx.x, d = tid >> 2, eq = tid & 3;
  float S[32];
#pragma unroll
  for (int j = 0; j < 32; ++j) S[j] = 0.f;
  for (int pi = 0; pi < 68; ++pi) {
    const int base = dir == 0 ? (pi < 4 ? T + 64 * pi : 64 * (pi - 4)) : (pi < 4 ? T + 64 * (3 - pi) : 64 * (67 - pi));
    const int cid = base >> 6;
    __syncthreads();
    for (int e = tid; e < 64 * 64; e += 256) { const int c = e >> 6, dd = e & 63; const size_t row = (size_t)(bl * SB + base + c);
      kt[e] = bf2f(P[row * LDP + C_GK + h * 64 + dd]); gc[e] = G[row * 512 + dir * 256 + h * 64 + dd]; }
    for (int e = tid; e < 64 * 128; e += 256) { const int c = e >> 7, ee = e & 127; const size_t row = (size_t)(bl * SB + base + c);
      vs[e] = bf2f(P[row * LDP + C_GV + h * 128 + ee]); }
    __syncthreads();
    if (tid < 64) { float run = 0.f; for (int i = 0; i < 64; ++i) { const int c = dir ? 63 - i : i; run += gc[c * 64 + tid]; gc[c * 64 + tid] = run; } }
    __syncthreads();
    const int lastc = dir ? 0 : 63;
    for (int e = tid; e < 64 * 64; e += 256) { const int dd = e & 63; kt[e] *= __expf(gc[lastc * 64 + dd] - gc[e]); }
    __syncthreads();
    float* dst = Sst + ((((size_t)(bl * 4 + h) * 2 + dir) * 68 + cid) * 64 + d) * 128 + eq * 32;
#pragma unroll
    for (int j = 0; j < 32; j += 4) *(float4*)(dst + j) = make_float4(S[j], S[j + 1], S[j + 2], S[j + 3]);
    const float dec = __expf(gc[lastc * 64 + d]);
#pragma unroll
    for (int j = 0; j < 32; ++j) S[j] *= dec;
    for (int s = 0; s < 64; ++s) {
      const float kv = kt[s * 64 + d];
      const float* vp = vs + s * 128 + eq * 32;
#pragma unroll
      for (int j = 0; j < 32; j += 4) { float4 v4 = *(const float4*)(vp + j); S[j] += kv * v4.x; S[j + 1] += kv * v4.y; S[j + 2] += kv * v4.z; S[j + 3] += kv * v4.w; }
    }
  }
}
constexpr int GLQ = 68;
constexpr int GLA_OUT_SMEM = (4 * 64 * GLQ + 64 * 128 + 64 * 65) * 4;
__global__ __launch_bounds__(256) void k_gla_out(const u16* __restrict__ P, const float* __restrict__ G, const float* __restrict__ Sst,
                                                 const float* __restrict__ gnorm, u16* __restrict__ Y) {
  extern __shared__ __attribute__((aligned(16))) char smem[];
  float* qdf = (float*)smem; float* kif = qdf + 64 * GLQ; float* qdb = kif + 64 * GLQ; float* kib = qdb + 64 * GLQ;
  float* vs = kib + 64 * GLQ; float* Am = vs + 64 * 128;
  const int cid = blockIdx.x % 68, h = (blockIdx.x / 68) & 3, bl = blockIdx.x / (68 * 4);
  const int tid = threadIdx.x;
  const size_t row0 = (size_t)(bl * SB + cid * 64);
  for (int e = tid; e < 64 * 64; e += 256) { const int c = e >> 6, dd = e & 63;
    kif[c * GLQ + dd] = G[(row0 + c) * 512 + h * 64 + dd]; kib[c * GLQ + dd] = G[(row0 + c) * 512 + 256 + h * 64 + dd]; }
  for (int e = tid; e < 64 * 128; e += 256) { const int c = e >> 7, ee = e & 127; vs[e] = bf2f(P[(row0 + c) * LDP + C_GV + h * 128 + ee]); }
  __syncthreads();
  if (tid < 64) { float run = 0.f; for (int c = 0; c < 64; ++c) { run += kif[c * GLQ + tid]; kif[c * GLQ + tid] = run; } }
  else if (tid < 128) { const int dd = tid - 64; float run = 0.f; for (int c = 63; c >= 0; --c) { run += kib[c * GLQ + dd]; kib[c * GLQ + dd] = run; } }
  __syncthreads();
  for (int e = tid; e < 64 * 64; e += 256) { const int c = e >> 6, dd = e & 63;
    const float q = bf2f(P[(row0 + c) * LDP + C_GQ + h * 64 + dd]) * 0.125f, k = bf2f(P[(row0 + c) * LDP + C_GK + h * 64 + dd]);
    const float gf = kif[c * GLQ + dd], gb = kib[c * GLQ + dd];
    qdf[c * GLQ + dd] = q * __expf(gf); kif[c * GLQ + dd] = k * __expf(-gf);
    qdb[c * GLQ + dd] = q * __expf(gb); kib[c * GLQ + dd] = k * __expf(-gb); }
  __syncthreads();
  const int c = tid >> 2, sq = tid & 3;
  {
    float af[16], ab[16];
#pragma unroll
    for (int i = 0; i < 16; ++i) { af[i] = 0.f; ab[i] = 0.f; }
    for (int d4 = 0; d4 < 16; ++d4) {
      const float4 qf = *(const float4*)(qdf + c * GLQ + d4 * 4), qb = *(const float4*)(qdb + c * GLQ + d4 * 4);
#pragma unroll
      for (int i = 0; i < 16; ++i) { const int s = sq + 4 * i;
        const float4 kf = *(const float4*)(kif + s * GLQ + d4 * 4), kb = *(const float4*)(kib + s * GLQ + d4 * 4);
        af[i] += qf.x * kf.x + qf.y * kf.y + qf.z * kf.z + qf.w * kf.w;
        ab[i] += qb.x * kb.x + qb.y * kb.y + qb.z * kb.z + qb.w * kb.w; }
    }
#pragma unroll
    for (int i = 0; i < 16; ++i) { const int s = sq + 4 * i; Am[c * 65 + s] = (s <= c ? af[i] : 0.f) + (s >= c ? ab[i] : 0.f); }
  }
  __syncthreads();
  float acc[32];
#pragma unroll
  for (int j = 0; j < 32; ++j) acc[j] = 0.f;
  const int e0 = sq * 32;
  for (int s = 0; s < 64; ++s) {
    const float a = Am[c * 65 + s]; const float* vp = vs + s * 128 + e0;
#pragma unroll
    for (int j = 0; j < 32; j += 4) { float4 v4 = *(const float4*)(vp + j); acc[j] += a * v4.x; acc[j + 1] += a * v4.y; acc[j + 2] += a * v4.z; acc[j + 3] += a * v4.w; }
  }
  const float* Sf = Sst + ((((size_t)(bl * 4 + h) * 2 + 0) * 68 + cid) * 64) * 128 + e0;
  const float* Sb = Sst + ((((size_t)(bl * 4 + h) * 2 + 1) * 68 + cid) * 64) * 128 + e0;
  for (int d = 0; d < 64; ++d) {
    const float qf = qdf[c * GLQ + d], qb = qdb[c * GLQ + d];
#pragma unroll
    for (int j = 0; j < 32; j += 4) { float4 s4 = *(const float4*)(Sf + d * 128 + j), t4 = *(const float4*)(Sb + d * 128 + j);
      acc[j] += qf * s4.x + qb * t4.x; acc[j + 1] += qf * s4.y + qb * t4.y; acc[j + 2] += qf * s4.z + qb * t4.z; acc[j + 3] += qf * s4.w + qb * t4.w; }
  }
  float ss = 0.f;
#pragma unroll
  for (int j = 0; j < 32; ++j) ss += acc[j] * acc[j];
  ss += __shfl_xor(ss, 1); ss += __shfl_xor(ss, 2);
  const float rstd = rsqrtf(ss * (1.f / 128.f) + 1e-6f);
#pragma unroll
  for (int j = 0; j < 32; ++j) {
    const float gt = bf2f(P[(row0 + c) * LDP + C_GG + h * 128 + e0 + j]);
    Y[(row0 + c) * LDY + h * 128 + e0 + j] = f2bf(acc[j] * rstd * gnorm[h * 128 + e0 + j] * siluf_(gt));
  }
}

struct RwkvW { const float *mu, *w0f, *wupf, *w0b, *wupb, *a0f, *aupf, *a0b, *aupb, *kk, *ka, *rk, *lng, *lnb; };
__global__ __launch_bounds__(512) void k_rwkv_prep(const u16* __restrict__ P, RwkvW w, float* __restrict__ RW) {
  __shared__ float lr[4][64];
  const int j = threadIdx.x;
  const size_t AR = (size_t)RG * 512;
  for (int r = blockIdx.x; r < RG; r += gridDim.x) {
    const int s = r % SB;
    const bool first = (s == 0) || (s == T), last = (s == T - 1) || (s == SB - 1);
    const u16* p0 = P + (size_t)r * LDP + C_RW;
#define SHF(col) ({ const int c_ = (col); const float cc = bf2f(p0[c_]); const float ll = first ? 0.f : bf2f(p0[c_ - LDP]); \
      const float nn = last ? 0.f : bf2f(p0[c_ + LDP]); cc + w.mu[c_] * (0.5f * (ll + nn) - cc); })
    const float rr = SHF(j), kx = SHF(512 + j), vv = SHF(1024 + j), gg = SHF(1536 + j);
    __syncthreads();
    if (j < 256) { const float x = SHF(2048 + j); lr[j >> 6][j & 63] = (j < 128) ? tanhf(x) : x; }
#undef SHF
    __syncthreads();
    float sf = w.w0f[j], sb = w.w0b[j], af = w.a0f[j], ab = w.a0b[j];
#pragma unroll 8
    for (int i = 0; i < 64; ++i) { sf += lr[0][i] * w.wupf[i * 512 + j]; sb += lr[1][i] * w.wupb[i * 512 + j];
      af += lr[2][i] * w.aupf[i * 512 + j]; ab += lr[3][i] * w.aupb[i * 512 + j]; }
    const float wf = __expf(-0.6065306597f * sigmoidf_(sf)), wb = __expf(-0.6065306597f * sigmoidf_(sb));
    const float a_f = sigmoidf_(af), a_b = sigmoidf_(ab);
    const float ka = w.ka[j];
    const float kdf = kx * (1.f + (a_f - 1.f) * ka), kdb = kx * (1.f + (a_b - 1.f) * ka);
    float kk = kx * w.kk[j];
    const float ss = wave_sum(kk * kk);
    kk *= rsqrtf(ss + 1e-12f);
    const size_t o = (size_t)r * 512 + j;
    RW[0 * AR + o] = rr; RW[1 * AR + o] = vv; RW[2 * AR + o] = kk; RW[3 * AR + o] = gg;
    RW[4 * AR + o] = wf; RW[5 * AR + o] = kdf; RW[6 * AR + o] = kk * a_f;
    RW[7 * AR + o] = wb; RW[8 * AR + o] = kdb; RW[9 * AR + o] = kk * a_b;
  }
}
__global__ __launch_bounds__(256) void k_rwkv_scan(const float* __restrict__ RW, float* __restrict__ yfb) {
  constexpr int CH = 16;
  __shared__ __attribute__((aligned(16))) float sw[CH][64], skk[CH][64], sb[CH][64], skd[CH][64], sr[CH][64], sv[CH][64], sy[CH][64];
  const int unit = blockIdx.x, dir = unit & 1, h = (unit >> 1) & 7, bl = unit >> 4;
  const int tid = threadIdx.x, vrow = tid >> 2, q = tid & 3;
  const size_t AR = (size_t)RG * 512;
  const float* r_ = RW, *v_ = RW + AR, *kk_ = RW + 2 * AR, *w_ = RW + (dir ? 7 : 4) * AR, *kd_ = RW + (dir ? 8 : 5) * AR, *b_ = RW + (dir ? 9 : 6) * AR;
  float S[16];
#pragma unroll
  for (int k = 0; k < 16; ++k) S[k] = 0.f;
  for (int seg = 0; seg < 2; ++seg) {
    const int base = seg == 0 ? T : 0, len = seg == 0 ? TC : T;
    for (int c0 = 0; c0 < len; c0 += CH) {
      __syncthreads();
      for (int e = tid; e < CH * 64; e += 256) { const int i = e >> 6, n = e & 63; const int s = dir ? base + len - 1 - (c0 + i) : base + c0 + i;
        const size_t off = (size_t)(bl * SB + s) * 512 + h * 64 + n;
        sw[i][n] = w_[off]; skk[i][n] = kk_[off]; sb[i][n] = b_[off]; skd[i][n] = kd_[off]; sr[i][n] = r_[off]; sv[i][n] = v_[off]; }
      __syncthreads();
      for (int i = 0; i < CH; ++i) {
        float sa = 0.f;
#pragma unroll
        for (int k = 0; k < 16; ++k) sa += S[k] * skk[i][q * 16 + k];
        sa += __shfl_xor(sa, 1); sa += __shfl_xor(sa, 2);
        const float vv = sv[i][vrow];
        float y = 0.f;
#pragma unroll
        for (int k = 0; k < 16; ++k) { S[k] = S[k] * sw[i][q * 16 + k] + (vv * skd[i][q * 16 + k] - sa * sb[i][q * 16 + k]); y += S[k] * sr[i][q * 16 + k]; }
        y += __shfl_xor(y, 1); y += __shfl_xor(y, 2);
        if (q == 0) sy[i][vrow] = y;
      }
      __syncthreads();
      for (int e = tid; e < CH * 64; e += 256) { const int i = e >> 6, n = e & 63; const int s = dir ? base + len - 1 - (c0 + i) : base + c0 + i;
        yfb[(size_t)(bl * SB + s) * 1024 + dir * 512 + h * 64 + n] = sy[i][n]; }
    }
  }
}
__global__ __launch_bounds__(512) void k_rwkv_final(const float* __restrict__ RW, const float* __restrict__ yfb, RwkvW w, u16* __restrict__ Y) {
  const int j = threadIdx.x;
  const size_t AR = (size_t)RG * 512;
  for (int r = blockIdx.x; r < RG; r += gridDim.x) {
    const size_t o = (size_t)r * 512 + j;
    const float y = yfb[(size_t)r * 1024 + j] + yfb[(size_t)r * 1024 + 512 + j];
    const float mean = wave_sum(y) * (1.f / 64.f);
    const float dv = y - mean;
    const float var = wave_sum(dv * dv) * (1.f / 64.f);
    const float ln = dv * rsqrtf(var + 64e-5f) * w.lng[j] + w.lnb[j];
    const float rr = RW[o], vv = RW[AR + o], gg = RW[3 * AR + o], kdf = RW[5 * AR + o], kdb = RW[8 * AR + o];
    const float bonus = wave_sum(rr * (kdf + kdb) * w.rk[j]);
    Y[(size_t)r * LDY + 1024 + j] = f2bf((ln + bonus * vv) * siluf_(gg));
  }
}

__global__ __launch_bounds__(256) void k_final(const float* __restrict__ z, const float* xlat_in, const float* xctx_in, const float* __restrict__ g_post,
                                               const float* __restrict__ mod, float* xlat_out, float* xctx_out, int b0) {
  const int wid = threadIdx.x >> 6, lane = threadIdx.x & 63;
  for (int r = blockIdx.x * 4 + wid; r < RG; r += gridDim.x * 4) {
    const int bl = r / SB, s = r % SB, b = b0 + bl;
    const float* src; float* dst; const float* gate;
    if (s < T) { src = xlat_in + ((size_t)b * T + s) * DM; dst = xlat_out + ((size_t)b * T + s) * DM; gate = mod + (size_t)b * 3072 + 2048; }
    else { if (xctx_out == nullptr) continue; src = xctx_in + ((size_t)b * TC + (s - T)) * DM; dst = xctx_out + ((size_t)b * TC + (s - T)) * DM; gate = mod + (size_t)16 * 3072 + 2048; }
    float4 v[4]; float ss = 0.f;
#pragma unroll
    for (int i = 0; i < 4; ++i) { v[i] = *(const float4*)(z + (size_t)r * DM + i * 256 + lane * 4); ss += v[i].x * v[i].x + v[i].y * v[i].y + v[i].z * v[i].z + v[i].w * v[i].w; }
    ss = wave_sum(ss);
    const float rstd = rsqrtf(ss * (1.f / 1024.f) + 1e-6f);
#pragma unroll
    for (int i = 0; i < 4; ++i) {
      const int col = i * 256 + lane * 4;
      const float4 g = *(const float4*)(g_post + col), gt = *(const float4*)(gate + col), xv = *(const float4*)(src + col);
      float4 o;
      o.x = xv.x + gt.x * (v[i].x * rstd * g.x); o.y = xv.y + gt.y * (v[i].y * rstd * g.y);
      o.z = xv.z + gt.z * (v[i].z * rstd * g.z); o.w = xv.w + gt.w * (v[i].w * rstd * g.w);
      *(float4*)(dst + col) = o;
    }
  }
}

static inline size_t al256(size_t x) { return (x + 255) / 256 * 256; }
extern "C" void kernel_launch(void* const* d_in, const int* in_sizes, int n_in, void* d_out, int out_size, void* d_ws, size_t ws_size, hipStream_t stream) {
  const float* x = (const float*)d_in[0]; const float* c = (const float*)d_in[1]; const float* ctx = (const float*)d_in[2]; const float* c_ctx = (const float*)d_in[3];
  const float* w_mod = (const float*)d_in[4]; const float* b_mod = (const float*)d_in[5]; const float* g_pre = (const float*)d_in[6]; const float* w_in = (const float*)d_in[7];
  const float* gla_wup_f = (const float*)d_in[8]; const float* gla_b_f = (const float*)d_in[9]; const float* gla_wup_b = (const float*)d_in[10]; const float* gla_b_b = (const float*)d_in[11];
  const float* gla_norm = (const float*)d_in[12]; const float* att_qnorm = (const float*)d_in[13]; const float* att_knorm = (const float*)d_in[14];
  const float* rwkv_mu = (const float*)d_in[15]; const float* rwkv_w0_f = (const float*)d_in[16]; const float* rwkv_wup_f = (const float*)d_in[17];
  const float* rwkv_w0_b = (const float*)d_in[18]; const float* rwkv_wup_b = (const float*)d_in[19]; const float* rwkv_a0_f = (const float*)d_in[20];
  const float* rwkv_aup_f = (const float*)d_in[21]; const float* rwkv_a0_b = (const float*)d_in[22]; const float* rwkv_aup_b = (const float*)d_in[23];
  const float* rwkv_kk = (const float*)d_in[24]; const float* rwkv_ka = (const float*)d_in[25]; const float* rwkv_rk = (const float*)d_in[26];
  const float* rwkv_ln_g = (const float*)d_in[27]; const float* rwkv_ln_b = (const float*)d_in[28];
  const float* w_o_gla = (const float*)d_in[29]; const float* w_o_att = (const float*)d_in[30]; const float* w_o_rwkv = (const float*)d_in[31];
  const float* w_out = (const float*)d_in[32]; const float* g_post = (const float*)d_in[33];
  float* out = (float*)d_out;

  char* ws = (char*)d_ws; size_t off = 0;
  auto take = [&](size_t bytes) { char* p = ws + off; off += al256(bytes); return p; };
  u16* Wt_in = (u16*)take((size_t)2 * DINP * 1024 * 2);
  u16* Wt_o = (u16*)take((size_t)2 * 3 * 1024 * 512 * 2);
  u16* Wt_out = (u16*)take((size_t)2 * 1024 * 1024 * 2);
  float* mod = (float*)take((size_t)2 * 17 * 3072 * 4);
  float* xc1 = (float*)take((size_t)NB * TC * DM * 4);
  u16* hbf = (u16*)take((size_t)RG * DM * 2);
  u16* P = (u16*)take((size_t)RG * LDP * 2);
  u16* Y = (u16*)take((size_t)RG * LDY * 2);
  float* G = (float*)take((size_t)RG * 512 * 4);
  float* Sst = (float*)take((size_t)GB * 4 * 2 * 68 * 64 * 128 * 4);
  float* RW = (float*)take((size_t)10 * RG * 512 * 4);
  float* yfb = (float*)take((size_t)RG * 1024 * 4);
  float* m32 = (float*)take((size_t)RG * 1024 * 4);
  u16* mbf = (u16*)take((size_t)RG * 1024 * 2);
  if (off > ws_size) { fprintf(stderr, "kernel_launch: workspace too small (%zu > %zu)\n", off, ws_size); return; }

  static int attr_done = 0;
  if (!attr_done) {
    hipFuncSetAttribute((const void*)k_gemm<0>, hipFuncAttributeMaxDynamicSharedMemorySize, GEMM_SMEM);
    hipFuncSetAttribute((const void*)k_gemm<1>, hipFuncAttributeMaxDynamicSharedMemorySize, GEMM_SMEM);
    hipFuncSetAttribute((const void*)k_gemm<2>, hipFuncAttributeMaxDynamicSharedMemorySize, GEMM_SMEM);
    hipFuncSetAttribute((const void*)k_attn, hipFuncAttributeMaxDynamicSharedMemorySize, (int)att::SHM_ATTN);
    hipFuncSetAttribute((const void*)k_gla_state, hipFuncAttributeMaxDynamicSharedMemorySize, 65536);
    hipFuncSetAttribute((const void*)k_gla_out, hipFuncAttributeMaxDynamicSharedMemorySize, GLA_OUT_SMEM);
    attr_done = 1;
  }

  for (int l = 0; l < 2; ++l) {
    hipLaunchKernelGGL(k_transpose, dim3(DINP / 64, 1024 / 64), dim3(256), 0, stream, w_in + (size_t)l * 1024 * DIN, Wt_in + (size_t)l * DINP * 1024, 1024, DIN);
    const float* wo[3] = {w_o_gla, w_o_att, w_o_rwkv};
    for (int i = 0; i < 3; ++i)
      hipLaunchKernelGGL(k_transpose, dim3(1024 / 64, 512 / 64), dim3(256), 0, stream, wo[i] + (size_t)l * 512 * 1024, Wt_o + ((size_t)l * 3 + i) * 1024 * 512, 512, 1024);
    hipLaunchKernelGGL(k_transpose, dim3(1024 / 64, 1024 / 64), dim3(256), 0, stream, w_out + (size_t)l * 1024 * 1024, Wt_out + (size_t)l * 1024 * 1024, 1024, 1024);
  }
  hipLaunchKernelGGL(k_mod, dim3(96), dim3(256), 0, stream, c, c_ctx, w_mod, b_mod, mod);

  for (int l = 0; l < 2; ++l) {
    const float* xlat_in = l == 0 ? x : out;
    const float* xctx_in = l == 0 ? ctx : xc1;
    const float* modl = mod + (size_t)l * 17 * 3072;
    RwkvW rw;
    rw.mu = rwkv_mu + l * 2304; rw.w0f = rwkv_w0_f + l * 512; rw.wupf = rwkv_wup_f + l * 64 * 512; rw.w0b = rwkv_w0_b + l * 512; rw.wupb = rwkv_wup_b + l * 64 * 512;
    rw.a0f = rwkv_a0_f + l * 512; rw.aupf = rwkv_aup_f + l * 64 * 512; rw.a0b = rwkv_a0_b + l * 512; rw.aupb = rwkv_aup_b + l * 64 * 512;
    rw.kk = rwkv_kk + l * 512; rw.ka = rwkv_ka + l * 512; rw.rk = rwkv_rk + l * 512; rw.lng = rwkv_ln_g + l * 512; rw.lnb = rwkv_ln_b + l * 512;
    for (int gidx = 0; gidx < NGRP; ++gidx) {
      const int b0 = gidx * GB;
      hipLaunchKernelGGL(k_modnorm, dim3(1024), dim3(256), 0, stream, xlat_in, xctx_in, g_pre + l * 1024, modl, hbf, b0);
      { GemmArgs g{}; g.A = hbf; g.lda = DM; g.Bt = Wt_in + (size_t)l * DINP * 1024; g.K = 1024; g.N = DIN; g.Cb = P; g.ldc = LDP;
        hipLaunchKernelGGL(k_gemm<0>, dim3(DINP / 128, RG / 256), dim3(512), GEMM_SMEM, stream, g); }
      hipLaunchKernelGGL(k_attn_prep, dim3(2048), dim3(256), 0, stream, P, att_qnorm + l * 128, att_knorm + l * 128);
      hipLaunchKernelGGL(k_attn, dim3(GB * 64 + (l == 0 ? GB * 4 : 0)), dim3(512), att::SHM_ATTN, stream, (const u16*)P, Y);
      hipLaunchKernelGGL(k_gla_prep, dim3(2048), dim3(256), 0, stream, (const u16*)P, gla_wup_f + l * 16 * 256, gla_b_f + l * 256, gla_wup_b + l * 16 * 256, gla_b_b + l * 256, G);
      hipLaunchKernelGGL(k_gla_state, dim3(GB * 8), dim3(256), 65536, stream, (const u16*)P, (const float*)G, Sst);
      hipLaunchKernelGGL(k_gla_out, dim3(GB * 4 * 68), dim3(256), GLA_OUT_SMEM, stream, (const u16*)P, (const float*)G, (const float*)Sst, gla_norm + l * 512, Y);
      hipLaunchKernelGGL(k_rwkv_prep, dim3(2048), dim3(512), 0, stream, (const u16*)P, rw, RW);
      hipLaunchKernelGGL(k_rwkv_scan, dim3(GB * 16), dim3(256), 0, stream, (const float*)RW, yfb);
      hipLaunchKernelGGL(k_rwkv_final, dim3(2048), dim3(512), 0, stream, (const float*)RW, (const float*)yfb, rw, Y);
      for (int i = 0; i < 3; ++i) {
        GemmArgs g{}; g.A = Y + i * 512; g.lda = LDY; g.Bt = Wt_o + ((size_t)l * 3 + i) * 1024 * 512; g.K = 512; g.N = 1024;
        g.G = P + C_MG + i * 1024; g.ldg = LDP; g.m32 = m32; g.mbf = mbf; g.first = (i == 0); g.last = (i == 2);
        hipLaunchKernelGGL(k_gemm<2>, dim3(8, RG / 256), dim3(512), GEMM_SMEM, stream, g);
      }
      { GemmArgs g{}; g.A = mbf; g.lda = DM; g.Bt = Wt_out + (size_t)l * 1024 * 1024; g.K = 1024; g.N = 1024; g.Cf = m32; g.ldc = 1024;
        hipLaunchKernelGGL(k_gemm<1>, dim3(8, RG / 256), dim3(512), GEMM_SMEM, stream, g); }
      hipLaunchKernelGGL(k_final, dim3(1024), dim3(256), 0, stream, (const float*)m32, xlat_in, xctx_in, g_post + l * 1024, modl, out, (l == 0 ? xc1 : (float*)nullptr), b0);
    }
  }
}
```

```cpp
#include <hip/hip_runtime.h>
#include <hip/hip_bf16.h>
#include <hip/hip_cooperative_groups.h>
#include <stdint.h>
#include <cstdio>
namespace cg = cooperative_groups;

typedef unsigned short u16;
using bf16 = __hip_bfloat16;
using bf16x8 = __attribute__((ext_vector_type(8))) short;
using s16x4  = __attribute__((ext_vector_type(4))) short;
using f32x16 = __attribute__((ext_vector_type(16))) float;
using f32x8  = __attribute__((ext_vector_type(8))) float;
using u32x4  = __attribute__((ext_vector_type(4))) unsigned;

constexpr int NB = 16, T = 4096, TC = 256, SB = T + TC;
constexpr int R = NB * SB;
constexpr int DM = 1024, DIN = 8480, DINP = 8576;
constexpr int LDP = 5408;
constexpr int NT_P = 43;
constexpr int C_GQ = 0, C_GK = 256, C_GV = 512, C_GG = 1024, C_GWF = 1536;
constexpr int C_AQ = 1568, C_AK = 2080, C_AV = 2336, C_AG = 2592;
constexpr int C_RW = 3104;
constexpr int C_MG = 5408;
constexpr int C_HRE = C_AK;
constexpr int C_M = C_RW;
constexpr int SMEM_BYTES = 147456;

struct Params {
  const float *x, *c, *ctx, *c_ctx, *w_mod, *b_mod, *g_pre, *w_in, *gla_wup_f, *gla_b_f, *gla_wup_b, *gla_b_b, *gla_norm, *att_qnorm, *att_knorm,
      *rwkv_mu, *rwkv_w0_f, *rwkv_wup_f, *rwkv_w0_b, *rwkv_wup_b, *rwkv_a0_f, *rwkv_aup_f, *rwkv_a0_b, *rwkv_aup_b, *rwkv_kk, *rwkv_ka, *rwkv_rk,
      *rwkv_ln_g, *rwkv_ln_b, *w_o_gla, *w_o_att, *w_o_rwkv, *w_out, *g_post;
  float* out; u16* Wt_in; u16* Wt_o; u16* Wt_out; float* mod; float* bon; float* xc1; u16* SH; u16* P; unsigned* tmp;
  int p0, p1;
};
typedef const __attribute__((address_space(4))) Params* KParams;

__device__ __forceinline__ int tidx() { int t = threadIdx.x; asm volatile("" : "+v"(t)); return t; }
__device__ __forceinline__ float bf2f(u16 v) { return __uint_as_float(((unsigned)v) << 16); }
__device__ __forceinline__ u16 f2bf(float x) { unsigned u = __float_as_uint(x); u += 0x7fffu + ((u >> 16) & 1u); return (u16)(u >> 16); }
__device__ __forceinline__ float shfl_xor_f(float v, int m) { const int lane = tidx() & 63; return __builtin_bit_cast(float, __builtin_amdgcn_ds_bpermute((lane ^ m) << 2, __builtin_bit_cast(int, v))); }
__device__ __forceinline__ float wave_sum(float v) {
#pragma unroll
  for (int m = 32; m >= 1; m >>= 1) v += shfl_xor_f(v, m);
  return v;
}
__device__ __forceinline__ float sigmoidf_(float x) { return 1.f / (1.f + __expf(-x)); }
__device__ __forceinline__ float siluf_(float x) { return x / (1.f + __expf(-x)); }
__device__ __forceinline__ int crow(int r, int hi) { return (r & 3) + 8 * (r >> 2) + 4 * hi; }
__device__ __forceinline__ void unpack8(uint4 u, float* f) {
  f[0] = __uint_as_float(u.x << 16); f[1] = __uint_as_float(u.x & 0xffff0000u); f[2] = __uint_as_float(u.y << 16); f[3] = __uint_as_float(u.y & 0xffff0000u);
  f[4] = __uint_as_float(u.z << 16); f[5] = __uint_as_float(u.z & 0xffff0000u); f[6] = __uint_as_float(u.w << 16); f[7] = __uint_as_float(u.w & 0xffff0000u);
}
__device__ __forceinline__ unsigned pack2(float a, float b) { return (unsigned)f2bf(a) | ((unsigned)f2bf(b) << 16); }
template <int CTRL> __device__ __forceinline__ float dpp_f(float x) {
  return __builtin_bit_cast(float, __builtin_amdgcn_update_dpp(0, __builtin_bit_cast(int, x), CTRL, 0xF, 0xF, true));
}
__device__ __forceinline__ float red4(float x) { x += dpp_f<0xB1>(x); x += dpp_f<0x4E>(x); return x; }
__device__ __forceinline__ float red8(float x) { x = red4(x); x += shfl_xor_f(x, 4); return x; }

constexpr int GLS = 72;
constexpr int GEMM_SMEM = 2 * (256 * GLS + 128 * GLS) * 2;
__device__ __forceinline__ void gemm_kloop(const u16* __restrict__ A, int lda, const u16* __restrict__ Bt, int ldb, int K, char* smem, f32x16 (&acc)[2][2]) {
  u16* As = (u16*)smem; u16* Bs = As + 2 * 256 * GLS;
  const int tid = tidx(), wid = tid >> 6, lane = tid & 63, r32 = lane & 31, hi = lane >> 5;
  const int wm = wid >> 1, wn = wid & 1;
#pragma unroll
  for (int mi = 0; mi < 2; ++mi)
#pragma unroll
    for (int ni = 0; ni < 2; ++ni)
#pragma unroll
      for (int r = 0; r < 16; ++r) acc[mi][ni][r] = 0.f;
  uint4 ra0, ra1, ra2, ra3, rb0, rb1;
  const int nk = K / 64;
  const int lrow = tid >> 3, lkc = tid & 7;
  const u16* gA = A + (size_t)lrow * lda + lkc * 8;
  const u16* gB = Bt + (size_t)lrow * ldb + lkc * 8;
  const size_t sA = (size_t)64 * lda, sB = (size_t)64 * ldb;
  u16* wA = As + lrow * GLS + lkc * 8; u16* wB = Bs + lrow * GLS + lkc * 8;
#define GLOAD(kt) do { const u16* pa_ = gA + (kt) * 64; const u16* pb_ = gB + (kt) * 64; \
    ra0 = *(const uint4*)(pa_); ra1 = *(const uint4*)(pa_ + sA); ra2 = *(const uint4*)(pa_ + 2 * sA); ra3 = *(const uint4*)(pa_ + 3 * sA); \
    rb0 = *(const uint4*)(pb_); rb1 = *(const uint4*)(pb_ + sB); } while (0)
#define SWRITE(buf) do { u16* qa_ = wA + (buf) * 256 * GLS; u16* qb_ = wB + (buf) * 128 * GLS; \
    *(uint4*)(qa_) = ra0; *(uint4*)(qa_ + 64 * GLS) = ra1; *(uint4*)(qa_ + 128 * GLS) = ra2; *(uint4*)(qa_ + 192 * GLS) = ra3; \
    *(uint4*)(qb_) = rb0; *(uint4*)(qb_ + 64 * GLS) = rb1; } while (0)
  GLOAD(0); SWRITE(0); __syncthreads();
  for (int kt = 0; kt < nk; ++kt) {
    const int buf = kt & 1;
    if (kt + 1 < nk) GLOAD(kt + 1);
    const u16* Ab = As + buf * 256 * GLS + (wm * 64 + r32) * GLS + hi * 8;
    const u16* Bb = Bs + buf * 128 * GLS + (wn * 64 + r32) * GLS + hi * 8;
#pragma unroll
    for (int ks = 0; ks < 4; ++ks) {
      bf16x8 a0 = *(const bf16x8*)(Ab + ks * 16), a1 = *(const bf16x8*)(Ab + 32 * GLS + ks * 16);
      bf16x8 b0 = *(const bf16x8*)(Bb + ks * 16), b1 = *(const bf16x8*)(Bb + 32 * GLS + ks * 16);
      acc[0][0] = __builtin_amdgcn_mfma_f32_32x32x16_bf16(a0, b0, acc[0][0], 0, 0, 0);
      acc[0][1] = __builtin_amdgcn_mfma_f32_32x32x16_bf16(a0, b1, acc[0][1], 0, 0, 0);
      acc[1][0] = __builtin_amdgcn_mfma_f32_32x32x16_bf16(a1, b0, acc[1][0], 0, 0, 0);
      acc[1][1] = __builtin_amdgcn_mfma_f32_32x32x16_bf16(a1, b1, acc[1][1], 0, 0, 0);
    }
    if (kt + 1 < nk) SWRITE(buf ^ 1);
    __syncthreads();
  }
#undef GLOAD
#undef SWRITE
}
__device__ __forceinline__ void store_tile_bf16(const f32x16 (&acc)[2][2], u16* __restrict__ C, int ldc, int ncols) {
  const int wid = tidx() >> 6, lane = tidx() & 63, r32 = lane & 31, hi = lane >> 5, wm = wid >> 1, wn = wid & 1;
#pragma unroll
  for (int mi = 0; mi < 2; ++mi)
#pragma unroll
    for (int ni = 0; ni < 2; ++ni) {
      const int col = wn * 64 + ni * 32 + r32;
      if (col < ncols) {
#pragma unroll
        for (int r = 0; r < 16; ++r) C[(size_t)(wm * 64 + mi * 32 + crow(r, hi)) * ldc + col] = f2bf(acc[mi][ni][r]);
      }
    }
}

namespace att {
constexpr int D = 128, NW = 8, QBLK = 32, KVBLK = 64;
constexpr float SCALE = 0.088388347648318440f;
constexpr float THR = 8.f;
constexpr int LDQ = LDP, LDK = LDP;
constexpr size_t SHM_V = KVBLK * D * 2, SHM_K = KVBLK * D * 2, SHM_ATTN = 2 * SHM_V + 2 * SHM_K + NW * 64 * 4;
#define KSWZ(row, colB) ((row) * 256 + ((colB) ^ (((row) & 7) << 4)))
#define SBAR() __builtin_amdgcn_sched_barrier(0)
__device__ __forceinline__ unsigned cvtpk(float lo, float hi) {
  unsigned r; asm volatile("v_cvt_pk_bf16_f32 %0, %1, %2" : "=v"(r) : "v"(lo), "v"(hi)); return r;
}
__device__ __forceinline__ bf16x8 ld8(const bf16* p) { return *reinterpret_cast<const bf16x8*>(p); }
__device__ __forceinline__ void partialSM(f32x16& p0, f32x16& p1, float& m_reg, float& mn, float& alpha) {
  constexpr float C = SCALE * 1.4426950408889634f;
  float pmax = p0[0]; for (int r = 1; r < 16; ++r) pmax = fmaxf(pmax, p0[r]); for (int r = 0; r < 16; ++r) pmax = fmaxf(pmax, p1[r]);
  { auto rr = __builtin_amdgcn_permlane32_swap(__float_as_uint(pmax), __float_as_uint(pmax), false, false);
    pmax = fmaxf(__uint_as_float(rr[0]), __uint_as_float(rr[1])); }
  if (__builtin_expect(__all(pmax - m_reg <= THR / SCALE), 1)) { mn = m_reg; alpha = 1.f; }
  else { mn = fmaxf(m_reg, pmax); alpha = __builtin_amdgcn_exp2f((m_reg - mn) * C); m_reg = mn; }
  float mnC = -mn * C;
  for (int r = 0; r < 16; ++r) p0[r] = fmaf(p0[r], C, mnC); for (int r = 0; r < 16; ++r) p1[r] = fmaf(p1[r], C, mnC);
  for (int r = 0; r < 16; ++r) p0[r] = __builtin_amdgcn_exp2f(p0[r]);
}
__device__ __forceinline__ void finishSM(f32x16& p0, f32x16& p1, float alpha, float& l_reg, bf16x8& pa0, bf16x8& pa1, bf16x8& pa2, bf16x8& pa3) {
  for (int r = 0; r < 16; ++r) p1[r] = __builtin_amdgcn_exp2f(p1[r]);
  float ps = 0; for (int r = 0; r < 16; ++r) ps += p0[r]; for (int r = 0; r < 16; ++r) ps += p1[r];
  { auto rr = __builtin_amdgcn_permlane32_swap(__float_as_uint(ps), __float_as_uint(ps), false, false);
    ps = __uint_as_float(rr[0]) + __uint_as_float(rr[1]); }
  l_reg = l_reg * alpha + ps;
#define PK4(P, BASE, OUT) do { unsigned a0 = cvtpk(P[BASE + 0], P[BASE + 1]), a1 = cvtpk(P[BASE + 2], P[BASE + 3]);   \
    unsigned b0 = cvtpk(P[BASE + 4], P[BASE + 5]), b1 = cvtpk(P[BASE + 6], P[BASE + 7]);                              \
    auto r0 = __builtin_amdgcn_permlane32_swap(a0, b0, false, false); auto r1 = __builtin_amdgcn_permlane32_swap(a1, b1, false, false); \
    u32x4 w = {r0[0], r1[0], r0[1], r1[1]}; OUT = *reinterpret_cast<bf16x8*>(&w); } while (0)
  PK4(p0, 0, pa0); PK4(p0, 8, pa1); PK4(p1, 0, pa2); PK4(p1, 8, pa3);
#undef PK4
}
__device__ __forceinline__ void qkt(f32x16& p0, f32x16& p1, const bf16* Ks, const bf16x8* qr, int r32, int hi) {
  p0 = f32x16{}; p1 = f32x16{};
  for (int d0 = 0; d0 < 8; ++d0) { int cb = (d0 * 16 + hi * 8) * 2;
    bf16x8 b0 = *reinterpret_cast<const bf16x8*>((const char*)Ks + KSWZ(r32, cb));
    bf16x8 b1 = *reinterpret_cast<const bf16x8*>((const char*)Ks + KSWZ(32 + r32, cb));
    p0 = __builtin_amdgcn_mfma_f32_32x32x16_bf16(b0, qr[d0], p0, 0, 0, 0);
    p1 = __builtin_amdgcn_mfma_f32_32x32x16_bf16(b1, qr[d0], p1, 0, 0, 0); }
}
__device__ __forceinline__ int v_st(int k, int c) { const int kk = (k & ~0xC) | ((k & 4) << 1) | ((k & 8) >> 1); return ((kk >> 3) * 4 + (c >> 5)) * 512 + ((kk & 7) * 32 + (c & 31)) * 2; }
__device__ __forceinline__ int v_rd_base(int lane) { return ((lane & 3) << 3) | (((lane >> 2) & 3) << 6) | (((lane >> 4) & 1) << 5) | (((lane >> 5) & 1) << 8); }
constexpr int v_rd_off(int d0, int ks, int half) { return d0 * 512 + ks * 4096 + half * 2048; }
template <int OFF> __device__ __forceinline__ s16x4 tr_read(int vb) {
  s16x4 r; asm volatile("ds_read_b64_tr_b16 %0, %1 offset:%2" : "=&v"(r) : "v"(vb), "i"(OFF) : "memory"); return r;
}
template <int D0> __device__ __forceinline__ void pv_one(f32x16& od, int vb, bf16x8 pa0, bf16x8 pa1, bf16x8 pa2, bf16x8 pa3) {
  const s16x4 l0 = tr_read<v_rd_off(D0, 0, 0)>(vb), h0 = tr_read<v_rd_off(D0, 0, 1)>(vb), l1 = tr_read<v_rd_off(D0, 1, 0)>(vb), h1 = tr_read<v_rd_off(D0, 1, 1)>(vb);
  const s16x4 l2 = tr_read<v_rd_off(D0, 2, 0)>(vb), h2 = tr_read<v_rd_off(D0, 2, 1)>(vb), l3 = tr_read<v_rd_off(D0, 3, 0)>(vb), h3 = tr_read<v_rd_off(D0, 3, 1)>(vb);
  asm volatile("s_waitcnt lgkmcnt(0)" ::: "memory"); SBAR();
#define PK(L, H) (bf16x8){L[0], L[1], L[2], L[3], H[0], H[1], H[2], H[3]}
  od = __builtin_amdgcn_mfma_f32_32x32x16_bf16(pa0, PK(l0, h0), od, 0, 0, 0);
  od = __builtin_amdgcn_mfma_f32_32x32x16_bf16(pa1, PK(l1, h1), od, 0, 0, 0);
  od = __builtin_amdgcn_mfma_f32_32x32x16_bf16(pa2, PK(l2, h2), od, 0, 0, 0);
  od = __builtin_amdgcn_mfma_f32_32x32x16_bf16(pa3, PK(l3, h3), od, 0, 0, 0);
#undef PK
}
__device__ __forceinline__ void pv_d0(f32x16* o, int vb, bf16x8 pa0, bf16x8 pa1, bf16x8 pa2, bf16x8 pa3) {
  pv_one<0>(o[0], vb, pa0, pa1, pa2, pa3); pv_one<1>(o[1], vb, pa0, pa1, pa2, pa3); pv_one<2>(o[2], vb, pa0, pa1, pa2, pa3); pv_one<3>(o[3], vb, pa0, pa1, pa2, pa3);
}
__device__ __forceinline__ void attn_dense_body(const bf16* Qb, const bf16* __restrict__ Kh, const bf16* __restrict__ Vh,
                                                const u16* __restrict__ Gb, u16* Yb, int seq, char* lds) {
  const int tid = tidx(), wid = tid >> 6, lane = tid & 63, r32 = lane & 31, hi = lane >> 5;
  bf16* V_lds = (bf16*)lds; bf16* K_lds = (bf16*)(lds + 2 * SHM_V);
  float* ws = (float*)(lds + 2 * SHM_V + 2 * SHM_K) + wid * 64; float* li_l = ws; float* al_l = ws + 32;
  float m_reg = -1e30f, l_reg = 0; f32x16 o[4] = {}; bf16x8 qr[8];
  const bf16* Qw = Qb + (long)(wid * QBLK + r32) * LDQ + hi * 8;
#pragma unroll
  for (int d0 = 0; d0 < 8; ++d0) qr[d0] = ld8(Qw + d0 * 16);
  const int sr = tid >> 4, sc = (tid & 15) * 8, vst0 = v_st(sr, sc), vst1 = v_st(32 + sr, sc);
  const int vb0 = (int)(uintptr_t)V_lds + v_rd_base(lane);
  struct { bf16x8 vs0, vs1, ks0, ks1; } sr_[2];
#define SLOAD(i, k0) do { sr_[i].vs0 = ld8(&Vh[(long)((k0) + sr) * LDK + sc]); sr_[i].vs1 = ld8(&Vh[(long)((k0) + 32 + sr) * LDK + sc]); \
    sr_[i].ks0 = ld8(&Kh[(long)((k0) + sr) * LDK + sc]); sr_[i].ks1 = ld8(&Kh[(long)((k0) + 32 + sr) * LDK + sc]); } while (0)
#define SWRITE(b, i) do { *(bf16x8*)((char*)V_lds + (b) * SHM_V + vst0) = sr_[i].vs0;          \
    *(bf16x8*)((char*)V_lds + (b) * SHM_V + vst1) = sr_[i].vs1; int kc = sc * 2;               \
    *(bf16x8*)((char*)K_lds + (b) * SHM_K + KSWZ(sr, kc)) = sr_[i].ks0;                       \
    *(bf16x8*)((char*)K_lds + (b) * SHM_K + KSWZ(32 + sr, kc)) = sr_[i].ks1; } while (0)
#define SWAIT() do { asm volatile("s_waitcnt vmcnt(4)" ::: "memory"); } while (0)
#define RESC(a) do { if (__any((a) < 1.f)) { if (hi == 0) al_l[r32] = (a); asm volatile("s_waitcnt lgkmcnt(0)" ::: "memory"); \
    for (int d = 0; d < 4; ++d) for (int r = 0; r < 16; ++r) o[d][r] *= al_l[crow(r, hi)]; } } while (0)
  f32x16 pA0, pA1, pB0, pB1; float mnA, mnB, alA, alB; bf16x8 pa0, pa1, pa2, pa3; const int NT = seq / KVBLK;
  constexpr int SE = 0, SO = 1;
  SLOAD(SE, 0); asm volatile("s_waitcnt vmcnt(0)" ::: "memory"); SWRITE(0, SE); __syncthreads();
  qkt(pA0, pA1, K_lds, qr, r32, hi); partialSM(pA0, pA1, m_reg, mnA, alA);
  SLOAD(SO, KVBLK); if (2 < NT) SLOAD(SE, 2 * KVBLK);
  SWAIT(); SWRITE(1, SO); __syncthreads();
  for (int j = 1; j + 1 < NT; j += 2) {
    SBAR(); qkt(pB0, pB1, (bf16*)((char*)K_lds + SHM_K), qr, r32, hi);
    finishSM(pA0, pA1, alA, l_reg, pa0, pa1, pa2, pa3); SBAR();
    SLOAD(SO, (j + 2) * KVBLK); SBAR();
    pv_d0(o, vb0, pa0, pa1, pa2, pa3); partialSM(pB0, pB1, m_reg, mnB, alB);
    __syncthreads(); SWAIT(); SWRITE(0, SE);
    RESC(alB); __syncthreads();
    SBAR(); qkt(pA0, pA1, K_lds, qr, r32, hi);
    finishSM(pB0, pB1, alB, l_reg, pa0, pa1, pa2, pa3); SBAR();
    if (j + 3 < NT) SLOAD(SE, (j + 3) * KVBLK); SBAR();
    pv_d0(o, vb0 + (int)SHM_V, pa0, pa1, pa2, pa3); partialSM(pA0, pA1, m_reg, mnA, alA);
    __syncthreads(); SWAIT(); SWRITE(1, SO);
    RESC(alA); __syncthreads();
  }
  SBAR(); qkt(pB0, pB1, (bf16*)((char*)K_lds + SHM_K), qr, r32, hi);
  finishSM(pA0, pA1, alA, l_reg, pa0, pa1, pa2, pa3); SBAR();
  pv_d0(o, vb0, pa0, pa1, pa2, pa3); partialSM(pB0, pB1, m_reg, mnB, alB);
  __syncthreads(); RESC(alB);
  finishSM(pB0, pB1, alB, l_reg, pa0, pa1, pa2, pa3); SBAR();
  pv_d0(o, vb0 + (int)SHM_V, pa0, pa1, pa2, pa3);
  if (hi == 0) li_l[r32] = l_reg; asm volatile("s_waitcnt lgkmcnt(0)" ::: "memory");
  float rli[16];
#pragma unroll
  for (int r = 0; r < 16; ++r) rli[r] = __builtin_amdgcn_rcpf(li_l[crow(r, hi)]);
#pragma unroll
  for (int r = 0; r < 16; ++r) { const long orow = wid * QBLK + crow(r, hi);
#pragma unroll
    for (int d0 = 0; d0 < 4; ++d0) {
      const float gt = bf2f(Gb[orow * LDQ + d0 * 32 + r32]);
      Yb[orow * LDQ + d0 * 32 + r32] = f2bf(o[d0][r] * rli[r] * siluf_(gt));
    } }
  __syncthreads();
#undef SLOAD
#undef SWRITE
#undef SWAIT
#undef RESC
}
}

__device__ __forceinline__ const float* xrow_ptr(KParams p, int l, int r) {
  const int b = r / SB, s = r % SB;
  if (s < T) return (l == 0 ? p->x : (const float*)p->out) + ((size_t)b * T + s) * DM;
  return (l == 0 ? p->ctx : (const float*)p->xc1) + ((size_t)b * TC + (s - T)) * DM;
}
__device__ __forceinline__ void hrow_write(const float4 (&v)[4], const float* __restrict__ g_pre, const float* __restrict__ md, u16* dst, int lane) {
  float ss = 0.f;
#pragma unroll
  for (int i = 0; i < 4; ++i) ss += v[i].x * v[i].x + v[i].y * v[i].y + v[i].z * v[i].z + v[i].w * v[i].w;
  ss = wave_sum(ss);
  const float rstd = rsqrtf(ss * (1.f / 1024.f) + 1e-6f);
#pragma unroll
  for (int i = 0; i < 4; ++i) {
    const int col = i * 256 + lane * 4;
    const float4 g = *(const float4*)(g_pre + col), sc = *(const float4*)(md + 1024 + col), sh = *(const float4*)(md + col);
    ushort4 o;
    o.x = f2bf(v[i].x * rstd * g.x * (1.f + sc.x) + sh.x); o.y = f2bf(v[i].y * rstd * g.y * (1.f + sc.y) + sh.y);
    o.z = f2bf(v[i].z * rstd * g.z * (1.f + sc.z) + sh.z); o.w = f2bf(v[i].w * rstd * g.w * (1.f + sc.w) + sh.w);
    *(ushort4*)(dst + col) = o;
  }
}

__device__ __forceinline__ void transpose_tile(const float* __restrict__ src, u16* __restrict__ dst, int K, int N, int nt, int kt, char* smem) {
  float* tile = (float*)smem;
  const int n0 = nt * 64, k0 = kt * 64, tx = tidx() & 63, ty = tidx() >> 6;
  __syncthreads();
#pragma unroll
  for (int i = 0; i < 8; ++i) { const int k = i * 8 + ty, n = n0 + tx; tile[k * 65 + tx] = (n < N) ? src[(size_t)(k0 + k) * N + n] : 0.f; }
  __syncthreads();
#pragma unroll
  for (int i = 0; i < 8; ++i) { const int n = i * 8 + ty; dst[(size_t)(n0 + n) * K + k0 + tx] = f2bf(tile[tx * 65 + n]); }
}
__device__ __forceinline__ void mod_item(KParams p, int item, char* smem) {
  float* sc = (float*)smem;
  float* red = sc + 17 * 512;
  const int l = item / 48, cgp = item % 48, tid = tidx(), kg = tid >> 6, jl = tid & 63, j = cgp * 64 + jl;
  const float* W = p->w_mod + (size_t)l * 1024 * 3072;
  float acc[17];
#pragma unroll
  for (int i = 0; i < 17; ++i) acc[i] = 0.f;
  for (int half = 0; half < 2; ++half) {
    __syncthreads();
    for (int e = tid; e < 17 * 512; e += 512) { const int i = e >> 9, k = e & 511; const float v = (i < 16) ? p->c[i * 1024 + half * 512 + k] : p->c_ctx[half * 512 + k]; sc[e] = siluf_(v); }
    __syncthreads();
    for (int kk = 0; kk < 64; ++kk) {
      const int k = kg * 64 + kk;
      const float w = W[(size_t)(half * 512 + k) * 3072 + j];
#pragma unroll
      for (int i = 0; i < 17; ++i) acc[i] += sc[i * 512 + k] * w;
    }
  }
#pragma unroll
  for (int i = 0; i < 17; ++i) red[(kg * 17 + i) * 64 + jl] = acc[i];
  __syncthreads();
  for (int e = tid; e < 17 * 64; e += 512) { const int i = e >> 6, jj = e & 63;
    float v = p->b_mod[l * 3072 + cgp * 64 + jj];
#pragma unroll
    for (int g = 0; g < 8; ++g) v += red[(g * 17 + i) * 64 + jj];
    p->mod[((size_t)l * 17 + i) * 3072 + cgp * 64 + jj] = v; }
}
__device__ __forceinline__ void phase_prologue(KParams p, char* smem) {
  constexpr int N_IN = 2 * 134 * 16, N_O = 2 * 3 * 16 * 8, N_OUT = 2 * 16 * 16, N_MOD = 96;
  for (int it = blockIdx.x; it < N_IN + N_O + N_OUT + N_MOD; it += gridDim.x) {
    if (it < N_MOD) mod_item(p, it, smem);
    else if (it < N_MOD + N_IN) { const int u = it - N_MOD, l = u / (134 * 16), v = u % (134 * 16);
      transpose_tile(p->w_in + (size_t)l * 1024 * DIN, p->Wt_in + (size_t)l * DINP * 1024, 1024, DIN, v % 134, v / 134, smem); }
    else if (it < N_MOD + N_IN + N_O) { const int u = it - N_MOD - N_IN, li = u / 128, v = u % 128, l = li / 3, i = li % 3;
      const float* src = (i == 0 ? p->w_o_gla : i == 1 ? p->w_o_att : p->w_o_rwkv) + (size_t)l * 512 * 1024;
      transpose_tile(src, p->Wt_o + (size_t)li * 1024 * 512, 512, 1024, v % 16, v / 16, smem); }
    else { const int u = it - N_MOD - N_IN - N_O, l = u / 256, v = u % 256;
      transpose_tile(p->w_out + (size_t)l * 1024 * 1024, p->Wt_out + (size_t)l * 1024 * 1024, 1024, 1024, v % 16, v / 16, smem); }
  }
}

__device__ __forceinline__ void phase_a0(KParams p) {
  const int wid = tidx() >> 6, lane = tidx() & 63;
  for (int r = blockIdx.x * 8 + wid; r < R; r += gridDim.x * 8) {
    const int b = r / SB, s = r % SB;
    const float* src = xrow_ptr(p, 0, r);
    float4 v[4];
#pragma unroll
    for (int i = 0; i < 4; ++i) v[i] = *(const float4*)(src + i * 256 + lane * 4);
    hrow_write(v, p->g_pre, p->mod + (size_t)((s < T) ? b : 16) * 3072, p->SH + (size_t)r * 1024, lane);
  }
}
__device__ __forceinline__ void phase_a1(KParams p, int l, char* smem) {
  const u16* W = p->Wt_in + (size_t)l * DINP * 1024;
  for (int t = blockIdx.x; t < (R / 256) * NT_P; t += gridDim.x) {
    const int mt = t / NT_P, nt = t % NT_P;
    f32x16 acc[2][2];
    gemm_kloop(p->SH + (size_t)mt * 256 * 1024, 1024, W + (size_t)nt * 128 * 1024, 1024, 1024, smem, acc);
    store_tile_bf16(acc, p->P + (size_t)mt * 256 * LDP + nt * 128, LDP, LDP - nt * 128);
  }
}

__device__ __forceinline__ void attn_prep_all(KParams p, int l) {
  const float* qn = p->att_qnorm + l * 128; const float* kn = p->att_knorm + l * 128;
  const int wid = tidx() >> 6, lane = tidx() & 63;
  const int i = lane & 31, half = lane >> 5;
  const float inv = exp2f(-(float)i * (13.287712379549449f / 32.f));
  const int d1 = half * 64 + i, d2 = d1 + 32;
  for (long item = (long)blockIdx.x * 8 + wid; item < (long)R * 6; item += (long)gridDim.x * 8) {
    const int r = (int)(item / 6), hh = (int)(item % 6), s = r % SB;
    const int col = (hh < 4) ? C_AQ + hh * 128 : C_AK + (hh - 4) * 128;
    const float* gw = (hh < 4) ? qn : kn;
    u16* pp = p->P + (size_t)r * LDP + col;
    float u1 = bf2f(pp[d1]), u2 = bf2f(pp[d2]);
    const float ss = wave_sum(u1 * u1 + u2 * u2);
    const float rstd = rsqrtf(ss * (1.f / 128.f) + 1e-6f);
    u1 *= rstd * gw[d1]; u2 *= rstd * gw[d2];
    if (s < T) {
      const float pos = half ? (float)(s & 63) : (float)(s >> 6);
      const float ang = pos * inv;
      const float cs = __cosf(ang), sn = __sinf(ang);
      const float o1 = u1 * cs - u2 * sn, o2 = u2 * cs + u1 * sn;
      u1 = o1; u2 = o2;
    }
    pp[d1] = f2bf(u1); pp[d2] = f2bf(u2);
  }
}

__device__ __forceinline__ float logsig16(float x) { return (fminf(x, 0.f) - log1pf(__expf(-fabsf(x)))) * (1.f / 16.f); }
__device__ __forceinline__ void gla_state_unit(KParams p, int l, int unit, char* smem) {
  const int eh = unit & 1, dir = (unit >> 1) & 1, h = (unit >> 2) & 3, b = unit >> 4;
  float* kt = (float*)smem; float* vs = kt + 4096; float* gc = vs + 4096; float* lr = gc + 4096; float* wu = lr + 1024; float* bb = wu + 1024;
  const int tid = tidx(), d = tid >> 3, eq = tid & 7;
  const float* wup = (dir ? p->gla_wup_b : p->gla_wup_f) + l * 16 * 256; const float* bia = (dir ? p->gla_b_b : p->gla_b_f) + l * 256;
  __syncthreads();
  for (int e = tid; e < 1024; e += 512) wu[e] = wup[(e >> 6) * 256 + h * 64 + (e & 63)];
  if (tid < 64) bb[tid] = bia[h * 64 + tid];
  float S[8];
#pragma unroll
  for (int j = 0; j < 8; ++j) S[j] = 0.f;
  for (int pi = 0; pi < 68; ++pi) {
    const int base = dir == 0 ? (pi < 4 ? T + 64 * pi : 64 * (pi - 4)) : (pi < 4 ? T + 64 * (3 - pi) : 64 * (67 - pi));
    const int cid = base >> 6;
    const u16* Pr = p->P + (size_t)(b * SB + base) * LDP;
    __syncthreads();
    { const int c = tid >> 3, v8 = tid & 7;
      unpack8(*(const uint4*)(Pr + (size_t)c * LDP + C_GK + h * 64 + v8 * 8), kt + c * 64 + v8 * 8);
      unpack8(*(const uint4*)(Pr + (size_t)c * LDP + C_GV + h * 128 + eh * 64 + v8 * 8), vs + c * 64 + v8 * 8);
      if (tid < 128) { const int c2 = tid >> 1, hf = tid & 1; unpack8(*(const uint4*)(Pr + (size_t)c2 * LDP + C_GWF + dir * 16 + hf * 8), lr + c2 * 16 + hf * 8); } }
    __syncthreads();
#pragma unroll
    for (int it = 0; it < 8; ++it) { const int c = (tid >> 6) + 8 * it, dd = tid & 63;
      float x = bb[dd];
#pragma unroll
      for (int i = 0; i < 16; ++i) x += lr[c * 16 + i] * wu[i * 64 + dd];
      gc[c * 64 + dd] = logsig16(x); }
    __syncthreads();
    if (tid < 64) { float run = 0.f; for (int i = 0; i < 64; ++i) { const int c = dir ? 63 - i : i; run += gc[c * 64 + tid]; gc[c * 64 + tid] = run; } }
    __syncthreads();
    const int lastc = dir ? 0 : 63;
#pragma unroll
    for (int it = 0; it < 8; ++it) { const int e = tid + it * 512; kt[e] *= __expf(gc[lastc * 64 + (e & 63)] - gc[e]); }
    __syncthreads();
    u16* dst = p->SH + ((((size_t)(b * 4 + h) * 2 + dir) * 68 + cid) * 64 + d) * 128 + eh * 64 + eq * 8;
    uint4 o; o.x = pack2(S[0], S[1]); o.y = pack2(S[2], S[3]); o.z = pack2(S[4], S[5]); o.w = pack2(S[6], S[7]);
    *(uint4*)dst = o;
    const float dec = __expf(gc[lastc * 64 + d]);
#pragma unroll
    for (int j = 0; j < 8; ++j) S[j] *= dec;
    for (int s = 0; s < 64; ++s) {
      const float kv = kt[s * 64 + d];
      const float4 va = *(const float4*)(vs + s * 64 + eq * 8), vb = *(const float4*)(vs + s * 64 + eq * 8 + 4);
      S[0] += kv * va.x; S[1] += kv * va.y; S[2] += kv * va.z; S[3] += kv * va.w; S[4] += kv * vb.x; S[5] += kv * vb.y; S[6] += kv * vb.z; S[7] += kv * vb.w;
    }
  }
}
constexpr int GLQ = 68;
__device__ __forceinline__ void gla_out_tile(KParams p, int l, int b, int h, int cid, char* smem) {
  float* qdf = (float*)smem; float* kif = qdf + 64 * GLQ; float* qdb = kif + 64 * GLQ; float* kib = qdb + 64 * GLQ;
  float* vs = kib + 64 * GLQ; float* Am = vs + 64 * 128; float* lr = Am + 64 * 65; float* wuf = lr + 64 * 32; float* wub = wuf + 1024; float* bfb = wub + 1024;
  const int tid = tidx();
  u16* Pr = p->P + (size_t)(b * SB + cid * 64) * LDP;
  __syncthreads();
  for (int e = tid; e < 1024; e += 512) { wuf[e] = p->gla_wup_f[l * 4096 + (e >> 6) * 256 + h * 64 + (e & 63)]; wub[e] = p->gla_wup_b[l * 4096 + (e >> 6) * 256 + h * 64 + (e & 63)]; }
  if (tid < 64) bfb[tid] = p->gla_b_f[l * 256 + h * 64 + tid]; else if (tid < 128) bfb[tid] = p->gla_b_b[l * 256 + h * 64 + tid - 64];
  if (tid < 256) { const int c = tid >> 2, q4 = tid & 3; unpack8(*(const uint4*)(Pr + (size_t)c * LDP + C_GWF + q4 * 8), lr + c * 32 + q4 * 8); }
#pragma unroll
  for (int it = 0; it < 2; ++it) { const int e = tid + it * 512, c = e >> 4, v8 = e & 15; unpack8(*(const uint4*)(Pr + (size_t)c * LDP + C_GV + h * 128 + v8 * 8), vs + c * 128 + v8 * 8); }
  __syncthreads();
#pragma unroll
  for (int it = 0; it < 8; ++it) { const int c = (tid >> 6) + 8 * it, dd = tid & 63;
    float xf = bfb[dd], xb = bfb[64 + dd];
#pragma unroll
    for (int i = 0; i < 16; ++i) { xf += lr[c * 32 + i] * wuf[i * 64 + dd]; xb += lr[c * 32 + 16 + i] * wub[i * 64 + dd]; }
    kif[c * GLQ + dd] = logsig16(xf); kib[c * GLQ + dd] = logsig16(xb); }
  __syncthreads();
  if (tid < 64) { float run = 0.f; for (int c = 0; c < 64; ++c) { run += kif[c * GLQ + tid]; kif[c * GLQ + tid] = run; } }
  else if (tid < 128) { const int dd = tid - 64; float run = 0.f; for (int c = 63; c >= 0; --c) { run += kib[c * GLQ + dd]; kib[c * GLQ + dd] = run; } }
  __syncthreads();
  { const int c = tid >> 3, v8 = tid & 7; float qv[8], kv[8];
    unpack8(*(const uint4*)(Pr + (size_t)c * LDP + C_GQ + h * 64 + v8 * 8), qv); unpack8(*(const uint4*)(Pr + (size_t)c * LDP + C_GK + h * 64 + v8 * 8), kv);
#pragma unroll
    for (int j = 0; j < 8; ++j) { const int o = c * GLQ + v8 * 8 + j; const float gf = kif[o], gb = kib[o], q = qv[j] * 0.125f;
      qdf[o] = q * __expf(gf); kif[o] = kv[j] * __expf(-gf); qdb[o] = q * __expf(gb); kib[o] = kv[j] * __expf(-gb); } }
  __syncthreads();
  const int c = tid >> 3, sq = tid & 7;
  {
    float af[8], ab[8];
#pragma unroll
    for (int i = 0; i < 8; ++i) { af[i] = 0.f; ab[i] = 0.f; }
    for (int d4 = 0; d4 < 16; ++d4) {
      const float4 qf = *(const float4*)(qdf + c * GLQ + d4 * 4), qb = *(const float4*)(qdb + c * GLQ + d4 * 4);
#pragma unroll
      for (int i = 0; i < 8; ++i) { const int s = sq + 8 * i;
        const float4 kf = *(const float4*)(kif + s * GLQ + d4 * 4), kb = *(const float4*)(kib + s * GLQ + d4 * 4);
        af[i] += qf.x * kf.x + qf.y * kf.y + qf.z * kf.z + qf.w * kf.w;
        ab[i] += qb.x * kb.x + qb.y * kb.y + qb.z * kb.z + qb.w * kb.w; }
    }
#pragma unroll
    for (int i = 0; i < 8; ++i) { const int s = sq + 8 * i; Am[c * 65 + s] = (s <= c ? af[i] : 0.f) + (s >= c ? ab[i] : 0.f); }
  }
  __syncthreads();
  float acc[16];
#pragma unroll
  for (int j = 0; j < 16; ++j) acc[j] = 0.f;
  const int e0 = sq * 16;
  for (int s = 0; s < 64; ++s) {
    const float a = Am[c * 65 + s]; const float* vp = vs + s * 128 + e0;
#pragma unroll
    for (int j = 0; j < 16; j += 4) { const float4 v4 = *(const float4*)(vp + j); acc[j] += a * v4.x; acc[j + 1] += a * v4.y; acc[j + 2] += a * v4.z; acc[j + 3] += a * v4.w; }
  }
  const u16* Sf = p->SH + ((((size_t)(b * 4 + h) * 2 + 0) * 68 + cid) * 64) * 128 + e0;
  const u16* Sb = p->SH + ((((size_t)(b * 4 + h) * 2 + 1) * 68 + cid) * 64) * 128 + e0;
  for (int d = 0; d < 64; ++d) {
    const float qf = qdf[c * GLQ + d], qb = qdb[c * GLQ + d];
    float sf[16], sb[16];
    unpack8(*(const uint4*)(Sf + d * 128), sf); unpack8(*(const uint4*)(Sf + d * 128 + 8), sf + 8);
    unpack8(*(const uint4*)(Sb + d * 128), sb); unpack8(*(const uint4*)(Sb + d * 128 + 8), sb + 8);
#pragma unroll
    for (int j = 0; j < 16; ++j) acc[j] += qf * sf[j] + qb * sb[j];
  }
  float ss = 0.f;
#pragma unroll
  for (int j = 0; j < 16; ++j) ss += acc[j] * acc[j];
  ss = red8(ss);
  const float rstd = rsqrtf(ss * (1.f / 128.f) + 1e-6f);
  float gt[16];
  unpack8(*(const uint4*)(Pr + (size_t)c * LDP + C_GG + h * 128 + e0), gt); unpack8(*(const uint4*)(Pr + (size_t)c * LDP + C_GG + h * 128 + e0 + 8), gt + 8);
  const float* gn = p->gla_norm + l * 512 + h * 128 + e0;
  unsigned ow[8];
#pragma unroll
  for (int j = 0; j < 16; j += 2) ow[j >> 1] = pack2(acc[j] * rstd * gn[j] * siluf_(gt[j]), acc[j + 1] * rstd * gn[j + 1] * siluf_(gt[j + 1]));
  u16* dst = Pr + (size_t)c * LDP + C_GV + h * 128 + e0;
  *(uint4*)dst = make_uint4(ow[0], ow[1], ow[2], ow[3]); *(uint4*)(dst + 8) = make_uint4(ow[4], ow[5], ow[6], ow[7]);
}

constexpr int RCH = 32;
__device__ __forceinline__ void rwkv_scan_unit(KParams p, int l, int unit, char* smem) {
  const int dir = unit & 1, h = (unit >> 1) & 7, b = unit >> 4;
  const int tid = tidx(), wid = tid >> 6, lane = tid & 63;
  u16* raw = (u16*)smem;
  float* sR = (float*)(smem + 21760); float* sK = sR + 2048; float* sV = sK + 2048; float* sW = sV + 2048; float* sA = sW + 2048; float* sKK = sA + 2048; float* sY = sKK + 2048;
  u16* tTW = (u16*)(smem + 21760 + 7 * 8192); u16* tAD = tTW + 32 * 72; u16* wupT = tAD + 32 * 72; u16* aupT = wupT + 64 * 72;
  const float* mu = p->rwkv_mu + l * 2304;
  const float* wup = (dir ? p->rwkv_wup_b : p->rwkv_wup_f) + l * 64 * 512; const float* aup = (dir ? p->rwkv_aup_b : p->rwkv_aup_f) + l * 64 * 512;
  const float* w0 = (dir ? p->rwkv_w0_b : p->rwkv_w0_f) + l * 512 + h * 64; const float* a0 = (dir ? p->rwkv_a0_b : p->rwkv_a0_f) + l * 512 + h * 64;
  const float* kkw = p->rwkv_kk + l * 512 + h * 64; const float* kaw = p->rwkv_ka + l * 512 + h * 64; const float* rkw = p->rwkv_rk + l * 512 + h * 64;
  __syncthreads();
  for (int e = tid; e < 4096; e += 512) { const int n = e & 63, i = e >> 6; wupT[n * 72 + i] = f2bf(wup[i * 512 + h * 64 + n]); aupT[n * 72 + i] = f2bf(aup[i * 512 + h * 64 + n]); }
  const int vrow = tid >> 3, q = tid & 7;
  float S[8];
#pragma unroll
  for (int j = 0; j < 8; ++j) S[j] = 0.f;
  for (int seg = 0; seg < 2; ++seg) {
    const int base = seg == 0 ? T : 0, len = seg == 0 ? TC : T;
    for (int ci = 0; ci < len / RCH; ++ci) {
      const int t0 = dir ? base + len - (ci + 1) * RCH : base + ci * RCH;
      const size_t row0 = (size_t)b * SB + t0;
      __syncthreads();
      for (int e = tid; e < 34 * 40; e += 512) { const int rr = e / 40, v = e % 40, gidx = v >> 3, v8 = v & 7; const int t = t0 - 1 + rr;
        const int gcol = (gidx == 0 ? h * 64 : gidx == 1 ? 512 + h * 64 : gidx == 2 ? 1024 + h * 64 : gidx == 3 ? 2048 + dir * 64 : 2176 + dir * 64) + v8 * 8;
        uint4 val = make_uint4(0, 0, 0, 0);
        if (t >= base && t < base + len) val = *(const uint4*)(p->P + ((size_t)b * SB + t) * LDP + C_RW + gcol);
        *(uint4*)(raw + rr * 320 + v * 8) = val; }
      __syncthreads();
      for (int e = tid; e < RCH * 320; e += 512) { const int tl = e / 320, cc = e % 320, gidx = cc >> 6, n = cc & 63;
        const int mcol = (gidx == 0 ? h * 64 : gidx == 1 ? 512 + h * 64 : gidx == 2 ? 1024 + h * 64 : gidx == 3 ? 2048 + dir * 64 : 2176 + dir * 64) + n;
        const float c0 = bf2f(raw[(tl + 1) * 320 + cc]), lf = bf2f(raw[tl * 320 + cc]), nx = bf2f(raw[(tl + 2) * 320 + cc]);
        const float val = c0 + mu[mcol] * (0.5f * (lf + nx) - c0);
        if (gidx == 0) sR[tl * 64 + n] = val; else if (gidx == 1) sK[tl * 64 + n] = val; else if (gidx == 2) sV[tl * 64 + n] = val;
        else if (gidx == 3) tTW[tl * 72 + n] = f2bf(tanhf(val)); else tAD[tl * 72 + n] = f2bf(val); }
      __syncthreads();
      if (wid < 4) {
        const int gsel = wid >> 1, ni = wid & 1, r32 = lane & 31, hi = lane >> 5;
        const u16* At = gsel ? tAD : tTW; const u16* Bt = gsel ? aupT : wupT;
        f32x16 acc;
#pragma unroll
        for (int r = 0; r < 16; ++r) acc[r] = 0.f;
#pragma unroll
        for (int ks = 0; ks < 4; ++ks) {
          const bf16x8 a = *(const bf16x8*)(At + r32 * 72 + ks * 16 + hi * 8), bb = *(const bf16x8*)(Bt + (ni * 32 + r32) * 72 + ks * 16 + hi * 8);
          acc = __builtin_amdgcn_mfma_f32_32x32x16_bf16(a, bb, acc, 0, 0, 0);
        }
        const int n = ni * 32 + r32;
        if (gsel == 0) { const float w0n = w0[n];
#pragma unroll
          for (int r = 0; r < 16; ++r) sW[crow(r, hi) * 64 + n] = __expf(-0.6065306597f * sigmoidf_(w0n + acc[r])); }
        else { const float a0n = a0[n];
#pragma unroll
          for (int r = 0; r < 16; ++r) sA[crow(r, hi) * 64 + n] = sigmoidf_(a0n + acc[r]); }
      }
      __syncthreads();
      { const int tl = tid >> 4, n0 = (tid & 15) * 4;
        float kd[4], kk[4], aa[4]; float ss = 0.f, bs = 0.f;
#pragma unroll
        for (int j = 0; j < 4; ++j) { const int n = n0 + j; const float k = sK[tl * 64 + n]; aa[j] = sA[tl * 64 + n];
          kd[j] = k * (1.f + (aa[j] - 1.f) * kaw[n]); kk[j] = k * kkw[n]; ss += kk[j] * kk[j]; bs += sR[tl * 64 + n] * kd[j] * rkw[n]; }
        ss += shfl_xor_f(ss, 1); ss += shfl_xor_f(ss, 2); ss += shfl_xor_f(ss, 4); ss += shfl_xor_f(ss, 8);
        bs += shfl_xor_f(bs, 1); bs += shfl_xor_f(bs, 2); bs += shfl_xor_f(bs, 4); bs += shfl_xor_f(bs, 8);
        const float rn = rsqrtf(ss + 1e-12f);
#pragma unroll
        for (int j = 0; j < 4; ++j) { const int n = n0 + j; const float kn = kk[j] * rn; sK[tl * 64 + n] = kd[j]; sKK[tl * 64 + n] = kn; sA[tl * 64 + n] = kn * aa[j]; }
        if ((tid & 15) == 0) p->bon[((size_t)dir * R + row0 + tl) * 8 + h] = bs; }
      __syncthreads();
      for (int i = 0; i < RCH; ++i) {
        const int tl = dir ? RCH - 1 - i : i;
        const float4 k0 = *(const float4*)(sKK + tl * 64 + q * 8), k1 = *(const float4*)(sKK + tl * 64 + q * 8 + 4);
        float sa = S[0] * k0.x + S[1] * k0.y + S[2] * k0.z + S[3] * k0.w + S[4] * k1.x + S[5] * k1.y + S[6] * k1.z + S[7] * k1.w;
        sa = red8(sa);
        const float vv = sV[tl * 64 + vrow];
        const float4 w0_ = *(const float4*)(sW + tl * 64 + q * 8), w1_ = *(const float4*)(sW + tl * 64 + q * 8 + 4);
        const float4 d0 = *(const float4*)(sK + tl * 64 + q * 8), d1 = *(const float4*)(sK + tl * 64 + q * 8 + 4);
        const float4 b0 = *(const float4*)(sA + tl * 64 + q * 8), b1 = *(const float4*)(sA + tl * 64 + q * 8 + 4);
        const float4 r0 = *(const float4*)(sR + tl * 64 + q * 8), r1 = *(const float4*)(sR + tl * 64 + q * 8 + 4);
        S[0] = S[0] * w0_.x + (vv * d0.x - sa * b0.x); S[1] = S[1] * w0_.y + (vv * d0.y - sa * b0.y);
        S[2] = S[2] * w0_.z + (vv * d0.z - sa * b0.z); S[3] = S[3] * w0_.w + (vv * d0.w - sa * b0.w);
        S[4] = S[4] * w1_.x + (vv * d1.x - sa * b1.x); S[5] = S[5] * w1_.y + (vv * d1.y - sa * b1.y);
        S[6] = S[6] * w1_.z + (vv * d1.z - sa * b1.z); S[7] = S[7] * w1_.w + (vv * d1.w - sa * b1.w);
        float y = S[0] * r0.x + S[1] * r0.y + S[2] * r0.z + S[3] * r0.w + S[4] * r1.x + S[5] * r1.y + S[6] * r1.z + S[7] * r1.w;
        y = red8(y);
        if (q == 0) sY[tl * 64 + vrow] = y;
      }
      __syncthreads();
      { const int tl = tid >> 4, n4 = (tid & 15) * 4; const float4 yv = *(const float4*)(sY + tl * 64 + n4);
        uint2 o; o.x = pack2(yv.x, yv.y); o.y = pack2(yv.z, yv.w);
        *(uint2*)(p->SH + (row0 + tl) * 1024 + dir * 512 + h * 64 + n4) = o; }
    }
  }
}

__device__ __forceinline__ void phase_f0(KParams p, int l) {
  const int tid = tidx(), wid = tid >> 6, lane = tid & 63;
  const float* mu = p->rwkv_mu + l * 2304; const float* lng = p->rwkv_ln_g + l * 512; const float* lnb = p->rwkv_ln_b + l * 512;
  for (int r = blockIdx.x; r < R; r += gridDim.x) {
    const int s = r % SB;
    if (l == 1 && s >= T) continue;
    const bool first = (s == 0) || (s == T), last = (s == T - 1) || (s == SB - 1);
    const int j = tid;
    const u16* p0 = p->P + (size_t)r * LDP + C_RW;
    float vv, gg;
    { const int cv = 1024 + j, cg_ = 1536 + j;
      const float c1 = bf2f(p0[cv]), l1 = first ? 0.f : bf2f(p0[cv - LDP]), n1 = last ? 0.f : bf2f(p0[cv + LDP]); vv = c1 + mu[cv] * (0.5f * (l1 + n1) - c1);
      const float c2 = bf2f(p0[cg_]), l2 = first ? 0.f : bf2f(p0[cg_ - LDP]), n2 = last ? 0.f : bf2f(p0[cg_ + LDP]); gg = c2 + mu[cg_] * (0.5f * (l2 + n2) - c2); }
    u16* yrow = p->SH + (size_t)r * 1024;
    const float y = bf2f(yrow[j]) + bf2f(yrow[512 + j]);
    const float mean = wave_sum(y) * (1.f / 64.f);
    const float dv = y - mean;
    const float var = wave_sum(dv * dv) * (1.f / 64.f);
    const float ln = dv * rsqrtf(var + 64e-5f) * lng[j] + lnb[j];
    const float bonus = p->bon[(size_t)r * 8 + wid] + p->bon[((size_t)R + r) * 8 + wid];
    yrow[j] = f2bf((ln + bonus * vv) * siluf_(gg));
  }
  const float* g_pre = p->g_pre + l * 1024; const float* modl = p->mod + (size_t)l * 17 * 3072;
  for (int r = blockIdx.x * 8 + wid; r < R; r += gridDim.x * 8) {
    const int b = r / SB, s = r % SB;
    if (l == 1 && s >= T) continue;
    const float* src = xrow_ptr(p, l, r);
    float4 v[4];
#pragma unroll
    for (int i = 0; i < 4; ++i) v[i] = *(const float4*)(src + i * 256 + lane * 4);
    hrow_write(v, g_pre, modl + (size_t)((s < T) ? b : 16) * 3072, p->P + (size_t)r * LDP + C_HRE, lane);
  }
}

__device__ __forceinline__ int rowtile_row0(int l, int i) { return l == 0 ? i * 256 : ((i >> 4) * 17 + (i & 15)) * 256; }
__device__ __forceinline__ int n_rowtiles(int l) { return l == 0 ? R / 256 : NB * 16; }

__device__ __forceinline__ void phase_f1(KParams p, int l, char* smem) {
  const u16* Wg = p->Wt_in + (size_t)l * DINP * 1024 + (size_t)C_MG * 1024;
  const u16* Wo = p->Wt_o + (size_t)l * 3 * 1024 * 512;
  uint4* park = (uint4*)(p->tmp + ((size_t)blockIdx.x * 512 + tidx()) * 32);
  for (int t = blockIdx.x; t < n_rowtiles(l) * 8; t += gridDim.x) {
    const int row0 = rowtile_row0(l, t >> 3), nt = t & 7;
    f32x16 accm[2][2];
#pragma unroll
    for (int mi = 0; mi < 2; ++mi)
#pragma unroll
      for (int ni = 0; ni < 2; ++ni)
#pragma unroll
        for (int r = 0; r < 16; ++r) accm[mi][ni][r] = 0.f;
#pragma unroll 1
    for (int i = 0; i < 3; ++i) {
      {
        f32x16 acc[2][2];
        gemm_kloop(p->P + (size_t)row0 * LDP + C_HRE, LDP, Wg + (size_t)(i * 1024 + nt * 128) * 1024, 1024, 1024, smem, acc);
#pragma unroll
        for (int mi = 0; mi < 2; ++mi)
#pragma unroll
          for (int ni = 0; ni < 2; ++ni)
#pragma unroll
            for (int r = 0; r < 16; r += 8) park[(mi * 2 + ni) * 2 + (r >> 3)] = make_uint4(pack2(sigmoidf_(acc[mi][ni][r]), sigmoidf_(acc[mi][ni][r + 1])), pack2(sigmoidf_(acc[mi][ni][r + 2]), sigmoidf_(acc[mi][ni][r + 3])),
                                                                                  pack2(sigmoidf_(acc[mi][ni][r + 4]), sigmoidf_(acc[mi][ni][r + 5])), pack2(sigmoidf_(acc[mi][ni][r + 6]), sigmoidf_(acc[mi][ni][r + 7])));
      }
      {
        f32x16 acc[2][2];
        const u16* Ai = (i == 0) ? p->P + (size_t)row0 * LDP + C_GV : (i == 1) ? p->P + (size_t)row0 * LDP + C_AQ : p->SH + (size_t)row0 * 1024;
        gemm_kloop(Ai, (i == 2) ? 1024 : LDP, Wo + (size_t)(i * 1024 + nt * 128) * 512, 512, 512, smem, acc);
#pragma unroll
        for (int mi = 0; mi < 2; ++mi)
#pragma unroll
          for (int ni = 0; ni < 2; ++ni)
#pragma unroll
            for (int r = 0; r < 16; r += 8) { const uint4 w = park[(mi * 2 + ni) * 2 + (r >> 3)];
              accm[mi][ni][r] += __uint_as_float(w.x << 16) * acc[mi][ni][r]; accm[mi][ni][r + 1] += __uint_as_float(w.x & 0xffff0000u) * acc[mi][ni][r + 1];
              accm[mi][ni][r + 2] += __uint_as_float(w.y << 16) * acc[mi][ni][r + 2]; accm[mi][ni][r + 3] += __uint_as_float(w.y & 0xffff0000u) * acc[mi][ni][r + 3];
              accm[mi][ni][r + 4] += __uint_as_float(w.z << 16) * acc[mi][ni][r + 4]; accm[mi][ni][r + 5] += __uint_as_float(w.z & 0xffff0000u) * acc[mi][ni][r + 5];
              accm[mi][ni][r + 6] += __uint_as_float(w.w << 16) * acc[mi][ni][r + 6]; accm[mi][ni][r + 7] += __uint_as_float(w.w & 0xffff0000u) * acc[mi][ni][r + 7]; }
      }
    }
    store_tile_bf16(accm, p->P + (size_t)row0 * LDP + C_M + nt * 128, LDP, 128);
  }
}
__device__ __forceinline__ void phase_f2(KParams p, int l, char* smem) {
  const u16* W = p->Wt_out + (size_t)l * 1024 * 1024;
  for (int t = blockIdx.x; t < n_rowtiles(l) * 8; t += gridDim.x) {
    const int row0 = rowtile_row0(l, t >> 3), nt = t & 7;
    f32x16 acc[2][2];
    gemm_kloop(p->P + (size_t)row0 * LDP + C_M, LDP, W + (size_t)nt * 128 * 1024, 1024, 1024, smem, acc);
    store_tile_bf16(acc, p->SH + (size_t)row0 * 1024 + nt * 128, 1024, 128);
  }
}
__device__ __forceinline__ void phase_f3(KParams p, int l) {
  const int wid = tidx() >> 6, lane = tidx() & 63;
  const float* g_post = p->g_post + l * 1024; const float* modl = p->mod + (size_t)l * 17 * 3072;
  for (int r = blockIdx.x * 8 + wid; r < R; r += gridDim.x * 8) {
    const int b = r / SB, s = r % SB;
    if (l == 1 && s >= T) continue;
    const float* src = xrow_ptr(p, l, r);
    float* dst = (s < T) ? p->out + ((size_t)b * T + s) * DM : p->xc1 + ((size_t)b * TC + (s - T)) * DM;
    const float* gate = modl + (size_t)((s < T) ? b : 16) * 3072 + 2048;
    u16* zrow = p->SH + (size_t)r * 1024;
    float z[4][4]; float ss = 0.f;
#pragma unroll
    for (int i = 0; i < 4; ++i) { const ushort4 u = *(const ushort4*)(zrow + i * 256 + lane * 4); z[i][0] = bf2f(u.x); z[i][1] = bf2f(u.y); z[i][2] = bf2f(u.z); z[i][3] = bf2f(u.w);
      ss += z[i][0] * z[i][0] + z[i][1] * z[i][1] + z[i][2] * z[i][2] + z[i][3] * z[i][3]; }
    ss = wave_sum(ss);
    const float rstd = rsqrtf(ss * (1.f / 1024.f) + 1e-6f);
    float4 o[4];
#pragma unroll
    for (int i = 0; i < 4; ++i) {
      const int col = i * 256 + lane * 4;
      const float4 g = *(const float4*)(g_post + col), gt = *(const float4*)(gate + col), xv = *(const float4*)(src + col);
      o[i].x = xv.x + gt.x * (z[i][0] * rstd * g.x); o[i].y = xv.y + gt.y * (z[i][1] * rstd * g.y);
      o[i].z = xv.z + gt.z * (z[i][2] * rstd * g.z); o[i].w = xv.w + gt.w * (z[i][3] * rstd * g.w);
      *(float4*)(dst + col) = o[i];
    }
    if (l == 0) hrow_write(o, p->g_pre + 1024, p->mod + (size_t)17 * 3072 + (size_t)((s < T) ? b : 16) * 3072, zrow, lane);
  }
}

constexpr int N_PHASES = 18;
#define LOADP() KParams p = kp; asm volatile("" : "+s"(p))
__global__ __launch_bounds__(512, 1) void megakernel(Params praw) {
  extern __shared__ __attribute__((aligned(16))) char smem[];
  const KParams kp = (KParams)__builtin_amdgcn_kernarg_segment_ptr();
  const int ph0 = praw.p0, ph1 = praw.p1;
  for (int ph = ph0; ph < ph1; ++ph) {
    const int l = (ph - 2) >> 3, sub = (ph - 2) & 7;
    if (ph == 0) { LOADP(); phase_prologue(p, smem); }
    else if (ph == 1) { LOADP(); phase_a0(p); }
    else if (sub == 0) { LOADP(); phase_a1(p, l, smem); }
    else if (sub == 1) { LOADP();
      for (int u = blockIdx.x; u < 256; u += gridDim.x) gla_state_unit(p, l, u, smem);
      attn_prep_all(p, l);
    } else if (sub == 2) {
      const int natt = 1024 + (l == 0 ? 64 : 0), nch = (l == 0 ? 68 : 64);
      for (int it = blockIdx.x; it < natt + NB * 4 * nch; it += gridDim.x) {
        if (it < natt) {
          int b, h, qrow0, krow0, seq;
          if (it < 1024) { b = it >> 6; h = (it >> 4) & 3; qrow0 = (it & 15) * 256; krow0 = 0; seq = SB; }
          else { const int u = it - 1024; b = u >> 2; h = u & 3; qrow0 = T; krow0 = T; seq = TC; }
          const int kvh = h >> 1;
          KParams q_ = kp; asm volatile("" : "+s"(q_)); u16* Pbase = q_->P;
          u16* Pq = Pbase + (size_t)(b * SB + qrow0) * LDP; const u16* Pk = Pbase + (size_t)(b * SB + krow0) * LDP;
          att::attn_dense_body((const bf16*)(Pq + C_AQ + h * 128), (const bf16*)(Pk + C_AK + kvh * 128), (const bf16*)(Pk + C_AV + kvh * 128),
                               Pq + C_AG + h * 128, Pq + C_AQ + h * 128, seq, smem);
        } else { LOADP(); const int g = it - natt; gla_out_tile(p, l, g / (nch * 4), (g / nch) & 3, g % nch, smem); }
      }
    } else if (sub == 3) { LOADP(); for (int u = blockIdx.x; u < 256; u += gridDim.x) rwkv_scan_unit(p, l, u, smem); }
    else if (sub == 4) { LOADP(); phase_f0(p, l); }
    else if (sub == 5) { LOADP(); phase_f1(p, l, smem); }
    else if (sub == 6) { LOADP(); phase_f2(p, l, smem); }
    else { LOADP(); phase_f3(p, l); }
    if (ph + 1 < ph1) cg::this_grid().sync();
  }
}

#ifndef MK_LAUNCHES
#define MK_LAUNCHES 1
#endif
static inline size_t al256(size_t x) { return (x + 255) / 256 * 256; }
extern "C" void kernel_launch(void* const* d_in, const int* in_sizes, int n_in, void* d_out, int out_size, void* d_ws, size_t ws_size, hipStream_t stream) {
  Params p{};
  const float** pf = (const float**)&p;
  for (int i = 0; i < 34; ++i) pf[i] = (const float*)d_in[i];
  p.out = (float*)d_out;
  char* ws = (char*)d_ws; size_t off = 0;
  auto take = [&](size_t bytes) { char* q = ws + off; off += al256(bytes); return q; };
  p.Wt_in = (u16*)take((size_t)2 * DINP * 1024 * 2);
  p.Wt_o = (u16*)take((size_t)2 * 3 * 1024 * 512 * 2);
  p.Wt_out = (u16*)take((size_t)2 * 1024 * 1024 * 2);
  p.mod = (float*)take((size_t)2 * 17 * 3072 * 4);
  p.bon = (float*)take((size_t)2 * R * 8 * 4);
  p.xc1 = (float*)take((size_t)NB * TC * DM * 4);
  p.SH = (u16*)take((size_t)R * 1024 * 2);
  p.P = (u16*)take((size_t)R * LDP * 2);
  p.tmp = (unsigned*)take((size_t)512 * 32 * 512 * 4);
  if (off > ws_size) { fprintf(stderr, "kernel_launch: workspace too small (%zu > %zu)\n", off, ws_size); return; }

  static int grid_blocks = 0;
  if (!grid_blocks) {
    if (hipFuncSetAttribute((const void*)megakernel, hipFuncAttributeMaxDynamicSharedMemorySize, SMEM_BYTES) != hipSuccess) { fprintf(stderr, "kernel_launch: LDS attribute failed\n"); return; }
    int dev = 0, cus = 0, per_cu = 0;
    (void)hipGetDevice(&dev);
    (void)hipDeviceGetAttribute(&cus, hipDeviceAttributeMultiprocessorCount, dev);
    (void)hipOccupancyMaxActiveBlocksPerMultiprocessor(&per_cu, megakernel, 512, SMEM_BYTES);
    if (per_cu < 1) { fprintf(stderr, "kernel_launch: occupancy query returned %d\n", per_cu); return; }
    grid_blocks = cus * (per_cu > 1 ? 1 : per_cu);
  }
#if MK_LAUNCHES == 1
  p.p0 = 0; p.p1 = N_PHASES;
  void* args[] = {&p};
  hipError_t e = hipLaunchCooperativeKernel((void*)megakernel, dim3(grid_blocks), dim3(512), args, SMEM_BYTES, stream);
  if (e != hipSuccess) fprintf(stderr, "cooperative launch failed: %s (grid %d)\n", hipGetErrorString(e), grid_blocks);
#else
  for (int ph = 0; ph < N_PHASES; ++ph) { p.p0 = ph; p.p1 = ph + 1; hipLaunchKernelGGL(megakernel, dim3(grid_blocks), dim3(512), SMEM_BYTES, stream, p); }
#endif
}
```

```cpp
#include <hip/hip_runtime.h>
#include <hip/hip_bf16.h>
#include <hip/hip_cooperative_groups.h>
#include <stdint.h>
#include <cstdio>
namespace cg = cooperative_groups;

typedef unsigned short u16;
using bf16 = __hip_bfloat16;
using bf16x8 = __attribute__((ext_vector_type(8))) short;
using s16x4  = __attribute__((ext_vector_type(4))) short;
using f32x16 = __attribute__((ext_vector_type(16))) float;
using f32x8  = __attribute__((ext_vector_type(8))) float;
using u32x4  = __attribute__((ext_vector_type(4))) unsigned;

constexpr int NB = 16, T = 4096, TC = 256, SB = T + TC;
constexpr int R = NB * SB;
constexpr int DM = 1024, DIN = 8480, DINP = 8576;
constexpr int LDP = 5408;
constexpr int NT_P = 43;
constexpr int C_GQ = 0, C_GK = 256, C_GV = 512, C_GG = 1024, C_GWF = 1536;
constexpr int C_AQ = 1568, C_AK = 2080, C_AV = 2336, C_AG = 2592;
constexpr int C_RW = 3104;
constexpr int C_MG = 5408;
constexpr int C_HRE = C_AK;
constexpr int C_M = C_RW;
constexpr int SMEM_BYTES = 147456;

struct Params {
  const float *x, *c, *ctx, *c_ctx, *w_mod, *b_mod, *g_pre, *w_in, *gla_wup_f, *gla_b_f, *gla_wup_b, *gla_b_b, *gla_norm, *att_qnorm, *att_knorm,
      *rwkv_mu, *rwkv_w0_f, *rwkv_wup_f, *rwkv_w0_b, *rwkv_wup_b, *rwkv_a0_f, *rwkv_aup_f, *rwkv_a0_b, *rwkv_aup_b, *rwkv_kk, *rwkv_ka, *rwkv_rk,
      *rwkv_ln_g, *rwkv_ln_b, *w_o_gla, *w_o_att, *w_o_rwkv, *w_out, *g_post;
  float* out; u16* Wt_in; u16* Wt_o; u16* Wt_out; float* mod; float* bon; float* xc1; u16* SH; u16* P; unsigned* tmp;
  int p0, p1;
};
typedef const __attribute__((address_space(4))) Params* KParams;

__device__ __forceinline__ int tidx() { int t = threadIdx.x; asm volatile("" : "+v"(t)); return t; }
__device__ __forceinline__ float bf2f(u16 v) { return __uint_as_float(((unsigned)v) << 16); }
__device__ __forceinline__ u16 f2bf(float x) { unsigned u = __float_as_uint(x); u += 0x7fffu + ((u >> 16) & 1u); return (u16)(u >> 16); }
__device__ __forceinline__ float shfl_xor_f(float v, int m) { const int lane = tidx() & 63; return __builtin_bit_cast(float, __builtin_amdgcn_ds_bpermute((lane ^ m) << 2, __builtin_bit_cast(int, v))); }
__device__ __forceinline__ float wave_sum(float v) {
#pragma unroll
  for (int m = 32; m >= 1; m >>= 1) v += shfl_xor_f(v, m);
  return v;
}
__device__ __forceinline__ float sigmoidf_(float x) { return 1.f / (1.f + __expf(-x)); }
__device__ __forceinline__ float siluf_(float x) { return x / (1.f + __expf(-x)); }
__device__ __forceinline__ int crow(int r, int hi) { return (r & 3) + 8 * (r >> 2) + 4 * hi; }
__device__ __forceinline__ void unpack8(uint4 u, float* f) {
  f[0] = __uint_as_float(u.x << 16); f[1] = __uint_as_float(u.x & 0xffff0000u); f[2] = __uint_as_float(u.y << 16); f[3] = __uint_as_float(u.y & 0xffff0000u);
  f[4] = __uint_as_float(u.z << 16); f[5] = __uint_as_float(u.z & 0xffff0000u); f[6] = __uint_as_float(u.w << 16); f[7] = __uint_as_float(u.w & 0xffff0000u);
}
__device__ __forceinline__ unsigned pack2(float a, float b) { return (unsigned)f2bf(a) | ((unsigned)f2bf(b) << 16); }
template <int CTRL> __device__ __forceinline__ float dpp_f(float x) {
  return __builtin_bit_cast(float, __builtin_amdgcn_update_dpp(0, __builtin_bit_cast(int, x), CTRL, 0xF, 0xF, true));
}
__device__ __forceinline__ float red4(float x) { x += dpp_f<0xB1>(x); x += dpp_f<0x4E>(x); return x; }
__device__ __forceinline__ float red8(float x) { x = red4(x); x += shfl_xor_f(x, 4); return x; }

constexpr int GLS = 72;
constexpr int GEMM_SMEM = 2 * (256 * GLS + 128 * GLS) * 2;
__device__ __forceinline__ void gemm_kloop(const u16* __restrict__ A, int lda, const u16* __restrict__ Bt, int ldb, int K, char* smem, f32x16 (&acc)[2][2]) {
  u16* As = (u16*)smem; u16* Bs = As + 2 * 256 * GLS;
  const int tid = tidx(), wid = tid >> 6, lane = tid & 63, r32 = lane & 31, hi = lane >> 5;
  const int wm = wid >> 1, wn = wid & 1;
#pragma unroll
  for (int mi = 0; mi < 2; ++mi)
#pragma unroll
    for (int ni = 0; ni < 2; ++ni)
#pragma unroll
      for (int r = 0; r < 16; ++r) acc[mi][ni][r] = 0.f;
  uint4 xa0, xa1, xa2, xa3, xb0, xb1, ya0, ya1, ya2, ya3, yb0, yb1;
  const int nk = K / 64;
  const int lrow = tid >> 3, lkc = tid & 7;
  const u16* gA = A + (size_t)lrow * lda + lkc * 8;
  const u16* gB = Bt + (size_t)lrow * ldb + lkc * 8;
  const size_t sA = (size_t)64 * lda, sB = (size_t)64 * ldb;
  u16* wA = As + lrow * GLS + lkc * 8; u16* wB = Bs + lrow * GLS + lkc * 8;
#define GLOAD(R, kt) do { const u16* pa_ = gA + (kt) * 64; const u16* pb_ = gB + (kt) * 64; \
    R##a0 = *(const uint4*)(pa_); R##a1 = *(const uint4*)(pa_ + sA); R##a2 = *(const uint4*)(pa_ + 2 * sA); R##a3 = *(const uint4*)(pa_ + 3 * sA); \
    R##b0 = *(const uint4*)(pb_); R##b1 = *(const uint4*)(pb_ + sB); } while (0)
#define SWRITE(R, buf) do { u16* qa_ = wA + (buf) * 256 * GLS; u16* qb_ = wB + (buf) * 128 * GLS; \
    *(uint4*)(qa_) = R##a0; *(uint4*)(qa_ + 64 * GLS) = R##a1; *(uint4*)(qa_ + 128 * GLS) = R##a2; *(uint4*)(qa_ + 192 * GLS) = R##a3; \
    *(uint4*)(qb_) = R##b0; *(uint4*)(qb_ + 64 * GLS) = R##b1; } while (0)
#define COMPUTE(buf) do { const u16* Ab = As + (buf) * 256 * GLS + (wm * 64 + r32) * GLS + hi * 8; const u16* Bb = Bs + (buf) * 128 * GLS + (wn * 64 + r32) * GLS + hi * 8; \
    _Pragma("unroll") for (int ks = 0; ks < 4; ++ks) { \
      bf16x8 a0 = *(const bf16x8*)(Ab + ks * 16), a1 = *(const bf16x8*)(Ab + 32 * GLS + ks * 16); \
      bf16x8 b0 = *(const bf16x8*)(Bb + ks * 16), b1 = *(const bf16x8*)(Bb + 32 * GLS + ks * 16); \
      acc[0][0] = __builtin_amdgcn_mfma_f32_32x32x16_bf16(a0, b0, acc[0][0], 0, 0, 0); \
      acc[0][1] = __builtin_amdgcn_mfma_f32_32x32x16_bf16(a0, b1, acc[0][1], 0, 0, 0); \
      acc[1][0] = __builtin_amdgcn_mfma_f32_32x32x16_bf16(a1, b0, acc[1][0], 0, 0, 0); \
      acc[1][1] = __builtin_amdgcn_mfma_f32_32x32x16_bf16(a1, b1, acc[1][1], 0, 0, 0); } } while (0)
  GLOAD(x, 0); GLOAD(y, 1);
  SWRITE(x, 0); GLOAD(x, 2);
  __syncthreads();
  for (int kt = 0; kt < nk; kt += 2) {
    COMPUTE(0);
    SWRITE(y, 1);
    if (kt + 3 < nk) GLOAD(y, kt + 3);
    __syncthreads();
    COMPUTE(1);
    if (kt + 2 < nk) { SWRITE(x, 0); if (kt + 4 < nk) GLOAD(x, kt + 4); }
    __syncthreads();
  }
#undef COMPUTE
#undef GLOAD
#undef SWRITE
}
__device__ __forceinline__ void store_tile_bf16(const f32x16 (&acc)[2][2], u16* __restrict__ C, int ldc, int ncols) {
  const int wid = tidx() >> 6, lane = tidx() & 63, r32 = lane & 31, hi = lane >> 5, wm = wid >> 1, wn = wid & 1;
#pragma unroll
  for (int mi = 0; mi < 2; ++mi)
#pragma unroll
    for (int ni = 0; ni < 2; ++ni) {
      const int col = wn * 64 + ni * 32 + r32;
      if (col < ncols) {
#pragma unroll
        for (int r = 0; r < 16; ++r) C[(size_t)(wm * 64 + mi * 32 + crow(r, hi)) * ldc + col] = f2bf(acc[mi][ni][r]);
      }
    }
}

namespace att {
constexpr int D = 128, NW = 8, QBLK = 32, KVBLK = 64;
constexpr float SCALE = 0.088388347648318440f;
constexpr float THR = 8.f;
constexpr int LDQ = LDP, LDK = LDP;
constexpr size_t SHM_V = KVBLK * D * 2, SHM_K = KVBLK * D * 2, SHM_ATTN = 2 * SHM_V + 2 * SHM_K + NW * 64 * 4;
#define KSWZ(row, colB) ((row) * 256 + ((colB) ^ (((row) & 7) << 4)))
#define SBAR() __builtin_amdgcn_sched_barrier(0)
__device__ __forceinline__ unsigned cvtpk(float lo, float hi) {
  unsigned r; asm volatile("v_cvt_pk_bf16_f32 %0, %1, %2" : "=v"(r) : "v"(lo), "v"(hi)); return r;
}
__device__ __forceinline__ bf16x8 ld8(const bf16* p) { return *reinterpret_cast<const bf16x8*>(p); }
__device__ __forceinline__ void partialSM(f32x16& p0, f32x16& p1, float& m_reg, float& mn, float& alpha) {
  constexpr float C = SCALE * 1.4426950408889634f;
  float pmax = p0[0]; for (int r = 1; r < 16; ++r) pmax = fmaxf(pmax, p0[r]); for (int r = 0; r < 16; ++r) pmax = fmaxf(pmax, p1[r]);
  { auto rr = __builtin_amdgcn_permlane32_swap(__float_as_uint(pmax), __float_as_uint(pmax), false, false);
    pmax = fmaxf(__uint_as_float(rr[0]), __uint_as_float(rr[1])); }
  if (__builtin_expect(__all(pmax - m_reg <= THR / SCALE), 1)) { mn = m_reg; alpha = 1.f; }
  else { mn = fmaxf(m_reg, pmax); alpha = __builtin_amdgcn_exp2f((m_reg - mn) * C); m_reg = mn; }
  float mnC = -mn * C;
  for (int r = 0; r < 16; ++r) p0[r] = fmaf(p0[r], C, mnC); for (int r = 0; r < 16; ++r) p1[r] = fmaf(p1[r], C, mnC);
  for (int r = 0; r < 16; ++r) p0[r] = __builtin_amdgcn_exp2f(p0[r]);
}
__device__ __forceinline__ void finishSM(f32x16& p0, f32x16& p1, float alpha, float& l_reg, bf16x8& pa0, bf16x8& pa1, bf16x8& pa2, bf16x8& pa3) {
  for (int r = 0; r < 16; ++r) p1[r] = __builtin_amdgcn_exp2f(p1[r]);
  float ps = 0; for (int r = 0; r < 16; ++r) ps += p0[r]; for (int r = 0; r < 16; ++r) ps += p1[r];
  { auto rr = __builtin_amdgcn_permlane32_swap(__float_as_uint(ps), __float_as_uint(ps), false, false);
    ps = __uint_as_float(rr[0]) + __uint_as_float(rr[1]); }
  l_reg = l_reg * alpha + ps;
#define PK4(P, BASE, OUT) do { unsigned a0 = cvtpk(P[BASE + 0], P[BASE + 1]), a1 = cvtpk(P[BASE + 2], P[BASE + 3]);   \
    unsigned b0 = cvtpk(P[BASE + 4], P[BASE + 5]), b1 = cvtpk(P[BASE + 6], P[BASE + 7]);                              \
    auto r0 = __builtin_amdgcn_permlane32_swap(a0, b0, false, false); auto r1 = __builtin_amdgcn_permlane32_swap(a1, b1, false, false); \
    u32x4 w = {r0[0], r1[0], r0[1], r1[1]}; OUT = *reinterpret_cast<bf16x8*>(&w); } while (0)
  PK4(p0, 0, pa0); PK4(p0, 8, pa1); PK4(p1, 0, pa2); PK4(p1, 8, pa3);
#undef PK4
}
__device__ __forceinline__ void qkt(f32x16& p0, f32x16& p1, const bf16* Ks, const bf16x8* qr, int r32, int hi) {
  p0 = f32x16{}; p1 = f32x16{};
  for (int d0 = 0; d0 < 8; ++d0) { int cb = (d0 * 16 + hi * 8) * 2;
    bf16x8 b0 = *reinterpret_cast<const bf16x8*>((const char*)Ks + KSWZ(r32, cb));
    bf16x8 b1 = *reinterpret_cast<const bf16x8*>((const char*)Ks + KSWZ(32 + r32, cb));
    p0 = __builtin_amdgcn_mfma_f32_32x32x16_bf16(b0, qr[d0], p0, 0, 0, 0);
    p1 = __builtin_amdgcn_mfma_f32_32x32x16_bf16(b1, qr[d0], p1, 0, 0, 0); }
}
__device__ __forceinline__ int v_st(int k, int c) { const int kk = (k & ~0xC) | ((k & 4) << 1) | ((k & 8) >> 1); return ((kk >> 3) * 4 + (c >> 5)) * 512 + ((kk & 7) * 32 + (c & 31)) * 2; }
__device__ __forceinline__ int v_rd_base(int lane) { return ((lane & 3) << 3) | (((lane >> 2) & 3) << 6) | (((lane >> 4) & 1) << 5) | (((lane >> 5) & 1) << 8); }
constexpr int v_rd_off(int d0, int ks, int half) { return d0 * 512 + ks * 4096 + half * 2048; }
template <int OFF> __device__ __forceinline__ s16x4 tr_read(int vb) {
  s16x4 r; asm volatile("ds_read_b64_tr_b16 %0, %1 offset:%2" : "=&v"(r) : "v"(vb), "i"(OFF) : "memory"); return r;
}
template <int D0> __device__ __forceinline__ void pv_one(f32x16& od, int vb, bf16x8 pa0, bf16x8 pa1, bf16x8 pa2, bf16x8 pa3) {
  const s16x4 l0 = tr_read<v_rd_off(D0, 0, 0)>(vb), h0 = tr_read<v_rd_off(D0, 0, 1)>(vb), l1 = tr_read<v_rd_off(D0, 1, 0)>(vb), h1 = tr_read<v_rd_off(D0, 1, 1)>(vb);
  const s16x4 l2 = tr_read<v_rd_off(D0, 2, 0)>(vb), h2 = tr_read<v_rd_off(D0, 2, 1)>(vb), l3 = tr_read<v_rd_off(D0, 3, 0)>(vb), h3 = tr_read<v_rd_off(D0, 3, 1)>(vb);
  asm volatile("s_waitcnt lgkmcnt(0)" ::: "memory"); SBAR();
#define PK(L, H) (bf16x8){L[0], L[1], L[2], L[3], H[0], H[1], H[2], H[3]}
  od = __builtin_amdgcn_mfma_f32_32x32x16_bf16(pa0, PK(l0, h0), od, 0, 0, 0);
  od = __builtin_amdgcn_mfma_f32_32x32x16_bf16(pa1, PK(l1, h1), od, 0, 0, 0);
  od = __builtin_amdgcn_mfma_f32_32x32x16_bf16(pa2, PK(l2, h2), od, 0, 0, 0);
  od = __builtin_amdgcn_mfma_f32_32x32x16_bf16(pa3, PK(l3, h3), od, 0, 0, 0);
#undef PK
}
__device__ __forceinline__ void pv_d0(f32x16* o, int vb, bf16x8 pa0, bf16x8 pa1, bf16x8 pa2, bf16x8 pa3) {
  pv_one<0>(o[0], vb, pa0, pa1, pa2, pa3); pv_one<1>(o[1], vb, pa0, pa1, pa2, pa3); pv_one<2>(o[2], vb, pa0, pa1, pa2, pa3); pv_one<3>(o[3], vb, pa0, pa1, pa2, pa3);
}
__device__ __forceinline__ void attn_dense_body(const bf16* Qb, const bf16* __restrict__ Kh, const bf16* __restrict__ Vh,
                                                const u16* __restrict__ Gb, u16* Yb, int seq, char* lds) {
  const int tid = tidx(), wid = tid >> 6, lane = tid & 63, r32 = lane & 31, hi = lane >> 5;
  bf16* V_lds = (bf16*)lds; bf16* K_lds = (bf16*)(lds + 2 * SHM_V);
  float* ws = (float*)(lds + 2 * SHM_V + 2 * SHM_K) + wid * 64; float* li_l = ws; float* al_l = ws + 32;
  float m_reg = -1e30f, l_reg = 0; f32x16 o[4] = {}; bf16x8 qr[8];
  const bf16* Qw = Qb + (long)(wid * QBLK + r32) * LDQ + hi * 8;
#pragma unroll
  for (int d0 = 0; d0 < 8; ++d0) qr[d0] = ld8(Qw + d0 * 16);
  const int sr = tid >> 4, sc = (tid & 15) * 8, vst0 = v_st(sr, sc), vst1 = v_st(32 + sr, sc);
  const int vb0 = (int)(uintptr_t)V_lds + v_rd_base(lane);
  struct { bf16x8 vs0, vs1, ks0, ks1; } sr_[2];
#define SLOAD(i, k0) do { sr_[i].vs0 = ld8(&Vh[(long)((k0) + sr) * LDK + sc]); sr_[i].vs1 = ld8(&Vh[(long)((k0) + 32 + sr) * LDK + sc]); \
    sr_[i].ks0 = ld8(&Kh[(long)((k0) + sr) * LDK + sc]); sr_[i].ks1 = ld8(&Kh[(long)((k0) + 32 + sr) * LDK + sc]); } while (0)
#define SWRITE(b, i) do { *(bf16x8*)((char*)V_lds + (b) * SHM_V + vst0) = sr_[i].vs0;          \
    *(bf16x8*)((char*)V_lds + (b) * SHM_V + vst1) = sr_[i].vs1; int kc = sc * 2;               \
    *(bf16x8*)((char*)K_lds + (b) * SHM_K + KSWZ(sr, kc)) = sr_[i].ks0;                       \
    *(bf16x8*)((char*)K_lds + (b) * SHM_K + KSWZ(32 + sr, kc)) = sr_[i].ks1; } while (0)
#define SWAIT() do { asm volatile("s_waitcnt vmcnt(4)" ::: "memory"); } while (0)
#define RESC(a) do { if (__any((a) < 1.f)) { if (hi == 0) al_l[r32] = (a); asm volatile("s_waitcnt lgkmcnt(0)" ::: "memory"); \
    for (int d = 0; d < 4; ++d) for (int r = 0; r < 16; ++r) o[d][r] *= al_l[crow(r, hi)]; } } while (0)
  f32x16 pA0, pA1, pB0, pB1; float mnA, mnB, alA, alB; bf16x8 pa0, pa1, pa2, pa3; const int NT = seq / KVBLK;
  constexpr int SE = 0, SO = 1;
  SLOAD(SE, 0); asm volatile("s_waitcnt vmcnt(0)" ::: "memory"); SWRITE(0, SE); __syncthreads();
  qkt(pA0, pA1, K_lds, qr, r32, hi); partialSM(pA0, pA1, m_reg, mnA, alA);
  SLOAD(SO, KVBLK); if (2 < NT) SLOAD(SE, 2 * KVBLK);
  SWAIT(); SWRITE(1, SO); __syncthreads();
  for (int j = 1; j + 1 < NT; j += 2) {
    SBAR(); qkt(pB0, pB1, (bf16*)((char*)K_lds + SHM_K), qr, r32, hi);
    finishSM(pA0, pA1, alA, l_reg, pa0, pa1, pa2, pa3); SBAR();
    SLOAD(SO, (j + 2) * KVBLK); SBAR();
    pv_d0(o, vb0, pa0, pa1, pa2, pa3); partialSM(pB0, pB1, m_reg, mnB, alB);
    __syncthreads(); SWAIT(); SWRITE(0, SE);
    RESC(alB); __syncthreads();
    SBAR(); qkt(pA0, pA1, K_lds, qr, r32, hi);
    finishSM(pB0, pB1, alB, l_reg, pa0, pa1, pa2, pa3); SBAR();
    if (j + 3 < NT) SLOAD(SE, (j + 3) * KVBLK); SBAR();
    pv_d0(o, vb0 + (int)SHM_V, pa0, pa1, pa2, pa3); partialSM(pA0, pA1, m_reg, mnA, alA);
    __syncthreads(); SWAIT(); SWRITE(1, SO);
    RESC(alA); __syncthreads();
  }
  SBAR(); qkt(pB0, pB1, (bf16*)((char*)K_lds + SHM_K), qr, r32, hi);
  finishSM(pA0, pA1, alA, l_reg, pa0, pa1, pa2, pa3); SBAR();
  pv_d0(o, vb0, pa0, pa1, pa2, pa3); partialSM(pB0, pB1, m_reg, mnB, alB);
  __syncthreads(); RESC(alB);
  finishSM(pB0, pB1, alB, l_reg, pa0, pa1, pa2, pa3); SBAR();
  pv_d0(o, vb0 + (int)SHM_V, pa0, pa1, pa2, pa3);
  if (hi == 0) li_l[r32] = l_reg; asm volatile("s_waitcnt lgkmcnt(0)" ::: "memory");
  float rli[16];
#pragma unroll
  for (int r = 0; r < 16; ++r) rli[r] = __builtin_amdgcn_rcpf(li_l[crow(r, hi)]);
#pragma unroll
  for (int r = 0; r < 16; ++r) { const long orow = wid * QBLK + crow(r, hi);
#pragma unroll
    for (int d0 = 0; d0 < 4; ++d0) {
      const float gt = bf2f(Gb[orow * LDQ + d0 * 32 + r32]);
      Yb[orow * LDQ + d0 * 32 + r32] = f2bf(o[d0][r] * rli[r] * siluf_(gt));
    } }
  __syncthreads();
#undef SLOAD
#undef SWRITE
#undef SWAIT
#undef RESC
}
}

__device__ __forceinline__ const float* xrow_ptr(KParams p, int l, int r) {
  const int b = r / SB, s = r % SB;
  if (s < T) return (l == 0 ? p->x : (const float*)p->out) + ((size_t)b * T + s) * DM;
  return (l == 0 ? p->ctx : (const float*)p->xc1) + ((size_t)b * TC + (s - T)) * DM;
}
__device__ __forceinline__ void hrow_write(const float4 (&v)[4], const float* __restrict__ g_pre, const float* __restrict__ md, u16* dst, int lane) {
  float ss = 0.f;
#pragma unroll
  for (int i = 0; i < 4; ++i) ss += v[i].x * v[i].x + v[i].y * v[i].y + v[i].z * v[i].z + v[i].w * v[i].w;
  ss = wave_sum(ss);
  const float rstd = rsqrtf(ss * (1.f / 1024.f) + 1e-6f);
#pragma unroll
  for (int i = 0; i < 4; ++i) {
    const int col = i * 256 + lane * 4;
    const float4 g = *(const float4*)(g_pre + col), sc = *(const float4*)(md + 1024 + col), sh = *(const float4*)(md + col);
    ushort4 o;
    o.x = f2bf(v[i].x * rstd * g.x * (1.f + sc.x) + sh.x); o.y = f2bf(v[i].y * rstd * g.y * (1.f + sc.y) + sh.y);
    o.z = f2bf(v[i].z * rstd * g.z * (1.f + sc.z) + sh.z); o.w = f2bf(v[i].w * rstd * g.w * (1.f + sc.w) + sh.w);
    *(ushort4*)(dst + col) = o;
  }
}

__device__ __forceinline__ void transpose_tile(const float* __restrict__ src, u16* __restrict__ dst, int K, int N, int nt, int kt, char* smem) {
  float* tile = (float*)smem;
  const int n0 = nt * 64, k0 = kt * 64, tx = tidx() & 63, ty = tidx() >> 6;
  __syncthreads();
#pragma unroll
  for (int i = 0; i < 8; ++i) { const int k = i * 8 + ty, n = n0 + tx; tile[k * 65 + tx] = (n < N) ? src[(size_t)(k0 + k) * N + n] : 0.f; }
  __syncthreads();
#pragma unroll
  for (int i = 0; i < 8; ++i) { const int n = i * 8 + ty; dst[(size_t)(n0 + n) * K + k0 + tx] = f2bf(tile[tx * 65 + n]); }
}
__device__ __forceinline__ void mod_item(KParams p, int item, char* smem) {
  float* sc = (float*)smem;
  float* red = sc + 17 * 512;
  const int l = item / 48, cgp = item % 48, tid = tidx(), kg = tid >> 6, jl = tid & 63, j = cgp * 64 + jl;
  const float* W = p->w_mod + (size_t)l * 1024 * 3072;
  float acc[17];
#pragma unroll
  for (int i = 0; i < 17; ++i) acc[i] = 0.f;
  for (int half = 0; half < 2; ++half) {
    __syncthreads();
    for (int e = tid; e < 17 * 512; e += 512) { const int i = e >> 9, k = e & 511; const float v = (i < 16) ? p->c[i * 1024 + half * 512 + k] : p->c_ctx[half * 512 + k]; sc[e] = siluf_(v); }
    __syncthreads();
    for (int kk = 0; kk < 64; ++kk) {
      const int k = kg * 64 + kk;
      const float w = W[(size_t)(half * 512 + k) * 3072 + j];
#pragma unroll
      for (int i = 0; i < 17; ++i) acc[i] += sc[i * 512 + k] * w;
    }
  }
#pragma unroll
  for (int i = 0; i < 17; ++i) red[(kg * 17 + i) * 64 + jl] = acc[i];
  __syncthreads();
  for (int e = tid; e < 17 * 64; e += 512) { const int i = e >> 6, jj = e & 63;
    float v = p->b_mod[l * 3072 + cgp * 64 + jj];
#pragma unroll
    for (int g = 0; g < 8; ++g) v += red[(g * 17 + i) * 64 + jj];
    p->mod[((size_t)l * 17 + i) * 3072 + cgp * 64 + jj] = v; }
}
__device__ __forceinline__ void phase_prologue(KParams p, char* smem) {
  constexpr int N_IN = 2 * 134 * 16, N_O = 2 * 3 * 16 * 8, N_OUT = 2 * 16 * 16, N_MOD = 96;
  for (int it = blockIdx.x; it < N_IN + N_O + N_OUT + N_MOD; it += gridDim.x) {
    if (it < N_MOD) mod_item(p, it, smem);
    else if (it < N_MOD + N_IN) { const int u = it - N_MOD, l = u / (134 * 16), v = u % (134 * 16);
      transpose_tile(p->w_in + (size_t)l * 1024 * DIN, p->Wt_in + (size_t)l * DINP * 1024, 1024, DIN, v % 134, v / 134, smem); }
    else if (it < N_MOD + N_IN + N_O) { const int u = it - N_MOD - N_IN, li = u / 128, v = u % 128, l = li / 3, i = li % 3;
      const float* src = (i == 0 ? p->w_o_gla : i == 1 ? p->w_o_att : p->w_o_rwkv) + (size_t)l * 512 * 1024;
      transpose_tile(src, p->Wt_o + (size_t)li * 1024 * 512, 512, 1024, v % 16, v / 16, smem); }
    else { const int u = it - N_MOD - N_IN - N_O, l = u / 256, v = u % 256;
      transpose_tile(p->w_out + (size_t)l * 1024 * 1024, p->Wt_out + (size_t)l * 1024 * 1024, 1024, 1024, v % 16, v / 16, smem); }
  }
}

__device__ __forceinline__ void phase_a0(KParams p) {
  const int wid = tidx() >> 6, lane = tidx() & 63;
  for (int r = blockIdx.x * 8 + wid; r < R; r += gridDim.x * 8) {
    const int b = r / SB, s = r % SB;
    const float* src = xrow_ptr(p, 0, r);
    float4 v[4];
#pragma unroll
    for (int i = 0; i < 4; ++i) v[i] = *(const float4*)(src + i * 256 + lane * 4);
    hrow_write(v, p->g_pre, p->mod + (size_t)((s < T) ? b : 16) * 3072, p->SH + (size_t)r * 1024, lane);
  }
}
__device__ __forceinline__ bool xcd_tile(int i, int nrt, int nnt, int& rt, int& nt) {
  const int x = blockIdx.x & 7, j = blockIdx.x >> 3, nb = gridDim.x >> 3;
  const int rpx = nrt >> 3;
  const int q = i * nb + j;
  if (q >= rpx * nnt) return false;
  const int g = q / (4 * nnt), r = q % (4 * nnt);
  const int gs = (rpx - g * 4) < 4 ? (rpx - g * 4) : 4;
  rt = x * rpx + g * 4 + r % gs; nt = r / gs;
  return true;
}
__device__ __forceinline__ void phase_a1(KParams p, int l, char* smem) {
  const u16* W = p->Wt_in + (size_t)l * DINP * 1024;
  int mt, nt;
  for (int i = 0; xcd_tile(i, R / 256, NT_P, mt, nt); ++i) {
    f32x16 acc[2][2];
    gemm_kloop(p->SH + (size_t)mt * 256 * 1024, 1024, W + (size_t)nt * 128 * 1024, 1024, 1024, smem, acc);
    store_tile_bf16(acc, p->P + (size_t)mt * 256 * LDP + nt * 128, LDP, LDP - nt * 128);
  }
}

__device__ __forceinline__ void attn_prep_all(KParams p, int l) {
  const float* qn = p->att_qnorm + l * 128; const float* kn = p->att_knorm + l * 128;
  const int wid = tidx() >> 6, lane = tidx() & 63;
  const int i = lane & 31, half = lane >> 5;
  const float inv = exp2f(-(float)i * (13.287712379549449f / 32.f));
  const int d1 = half * 64 + i, d2 = d1 + 32;
  for (long item = (long)blockIdx.x * 8 + wid; item < (long)R * 6; item += (long)gridDim.x * 8) {
    const int r = (int)(item / 6), hh = (int)(item % 6), s = r % SB;
    const int col = (hh < 4) ? C_AQ + hh * 128 : C_AK + (hh - 4) * 128;
    const float* gw = (hh < 4) ? qn : kn;
    u16* pp = p->P + (size_t)r * LDP + col;
    float u1 = bf2f(pp[d1]), u2 = bf2f(pp[d2]);
    const float ss = wave_sum(u1 * u1 + u2 * u2);
    const float rstd = rsqrtf(ss * (1.f / 128.f) + 1e-6f);
    u1 *= rstd * gw[d1]; u2 *= rstd * gw[d2];
    if (s < T) {
      const float pos = half ? (float)(s & 63) : (float)(s >> 6);
      const float ang = pos * inv;
      const float cs = __cosf(ang), sn = __sinf(ang);
      const float o1 = u1 * cs - u2 * sn, o2 = u2 * cs + u1 * sn;
      u1 = o1; u2 = o2;
    }
    pp[d1] = f2bf(u1); pp[d2] = f2bf(u2);
  }
}

__device__ __forceinline__ float logsig16(float x) { return (fminf(x, 0.f) - log1pf(__expf(-fabsf(x)))) * (1.f / 16.f); }
__device__ __forceinline__ void gla_state_unit(KParams p, int l, int unit, char* smem) {
  const int eh = unit & 1, dir = (unit >> 1) & 1, h = (unit >> 2) & 3, b = unit >> 4;
  float* kt = (float*)smem; float* vs = kt + 4096; float* gc = vs + 4096; float* lr = gc + 4096; float* wu = lr + 1024; float* bb = wu + 1024;
  const int tid = tidx(), d = tid >> 3, eq = tid & 7;
  const float* wup = (dir ? p->gla_wup_b : p->gla_wup_f) + l * 16 * 256; const float* bia = (dir ? p->gla_b_b : p->gla_b_f) + l * 256;
  __syncthreads();
  for (int e = tid; e < 1024; e += 512) wu[e] = wup[(e >> 6) * 256 + h * 64 + (e & 63)];
  if (tid < 64) bb[tid] = bia[h * 64 + tid];
  float S[8];
#pragma unroll
  for (int j = 0; j < 8; ++j) S[j] = 0.f;
  for (int pi = 0; pi < 68; ++pi) {
    const int base = dir == 0 ? (pi < 4 ? T + 64 * pi : 64 * (pi - 4)) : (pi < 4 ? T + 64 * (3 - pi) : 64 * (67 - pi));
    const int cid = base >> 6;
    const u16* Pr = p->P + (size_t)(b * SB + base) * LDP;
    __syncthreads();
    { const int c = tid >> 3, v8 = tid & 7;
      unpack8(*(const uint4*)(Pr + (size_t)c * LDP + C_GK + h * 64 + v8 * 8), kt + c * 64 + v8 * 8);
      unpack8(*(const uint4*)(Pr + (size_t)c * LDP + C_GV + h * 128 + eh * 64 + v8 * 8), vs + c * 64 + v8 * 8);
      if (tid < 128) { const int c2 = tid >> 1, hf = tid & 1; unpack8(*(const uint4*)(Pr + (size_t)c2 * LDP + C_GWF + dir * 16 + hf * 8), lr + c2 * 16 + hf * 8); } }
    __syncthreads();
#pragma unroll
    for (int it = 0; it < 8; ++it) { const int c = (tid >> 6) + 8 * it, dd = tid & 63;
      float x = bb[dd];
#pragma unroll
      for (int i = 0; i < 16; ++i) x += lr[c * 16 + i] * wu[i * 64 + dd];
      gc[c * 64 + dd] = logsig16(x); }
    __syncthreads();
    if (tid < 64) { float run = 0.f; for (int i = 0; i < 64; ++i) { const int c = dir ? 63 - i : i; run += gc[c * 64 + tid]; gc[c * 64 + tid] = run; } }
    __syncthreads();
    const int lastc = dir ? 0 : 63;
#pragma unroll
    for (int it = 0; it < 8; ++it) { const int e = tid + it * 512; kt[e] *= __expf(gc[lastc * 64 + (e & 63)] - gc[e]); }
    __syncthreads();
    u16* dst = p->SH + ((((size_t)(b * 4 + h) * 2 + dir) * 68 + cid) * 64 + d) * 128 + eh * 64 + eq * 8;
    uint4 o; o.x = pack2(S[0], S[1]); o.y = pack2(S[2], S[3]); o.z = pack2(S[4], S[5]); o.w = pack2(S[6], S[7]);
    *(uint4*)dst = o;
    const float dec = __expf(gc[lastc * 64 + d]);
#pragma unroll
    for (int j = 0; j < 8; ++j) S[j] *= dec;
    for (int s = 0; s < 64; ++s) {
      const float kv = kt[s * 64 + d];
      const float4 va = *(const float4*)(vs + s * 64 + eq * 8), vb = *(const float4*)(vs + s * 64 + eq * 8 + 4);
      S[0] += kv * va.x; S[1] += kv * va.y; S[2] += kv * va.z; S[3] += kv * va.w; S[4] += kv * vb.x; S[5] += kv * vb.y; S[6] += kv * vb.z; S[7] += kv * vb.w;
    }
  }
}
constexpr int GLQ = 68;
__device__ __forceinline__ void gla_out_tile(KParams p, int l, int b, int h, int cid, char* smem) {
  float* qdf = (float*)smem; float* kif = qdf + 64 * GLQ; float* qdb = kif + 64 * GLQ; float* kib = qdb + 64 * GLQ;
  float* vs = kib + 64 * GLQ; float* Am = vs + 64 * 128; float* lr = Am + 64 * 65; float* wuf = lr + 64 * 32; float* wub = wuf + 1024; float* bfb = wub + 1024;
  const int tid = tidx();
  u16* Pr = p->P + (size_t)(b * SB + cid * 64) * LDP;
  __syncthreads();
  for (int e = tid; e < 1024; e += 512) { wuf[e] = p->gla_wup_f[l * 4096 + (e >> 6) * 256 + h * 64 + (e & 63)]; wub[e] = p->gla_wup_b[l * 4096 + (e >> 6) * 256 + h * 64 + (e & 63)]; }
  if (tid < 64) bfb[tid] = p->gla_b_f[l * 256 + h * 64 + tid]; else if (tid < 128) bfb[tid] = p->gla_b_b[l * 256 + h * 64 + tid - 64];
  if (tid < 256) { const int c = tid >> 2, q4 = tid & 3; unpack8(*(const uint4*)(Pr + (size_t)c * LDP + C_GWF + q4 * 8), lr + c * 32 + q4 * 8); }
#pragma unroll
  for (int it = 0; it < 2; ++it) { const int e = tid + it * 512, c = e >> 4, v8 = e & 15; unpack8(*(const uint4*)(Pr + (size_t)c * LDP + C_GV + h * 128 + v8 * 8), vs + c * 128 + v8 * 8); }
  __syncthreads();
#pragma unroll
  for (int it = 0; it < 8; ++it) { const int c = (tid >> 6) + 8 * it, dd = tid & 63;
    float xf = bfb[dd], xb = bfb[64 + dd];
#pragma unroll
    for (int i = 0; i < 16; ++i) { xf += lr[c * 32 + i] * wuf[i * 64 + dd]; xb += lr[c * 32 + 16 + i] * wub[i * 64 + dd]; }
    kif[c * GLQ + dd] = logsig16(xf); kib[c * GLQ + dd] = logsig16(xb); }
  __syncthreads();
  if (tid < 64) { float run = 0.f; for (int c = 0; c < 64; ++c) { run += kif[c * GLQ + tid]; kif[c * GLQ + tid] = run; } }
  else if (tid < 128) { const int dd = tid - 64; float run = 0.f; for (int c = 63; c >= 0; --c) { run += kib[c * GLQ + dd]; kib[c * GLQ + dd] = run; } }
  __syncthreads();
  { const int c = tid >> 3, v8 = tid & 7; float qv[8], kv[8];
    unpack8(*(const uint4*)(Pr + (size_t)c * LDP + C_GQ + h * 64 + v8 * 8), qv); unpack8(*(const uint4*)(Pr + (size_t)c * LDP + C_GK + h * 64 + v8 * 8), kv);
#pragma unroll
    for (int j = 0; j < 8; ++j) { const int o = c * GLQ + v8 * 8 + j; const float gf = kif[o], gb = kib[o], q = qv[j] * 0.125f;
      qdf[o] = q * __expf(gf); kif[o] = kv[j] * __expf(-gf); qdb[o] = q * __expf(gb); kib[o] = kv[j] * __expf(-gb); } }
  __syncthreads();
  const int c = tid >> 3, sq = tid & 7;
  {
    float af[8], ab[8];
#pragma unroll
    for (int i = 0; i < 8; ++i) { af[i] = 0.f; ab[i] = 0.f; }
    for (int d4 = 0; d4 < 16; ++d4) {
      const float4 qf = *(const float4*)(qdf + c * GLQ + d4 * 4), qb = *(const float4*)(qdb + c * GLQ + d4 * 4);
#pragma unroll
      for (int i = 0; i < 8; ++i) { const int s = sq + 8 * i;
        const float4 kf = *(const float4*)(kif + s * GLQ + d4 * 4), kb = *(const float4*)(kib + s * GLQ + d4 * 4);
        af[i] += qf.x * kf.x + qf.y * kf.y + qf.z * kf.z + qf.w * kf.w;
        ab[i] += qb.x * kb.x + qb.y * kb.y + qb.z * kb.z + qb.w * kb.w; }
    }
#pragma unroll
    for (int i = 0; i < 8; ++i) { const int s = sq + 8 * i; Am[c * 65 + s] = (s <= c ? af[i] : 0.f) + (s >= c ? ab[i] : 0.f); }
  }
  __syncthreads();
  float acc[16];
#pragma unroll
  for (int j = 0; j < 16; ++j) acc[j] = 0.f;
  const int e0 = sq * 16;
  for (int s = 0; s < 64; ++s) {
    const float a = Am[c * 65 + s]; const float* vp = vs + s * 128 + e0;
#pragma unroll
    for (int j = 0; j < 16; j += 4) { const float4 v4 = *(const float4*)(vp + j); acc[j] += a * v4.x; acc[j + 1] += a * v4.y; acc[j + 2] += a * v4.z; acc[j + 3] += a * v4.w; }
  }
  const u16* Sf = p->SH + ((((size_t)(b * 4 + h) * 2 + 0) * 68 + cid) * 64) * 128 + e0;
  const u16* Sb = p->SH + ((((size_t)(b * 4 + h) * 2 + 1) * 68 + cid) * 64) * 128 + e0;
  for (int d = 0; d < 64; ++d) {
    const float qf = qdf[c * GLQ + d], qb = qdb[c * GLQ + d];
    float sf[16], sb[16];
    unpack8(*(const uint4*)(Sf + d * 128), sf); unpack8(*(const uint4*)(Sf + d * 128 + 8), sf + 8);
    unpack8(*(const uint4*)(Sb + d * 128), sb); unpack8(*(const uint4*)(Sb + d * 128 + 8), sb + 8);
#pragma unroll
    for (int j = 0; j < 16; ++j) acc[j] += qf * sf[j] + qb * sb[j];
  }
  float ss = 0.f;
#pragma unroll
  for (int j = 0; j < 16; ++j) ss += acc[j] * acc[j];
  ss = red8(ss);
  const float rstd = rsqrtf(ss * (1.f / 128.f) + 1e-6f);
  float gt[16];
  unpack8(*(const uint4*)(Pr + (size_t)c * LDP + C_GG + h * 128 + e0), gt); unpack8(*(const uint4*)(Pr + (size_t)c * LDP + C_GG + h * 128 + e0 + 8), gt + 8);
  const float* gn = p->gla_norm + l * 512 + h * 128 + e0;
  unsigned ow[8];
#pragma unroll
  for (int j = 0; j < 16; j += 2) ow[j >> 1] = pack2(acc[j] * rstd * gn[j] * siluf_(gt[j]), acc[j + 1] * rstd * gn[j + 1] * siluf_(gt[j + 1]));
  u16* dst = Pr + (size_t)c * LDP + C_GV + h * 128 + e0;
  *(uint4*)dst = make_uint4(ow[0], ow[1], ow[2], ow[3]); *(uint4*)(dst + 8) = make_uint4(ow[4], ow[5], ow[6], ow[7]);
}

constexpr int RCH = 32, RNCH = (TC + T) / RCH;
__device__ __forceinline__ float red16(float x) { x += dpp_f<0xB1>(x); x += dpp_f<0x4E>(x); x += dpp_f<0x141>(x); x += dpp_f<0x140>(x); return x; }
__device__ __forceinline__ float fast_tanh(float x) { const float e = __expf(2.f * x); return 1.f - 2.f * __builtin_amdgcn_rcpf(e + 1.f); }
__device__ __forceinline__ int rwkv_gcol(int gidx, int h, int dir) { return gidx == 0 ? h * 64 : gidx == 1 ? 512 + h * 64 : gidx == 2 ? 1024 + h * 64 : gidx == 3 ? 2048 + dir * 64 : 2176 + dir * 64; }
__device__ __forceinline__ void rwkv_scan_unit(KParams p, int l, int unit, char* smem) {
  const int dir = unit & 1, h = (unit >> 1) & 7, b = unit >> 4;
  const int tid = tidx(), wid = tid >> 6, lane = tid & 63;
  float* sR = (float*)smem; float* sK = sR + 2048; float* sV = sK + 2048; float* sW = sV + 2048; float* sA = sW + 2048; float* sKK = sA + 2048; float* sY = sKK + 2048;
  u16* tTW = (u16*)(smem + 7 * 8192); u16* tAD = tTW + 32 * 72; u16* wupT = tAD + 32 * 72; u16* aupT = wupT + 64 * 72;
  float* smu = (float*)(aupT + 64 * 72);
  const float* wup = (dir ? p->rwkv_wup_b : p->rwkv_wup_f) + l * 64 * 512; const float* aup = (dir ? p->rwkv_aup_b : p->rwkv_aup_f) + l * 64 * 512;
  const float* w0 = (dir ? p->rwkv_w0_b : p->rwkv_w0_f) + l * 512 + h * 64; const float* a0 = (dir ? p->rwkv_a0_b : p->rwkv_a0_f) + l * 512 + h * 64;
  const float* kkw = p->rwkv_kk + l * 512 + h * 64; const float* kaw = p->rwkv_ka + l * 512 + h * 64; const float* rkw = p->rwkv_rk + l * 512 + h * 64;
  const u16* Pb = p->P + (size_t)b * SB * LDP + C_RW;
  __syncthreads();
  for (int e = tid; e < 4096; e += 512) { const int n = e & 63, i = e >> 6; wupT[n * 72 + i] = f2bf(wup[i * 512 + h * 64 + n]); aupT[n * 72 + i] = f2bf(aup[i * 512 + h * 64 + n]); }
  if (tid < 320) smu[tid] = p->rwkv_mu[l * 2304 + rwkv_gcol(tid >> 6, h, dir) + (tid & 63)];
  const int rp = tid >> 4, kq = tid & 15;
  float S0[4], S1[4];
#pragma unroll
  for (int j = 0; j < 4; ++j) { S0[j] = 0.f; S1[j] = 0.f; }
  uint4 rg[3][3];
#define RW_T0(c, base, len, t0) do { const int ci_ = (c) < 8 ? (c) : (c) - 8; base = (c) < 8 ? T : 0; len = (c) < 8 ? TC : T; t0 = dir ? base + len - (ci_ + 1) * RCH : base + ci_ * RCH; } while (0)
#define RW_LOAD(c) do { int base_, len_, t0_; RW_T0(c, base_, len_, t0_); \
    _Pragma("unroll") for (int it = 0; it < 3; ++it) { const int e = tid + it * 512; \
      if (e < 1280) { const int tl = e / 40, v = e % 40; const int t = t0_ + tl; const u16* src = Pb + (size_t)t * LDP + rwkv_gcol(v >> 3, h, dir) + (v & 7) * 8; \
        rg[it][1] = *(const uint4*)src; \
        rg[it][0] = (t > base_) ? *(const uint4*)(src - LDP) : make_uint4(0, 0, 0, 0); \
        rg[it][2] = (t + 1 < base_ + len_) ? *(const uint4*)(src + LDP) : make_uint4(0, 0, 0, 0); } } } while (0)
  RW_LOAD(0);
  __syncthreads();
  for (int c = 0; c < RNCH; ++c) {
    int base, len, t0; RW_T0(c, base, len, t0);
    const size_t row0 = (size_t)b * SB + t0;
#pragma unroll
    for (int it = 0; it < 3; ++it) { const int e = tid + it * 512;
      if (e < 1280) { const int tl = e / 40, v = e % 40, gidx = v >> 3, n0 = (v & 7) * 8;
        float cc[8], ll[8], nn[8], val[8];
        unpack8(rg[it][1], cc); unpack8(rg[it][0], ll); unpack8(rg[it][2], nn);
        const float4 m0 = *(const float4*)(smu + gidx * 64 + n0), m1 = *(const float4*)(smu + gidx * 64 + n0 + 4);
        const float mm[8] = {m0.x, m0.y, m0.z, m0.w, m1.x, m1.y, m1.z, m1.w};
#pragma unroll
        for (int j = 0; j < 8; ++j) val[j] = cc[j] + mm[j] * (0.5f * (ll[j] + nn[j]) - cc[j]);
        if (gidx < 3) { float* dst = (gidx == 0 ? sR : gidx == 1 ? sK : sV) + tl * 64 + n0;
          *(float4*)dst = make_float4(val[0], val[1], val[2], val[3]); *(float4*)(dst + 4) = make_float4(val[4], val[5], val[6], val[7]); }
        else { if (gidx == 3) {
#pragma unroll
            for (int j = 0; j < 8; ++j) val[j] = fast_tanh(val[j]); }
          *(uint4*)((gidx == 3 ? tTW : tAD) + tl * 72 + n0) = make_uint4(pack2(val[0], val[1]), pack2(val[2], val[3]), pack2(val[4], val[5]), pack2(val[6], val[7])); } } }
    if (c + 1 < RNCH) RW_LOAD(c + 1);
    __syncthreads();
    if (wid < 4) {
      const int gsel = wid >> 1, ni = wid & 1, r32 = lane & 31, hi = lane >> 5;
      const u16* At = gsel ? tAD : tTW; const u16* Bt = gsel ? aupT : wupT;
      f32x16 acc;
#pragma unroll
      for (int r = 0; r < 16; ++r) acc[r] = 0.f;
#pragma unroll
      for (int ks = 0; ks < 4; ++ks) {
        const bf16x8 a = *(const bf16x8*)(At + r32 * 72 + ks * 16 + hi * 8), bb = *(const bf16x8*)(Bt + (ni * 32 + r32) * 72 + ks * 16 + hi * 8);
        acc = __builtin_amdgcn_mfma_f32_32x32x16_bf16(a, bb, acc, 0, 0, 0);
      }
      const int n = ni * 32 + r32;
      if (gsel == 0) { const float w0n = w0[n];
#pragma unroll
        for (int r = 0; r < 16; ++r) sW[crow(r, hi) * 64 + n] = __expf(-0.6065306597f * sigmoidf_(w0n + acc[r])); }
      else { const float a0n = a0[n];
#pragma unroll
        for (int r = 0; r < 16; ++r) sA[crow(r, hi) * 64 + n] = sigmoidf_(a0n + acc[r]); }
    }
    __syncthreads();
    { const int tl = tid >> 4, n0 = (tid & 15) * 4;
      const float4 k4 = *(const float4*)(sK + tl * 64 + n0), a4 = *(const float4*)(sA + tl * 64 + n0), r4 = *(const float4*)(sR + tl * 64 + n0);
      const float4 ka4 = *(const float4*)(kaw + n0), kw4 = *(const float4*)(kkw + n0), rk4 = *(const float4*)(rkw + n0);
      const float kk_[4] = {k4.x * kw4.x, k4.y * kw4.y, k4.z * kw4.z, k4.w * kw4.w};
      const float kd[4] = {k4.x * (1.f + (a4.x - 1.f) * ka4.x), k4.y * (1.f + (a4.y - 1.f) * ka4.y), k4.z * (1.f + (a4.z - 1.f) * ka4.z), k4.w * (1.f + (a4.w - 1.f) * ka4.w)};
      const float ss = red16(kk_[0] * kk_[0] + kk_[1] * kk_[1] + kk_[2] * kk_[2] + kk_[3] * kk_[3]);
      const float bs = red16(r4.x * kd[0] * rk4.x + r4.y * kd[1] * rk4.y + r4.z * kd[2] * rk4.z + r4.w * kd[3] * rk4.w);
      const float rn = rsqrtf(ss + 1e-12f);
      *(float4*)(sK + tl * 64 + n0) = make_float4(kd[0], kd[1], kd[2], kd[3]);
      *(float4*)(sKK + tl * 64 + n0) = make_float4(kk_[0] * rn, kk_[1] * rn, kk_[2] * rn, kk_[3] * rn);
      *(float4*)(sA + tl * 64 + n0) = make_float4(kk_[0] * rn * a4.x, kk_[1] * rn * a4.y, kk_[2] * rn * a4.z, kk_[3] * rn * a4.w);
      if ((tid & 15) == 0) p->bon[((size_t)dir * R + row0 + tl) * 8 + h] = bs; }
    __syncthreads();
    for (int i = 0; i < RCH; ++i) {
      const int tl = dir ? RCH - 1 - i : i;
      const float4 k4 = *(const float4*)(sKK + tl * 64 + kq * 4);
      const float4 w4 = *(const float4*)(sW + tl * 64 + kq * 4), d4 = *(const float4*)(sK + tl * 64 + kq * 4);
      const float4 b4 = *(const float4*)(sA + tl * 64 + kq * 4), r4 = *(const float4*)(sR + tl * 64 + kq * 4);
      const float2 vv = *(const float2*)(sV + tl * 64 + rp * 2);
      float sa0 = S0[0] * k4.x + S0[1] * k4.y + S0[2] * k4.z + S0[3] * k4.w;
      float sa1 = S1[0] * k4.x + S1[1] * k4.y + S1[2] * k4.z + S1[3] * k4.w;
      sa0 = red16(sa0); sa1 = red16(sa1);
      S0[0] = S0[0] * w4.x + (vv.x * d4.x - sa0 * b4.x); S0[1] = S0[1] * w4.y + (vv.x * d4.y - sa0 * b4.y);
      S0[2] = S0[2] * w4.z + (vv.x * d4.z - sa0 * b4.z); S0[3] = S0[3] * w4.w + (vv.x * d4.w - sa0 * b4.w);
      S1[0] = S1[0] * w4.x + (vv.y * d4.x - sa1 * b4.x); S1[1] = S1[1] * w4.y + (vv.y * d4.y - sa1 * b4.y);
      S1[2] = S1[2] * w4.z + (vv.y * d4.z - sa1 * b4.z); S1[3] = S1[3] * w4.w + (vv.y * d4.w - sa1 * b4.w);
      float y0 = S0[0] * r4.x + S0[1] * r4.y + S0[2] * r4.z + S0[3] * r4.w;
      float y1 = S1[0] * r4.x + S1[1] * r4.y + S1[2] * r4.z + S1[3] * r4.w;
      y0 = red16(y0); y1 = red16(y1);
      if (kq == 0) *(float2*)(sY + tl * 64 + rp * 2) = make_float2(y0, y1);
    }
    __syncthreads();
    { const int tl = tid >> 4, n4 = (tid & 15) * 4; const float4 yv = *(const float4*)(sY + tl * 64 + n4);
      uint2 o; o.x = pack2(yv.x, yv.y); o.y = pack2(yv.z, yv.w);
      *(uint2*)(p->SH + (row0 + tl) * 1024 + dir * 512 + h * 64 + n4) = o; }
  }
#undef RW_LOAD
#undef RW_T0
}

__device__ __forceinline__ void phase_f0(KParams p, int l) {
  const int tid = tidx(), wid = tid >> 6, lane = tid & 63;
  const float* mu = p->rwkv_mu + l * 2304; const float* lng = p->rwkv_ln_g + l * 512; const float* lnb = p->rwkv_ln_b + l * 512;
  for (int r = blockIdx.x; r < R; r += gridDim.x) {
    const int s = r % SB;
    if (l == 1 && s >= T) continue;
    const bool first = (s == 0) || (s == T), last = (s == T - 1) || (s == SB - 1);
    const int j = tid;
    const u16* p0 = p->P + (size_t)r * LDP + C_RW;
    float vv, gg;
    { const int cv = 1024 + j, cg_ = 1536 + j;
      const float c1 = bf2f(p0[cv]), l1 = first ? 0.f : bf2f(p0[cv - LDP]), n1 = last ? 0.f : bf2f(p0[cv + LDP]); vv = c1 + mu[cv] * (0.5f * (l1 + n1) - c1);
      const float c2 = bf2f(p0[cg_]), l2 = first ? 0.f : bf2f(p0[cg_ - LDP]), n2 = last ? 0.f : bf2f(p0[cg_ + LDP]); gg = c2 + mu[cg_] * (0.5f * (l2 + n2) - c2); }
    u16* yrow = p->SH + (size_t)r * 1024;
    const float y = bf2f(yrow[j]) + bf2f(yrow[512 + j]);
    const float mean = wave_sum(y) * (1.f / 64.f);
    const float dv = y - mean;
    const float var = wave_sum(dv * dv) * (1.f / 64.f);
    const float ln = dv * rsqrtf(var + 64e-5f) * lng[j] + lnb[j];
    const float bonus = p->bon[(size_t)r * 8 + wid] + p->bon[((size_t)R + r) * 8 + wid];
    yrow[j] = f2bf((ln + bonus * vv) * siluf_(gg));
  }
  const float* g_pre = p->g_pre + l * 1024; const float* modl = p->mod + (size_t)l * 17 * 3072;
  for (int r = blockIdx.x * 8 + wid; r < R; r += gridDim.x * 8) {
    const int b = r / SB, s = r % SB;
    if (l == 1 && s >= T) continue;
    const float* src = xrow_ptr(p, l, r);
    float4 v[4];
#pragma unroll
    for (int i = 0; i < 4; ++i) v[i] = *(const float4*)(src + i * 256 + lane * 4);
    hrow_write(v, g_pre, modl + (size_t)((s < T) ? b : 16) * 3072, p->P + (size_t)r * LDP + C_HRE, lane);
  }
}

__device__ __forceinline__ int rowtile_row0(int l, int i) { return l == 0 ? i * 256 : ((i >> 4) * 17 + (i & 15)) * 256; }
__device__ __forceinline__ int n_rowtiles(int l) { return l == 0 ? R / 256 : NB * 16; }

__device__ __forceinline__ void phase_f1(KParams p, int l, char* smem) {
  const u16* Wg = p->Wt_in + (size_t)l * DINP * 1024 + (size_t)C_MG * 1024;
  const u16* Wo = p->Wt_o + (size_t)l * 3 * 1024 * 512;
  uint4* park = (uint4*)(p->tmp + ((size_t)blockIdx.x * 512 + tidx()) * 32);
  int rti, nt;
  for (int it = 0; xcd_tile(it, n_rowtiles(l), 8, rti, nt); ++it) {
    const int row0 = rowtile_row0(l, rti);
    f32x16 accm[2][2];
#pragma unroll
    for (int mi = 0; mi < 2; ++mi)
#pragma unroll
      for (int ni = 0; ni < 2; ++ni)
#pragma unroll
        for (int r = 0; r < 16; ++r) accm[mi][ni][r] = 0.f;
#pragma unroll 1
    for (int i = 0; i < 3; ++i) {
      {
        f32x16 acc[2][2];
        gemm_kloop(p->P + (size_t)row0 * LDP + C_HRE, LDP, Wg + (size_t)(i * 1024 + nt * 128) * 1024, 1024, 1024, smem, acc);
#pragma unroll
        for (int mi = 0; mi < 2; ++mi)
#pragma unroll
          for (int ni = 0; ni < 2; ++ni)
#pragma unroll
            for (int r = 0; r < 16; r += 8) park[(mi * 2 + ni) * 2 + (r >> 3)] = make_uint4(pack2(sigmoidf_(acc[mi][ni][r]), sigmoidf_(acc[mi][ni][r + 1])), pack2(sigmoidf_(acc[mi][ni][r + 2]), sigmoidf_(acc[mi][ni][r + 3])),
                                                                                  pack2(sigmoidf_(acc[mi][ni][r + 4]), sigmoidf_(acc[mi][ni][r + 5])), pack2(sigmoidf_(acc[mi][ni][r + 6]), sigmoidf_(acc[mi][ni][r + 7])));
      }
      {
        f32x16 acc[2][2];
        const u16* Ai = (i == 0) ? p->P + (size_t)row0 * LDP + C_GV : (i == 1) ? p->P + (size_t)row0 * LDP + C_AQ : p->SH + (size_t)row0 * 1024;
        gemm_kloop(Ai, (i == 2) ? 1024 : LDP, Wo + (size_t)(i * 1024 + nt * 128) * 512, 512, 512, smem, acc);
#pragma unroll
        for (int mi = 0; mi < 2; ++mi)
#pragma unroll
          for (int ni = 0; ni < 2; ++ni)
#pragma unroll
            for (int r = 0; r < 16; r += 8) { const uint4 w = park[(mi * 2 + ni) * 2 + (r >> 3)];
              accm[mi][ni][r] += __uint_as_float(w.x << 16) * acc[mi][ni][r]; accm[mi][ni][r + 1] += __uint_as_float(w.x & 0xffff0000u) * acc[mi][ni][r + 1];
              accm[mi][ni][r + 2] += __uint_as_float(w.y << 16) * acc[mi][ni][r + 2]; accm[mi][ni][r + 3] += __uint_as_float(w.y & 0xffff0000u) * acc[mi][ni][r + 3];
              accm[mi][ni][r + 4] += __uint_as_float(w.z << 16) * acc[mi][ni][r + 4]; accm[mi][ni][r + 5] += __uint_as_float(w.z & 0xffff0000u) * acc[mi][ni][r + 5];
              accm[mi][ni][r + 6] += __uint_as_float(w.w << 16) * acc[mi][ni][r + 6]; accm[mi][ni][r + 7] += __uint_as_float(w.w & 0xffff0000u) * acc[mi][ni][r + 7]; }
      }
    }
    store_tile_bf16(accm, p->P + (size_t)row0 * LDP + C_M + nt * 128, LDP, 128);
  }
}
__device__ __forceinline__ void phase_f2(KParams p, int l, char* smem) {
  const u16* W = p->Wt_out + (size_t)l * 1024 * 1024;
  int rti, nt;
  for (int it = 0; xcd_tile(it, n_rowtiles(l), 8, rti, nt); ++it) {
    const int row0 = rowtile_row0(l, rti);
    f32x16 acc[2][2];
    gemm_kloop(p->P + (size_t)row0 * LDP + C_M, LDP, W + (size_t)nt * 128 * 1024, 1024, 1024, smem, acc);
    store_tile_bf16(acc, p->SH + (size_t)row0 * 1024 + nt * 128, 1024, 128);
  }
}
__device__ __forceinline__ void phase_f3(KParams p, int l) {
  const int wid = tidx() >> 6, lane = tidx() & 63;
  const float* g_post = p->g_post + l * 1024; const float* modl = p->mod + (size_t)l * 17 * 3072;
  for (int r = blockIdx.x * 8 + wid; r < R; r += gridDim.x * 8) {
    const int b = r / SB, s = r % SB;
    if (l == 1 && s >= T) continue;
    const float* src = xrow_ptr(p, l, r);
    float* dst = (s < T) ? p->out + ((size_t)b * T + s) * DM : p->xc1 + ((size_t)b * TC + (s - T)) * DM;
    const float* gate = modl + (size_t)((s < T) ? b : 16) * 3072 + 2048;
    u16* zrow = p->SH + (size_t)r * 1024;
    float z[4][4]; float ss = 0.f;
#pragma unroll
    for (int i = 0; i < 4; ++i) { const ushort4 u = *(const ushort4*)(zrow + i * 256 + lane * 4); z[i][0] = bf2f(u.x); z[i][1] = bf2f(u.y); z[i][2] = bf2f(u.z); z[i][3] = bf2f(u.w);
      ss += z[i][0] * z[i][0] + z[i][1] * z[i][1] + z[i][2] * z[i][2] + z[i][3] * z[i][3]; }
    ss = wave_sum(ss);
    const float rstd = rsqrtf(ss * (1.f / 1024.f) + 1e-6f);
    float4 o[4];
#pragma unroll
    for (int i = 0; i < 4; ++i) {
      const int col = i * 256 + lane * 4;
      const float4 g = *(const float4*)(g_post + col), gt = *(const float4*)(gate + col), xv = *(const float4*)(src + col);
      o[i].x = xv.x + gt.x * (z[i][0] * rstd * g.x); o[i].y = xv.y + gt.y * (z[i][1] * rstd * g.y);
      o[i].z = xv.z + gt.z * (z[i][2] * rstd * g.z); o[i].w = xv.w + gt.w * (z[i][3] * rstd * g.w);
      *(float4*)(dst + col) = o[i];
    }
    if (l == 0) hrow_write(o, p->g_pre + 1024, p->mod + (size_t)17 * 3072 + (size_t)((s < T) ? b : 16) * 3072, zrow, lane);
  }
}

constexpr int N_PHASES = 18;
#define LOADP() KParams p = kp; asm volatile("" : "+s"(p))
__global__ __launch_bounds__(512, 1) void megakernel(Params praw) {
  extern __shared__ __attribute__((aligned(16))) char smem[];
  const KParams kp = (KParams)__builtin_amdgcn_kernarg_segment_ptr();
  const int ph0 = praw.p0, ph1 = praw.p1;
  for (int ph = ph0; ph < ph1; ++ph) {
    const int l = (ph - 2) >> 3, sub = (ph - 2) & 7;
    if (ph == 0) { LOADP(); phase_prologue(p, smem); }
    else if (ph == 1) { LOADP(); phase_a0(p); }
    else if (sub == 0) { LOADP(); phase_a1(p, l, smem); }
    else if (sub == 1) { LOADP();
      for (int u = blockIdx.x; u < 256; u += gridDim.x) gla_state_unit(p, l, u, smem);
      attn_prep_all(p, l);
    } else if (sub == 2) {
      const int natt = 1024 + (l == 0 ? 64 : 0), nch = (l == 0 ? 68 : 64);
      for (int it = blockIdx.x; it < natt + NB * 4 * nch; it += gridDim.x) {
        if (it < natt) {
          int b, h, qrow0, krow0, seq;
          if (it < 1024) { b = it >> 6; h = (it >> 4) & 3; qrow0 = (it & 15) * 256; krow0 = 0; seq = SB; }
          else { const int u = it - 1024; b = u >> 2; h = u & 3; qrow0 = T; krow0 = T; seq = TC; }
          const int kvh = h >> 1;
          KParams q_ = kp; asm volatile("" : "+s"(q_)); u16* Pbase = q_->P;
          u16* Pq = Pbase + (size_t)(b * SB + qrow0) * LDP; const u16* Pk = Pbase + (size_t)(b * SB + krow0) * LDP;
          att::attn_dense_body((const bf16*)(Pq + C_AQ + h * 128), (const bf16*)(Pk + C_AK + kvh * 128), (const bf16*)(Pk + C_AV + kvh * 128),
                               Pq + C_AG + h * 128, Pq + C_AQ + h * 128, seq, smem);
        } else { LOADP(); const int g = it - natt; gla_out_tile(p, l, g / (nch * 4), (g / nch) & 3, g % nch, smem); }
      }
    } else if (sub == 3) { LOADP(); for (int u = blockIdx.x; u < 256; u += gridDim.x) rwkv_scan_unit(p, l, u, smem); }
    else if (sub == 4) { LOADP(); phase_f0(p, l); }
    else if (sub == 5) { LOADP(); phase_f1(p, l, smem); }
    else if (sub == 6) { LOADP(); phase_f2(p, l, smem); }
    else { LOADP(); phase_f3(p, l); }
    if (ph + 1 < ph1) cg::this_grid().sync();
  }
}

#ifndef MK_LAUNCHES
#define MK_LAUNCHES 1
#endif
static inline size_t al256(size_t x) { return (x + 255) / 256 * 256; }
extern "C" void kernel_launch(void* const* d_in, const int* in_sizes, int n_in, void* d_out, int out_size, void* d_ws, size_t ws_size, hipStream_t stream) {
  Params p{};
  const float** pf = (const float**)&p;
  for (int i = 0; i < 34; ++i) pf[i] = (const float*)d_in[i];
  p.out = (float*)d_out;
  char* ws = (char*)d_ws; size_t off = 0;
  auto take = [&](size_t bytes) { char* q = ws + off; off += al256(bytes); return q; };
  p.Wt_in = (u16*)take((size_t)2 * DINP * 1024 * 2);
  p.Wt_o = (u16*)take((size_t)2 * 3 * 1024 * 512 * 2);
  p.Wt_out = (u16*)take((size_t)2 * 1024 * 1024 * 2);
  p.mod = (float*)take((size_t)2 * 17 * 3072 * 4);
  p.bon = (float*)take((size_t)2 * R * 8 * 4);
  p.xc1 = (float*)take((size_t)NB * TC * DM * 4);
  p.SH = (u16*)take((size_t)R * 1024 * 2);
  p.P = (u16*)take((size_t)R * LDP * 2);
  p.tmp = (unsigned*)take((size_t)512 * 32 * 512 * 4);
  if (off > ws_size) { fprintf(stderr, "kernel_launch: workspace too small (%zu > %zu)\n", off, ws_size); return; }

  static int grid_blocks = 0;
  if (!grid_blocks) {
    if (hipFuncSetAttribute((const void*)megakernel, hipFuncAttributeMaxDynamicSharedMemorySize, SMEM_BYTES) != hipSuccess) { fprintf(stderr, "kernel_launch: LDS attribute failed\n"); return; }
    int dev = 0, cus = 0, per_cu = 0;
    (void)hipGetDevice(&dev);
    (void)hipDeviceGetAttribute(&cus, hipDeviceAttributeMultiprocessorCount, dev);
    (void)hipOccupancyMaxActiveBlocksPerMultiprocessor(&per_cu, megakernel, 512, SMEM_BYTES);
    if (per_cu < 1) { fprintf(stderr, "kernel_launch: occupancy query returned %d\n", per_cu); return; }
    grid_blocks = (cus * (per_cu > 1 ? 1 : per_cu)) / 8 * 8;
  }
#if MK_LAUNCHES == 1
  p.p0 = 0; p.p1 = N_PHASES;
  void* args[] = {&p};
  hipError_t e = hipLaunchCooperativeKernel((void*)megakernel, dim3(grid_blocks), dim3(512), args, SMEM_BYTES, stream);
  if (e != hipSuccess) fprintf(stderr, "cooperative launch failed: %s (grid %d)\n", hipGetErrorString(e), grid_blocks);
#else
  for (int ph = 0; ph < N_PHASES; ++ph) { p.p0 = ph; p.p1 = ph + 1; hipLaunchKernelGGL(megakernel, dim3(grid_blocks), dim3(512), SMEM_BYTES, stream, p); }
#endif
}
```

```cpp
#include <hip/hip_runtime.h>
#include <hip/hip_bf16.h>
#include <hip/hip_cooperative_groups.h>
#include <stdint.h>
#include <cstdio>
namespace cg = cooperative_groups;

typedef unsigned short u16;
using bf16 = __hip_bfloat16;
using bf16x8 = __attribute__((ext_vector_type(8))) short;
using s16x4  = __attribute__((ext_vector_type(4))) short;
using f32x16 = __attribute__((ext_vector_type(16))) float;
using f32x8  = __attribute__((ext_vector_type(8))) float;
using u32x4  = __attribute__((ext_vector_type(4))) unsigned;

constexpr int NB = 16, T = 4096, TC = 256, SB = T + TC;
constexpr int R = NB * SB;
constexpr int DM = 1024, DIN = 8480, DINP = 8576;
constexpr int LDP = 5408;
constexpr int NT_P = 43;
constexpr int C_GQ = 0, C_GK = 256, C_GV = 512, C_GG = 1024, C_GWF = 1536;
constexpr int C_AQ = 1568, C_AK = 2080, C_AV = 2336, C_AG = 2592;
constexpr int C_RW = 3104;
constexpr int C_MG = 5408;
constexpr int C_HRE = C_AK;
constexpr int C_M = C_RW;
constexpr int SMEM_BYTES = 147456;

struct Params {
  const float *x, *c, *ctx, *c_ctx, *w_mod, *b_mod, *g_pre, *w_in, *gla_wup_f, *gla_b_f, *gla_wup_b, *gla_b_b, *gla_norm, *att_qnorm, *att_knorm,
      *rwkv_mu, *rwkv_w0_f, *rwkv_wup_f, *rwkv_w0_b, *rwkv_wup_b, *rwkv_a0_f, *rwkv_aup_f, *rwkv_a0_b, *rwkv_aup_b, *rwkv_kk, *rwkv_ka, *rwkv_rk,
      *rwkv_ln_g, *rwkv_ln_b, *w_o_gla, *w_o_att, *w_o_rwkv, *w_out, *g_post;
  float* out; u16* Wt_in; u16* Wt_o; u16* Wt_out; float* mod; float* bon; float* xc1; u16* SH; u16* P; unsigned* tmp;
  int p0, p1;
};
typedef const __attribute__((address_space(4))) Params* KParams;

__device__ __forceinline__ int tidx() { int t = threadIdx.x; asm volatile("" : "+v"(t)); return t; }
__device__ __forceinline__ float bf2f(u16 v) { return __uint_as_float(((unsigned)v) << 16); }
__device__ __forceinline__ u16 f2bf(float x) { unsigned u = __float_as_uint(x); u += 0x7fffu + ((u >> 16) & 1u); return (u16)(u >> 16); }
__device__ __forceinline__ float shfl_xor_f(float v, int m) { const int lane = tidx() & 63; return __builtin_bit_cast(float, __builtin_amdgcn_ds_bpermute((lane ^ m) << 2, __builtin_bit_cast(int, v))); }
__device__ __forceinline__ float wave_sum(float v) {
#pragma unroll
  for (int m = 32; m >= 1; m >>= 1) v += shfl_xor_f(v, m);
  return v;
}
__device__ __forceinline__ float sigmoidf_(float x) { return 1.f / (1.f + __expf(-x)); }
__device__ __forceinline__ float siluf_(float x) { return x / (1.f + __expf(-x)); }
__device__ __forceinline__ int crow(int r, int hi) { return (r & 3) + 8 * (r >> 2) + 4 * hi; }
__device__ __forceinline__ void unpack8(uint4 u, float* f) {
  f[0] = __uint_as_float(u.x << 16); f[1] = __uint_as_float(u.x & 0xffff0000u); f[2] = __uint_as_float(u.y << 16); f[3] = __uint_as_float(u.y & 0xffff0000u);
  f[4] = __uint_as_float(u.z << 16); f[5] = __uint_as_float(u.z & 0xffff0000u); f[6] = __uint_as_float(u.w << 16); f[7] = __uint_as_float(u.w & 0xffff0000u);
}
__device__ __forceinline__ unsigned pack2(float a, float b) { return (unsigned)f2bf(a) | ((unsigned)f2bf(b) << 16); }
template <int CTRL> __device__ __forceinline__ float dpp_f(float x) {
  return __builtin_bit_cast(float, __builtin_amdgcn_update_dpp(0, __builtin_bit_cast(int, x), CTRL, 0xF, 0xF, true));
}
__device__ __forceinline__ float red4(float x) { x += dpp_f<0xB1>(x); x += dpp_f<0x4E>(x); return x; }
__device__ __forceinline__ float red8(float x) { x = red4(x); x += dpp_f<0x141>(x); return x; }
__device__ __forceinline__ float red16(float x) { x += dpp_f<0xB1>(x); x += dpp_f<0x4E>(x); x += dpp_f<0x141>(x); x += dpp_f<0x140>(x); return x; }

constexpr int GLS = 72;
constexpr int GEMM_SMEM = 2 * (256 * GLS + 128 * GLS) * 2;
__device__ __forceinline__ void gemm_kloop(const u16* __restrict__ A, int lda, const u16* __restrict__ Bt, int ldb, int K, char* smem, f32x16 (&acc)[2][2]) {
  u16* As = (u16*)smem; u16* Bs = As + 2 * 256 * GLS;
  const int tid = tidx(), wid = tid >> 6, lane = tid & 63, r32 = lane & 31, hi = lane >> 5;
  const int wm = wid >> 1, wn = wid & 1;
#pragma unroll
  for (int mi = 0; mi < 2; ++mi)
#pragma unroll
    for (int ni = 0; ni < 2; ++ni)
#pragma unroll
      for (int r = 0; r < 16; ++r) acc[mi][ni][r] = 0.f;
  uint4 xa0, xa1, xa2, xa3, xb0, xb1, ya0, ya1, ya2, ya3, yb0, yb1;
  const int nk = K / 64;
  const int lrow = tid >> 3, lkc = tid & 7;
  const u16* gA = A + (size_t)lrow * lda + lkc * 8;
  const u16* gB = Bt + (size_t)lrow * ldb + lkc * 8;
  const size_t sA = (size_t)64 * lda, sB = (size_t)64 * ldb;
  u16* wA = As + lrow * GLS + lkc * 8; u16* wB = Bs + lrow * GLS + lkc * 8;
#define GLOAD(R, kt) do { const u16* pa_ = gA + (kt) * 64; const u16* pb_ = gB + (kt) * 64; \
    R##a0 = *(const uint4*)(pa_); R##a1 = *(const uint4*)(pa_ + sA); R##a2 = *(const uint4*)(pa_ + 2 * sA); R##a3 = *(const uint4*)(pa_ + 3 * sA); \
    R##b0 = *(const uint4*)(pb_); R##b1 = *(const uint4*)(pb_ + sB); } while (0)
#define SWRITE(R, buf) do { u16* qa_ = wA + (buf) * 256 * GLS; u16* qb_ = wB + (buf) * 128 * GLS; \
    *(uint4*)(qa_) = R##a0; *(uint4*)(qa_ + 64 * GLS) = R##a1; *(uint4*)(qa_ + 128 * GLS) = R##a2; *(uint4*)(qa_ + 192 * GLS) = R##a3; \
    *(uint4*)(qb_) = R##b0; *(uint4*)(qb_ + 64 * GLS) = R##b1; } while (0)
#define COMPUTE(buf) do { const u16* Ab = As + (buf) * 256 * GLS + (wm * 64 + r32) * GLS + hi * 8; const u16* Bb = Bs + (buf) * 128 * GLS + (wn * 64 + r32) * GLS + hi * 8; \
    _Pragma("unroll") for (int ks = 0; ks < 4; ++ks) { \
      bf16x8 a0 = *(const bf16x8*)(Ab + ks * 16), a1 = *(const bf16x8*)(Ab + 32 * GLS + ks * 16); \
      bf16x8 b0 = *(const bf16x8*)(Bb + ks * 16), b1 = *(const bf16x8*)(Bb + 32 * GLS + ks * 16); \
      acc[0][0] = __builtin_amdgcn_mfma_f32_32x32x16_bf16(a0, b0, acc[0][0], 0, 0, 0); \
      acc[0][1] = __builtin_amdgcn_mfma_f32_32x32x16_bf16(a0, b1, acc[0][1], 0, 0, 0); \
      acc[1][0] = __builtin_amdgcn_mfma_f32_32x32x16_bf16(a1, b0, acc[1][0], 0, 0, 0); \
      acc[1][1] = __builtin_amdgcn_mfma_f32_32x32x16_bf16(a1, b1, acc[1][1], 0, 0, 0); } } while (0)
  GLOAD(x, 0); GLOAD(y, 1);
  SWRITE(x, 0); GLOAD(x, 2);
  __syncthreads();
  for (int kt = 0; kt < nk; kt += 2) {
    COMPUTE(0);
    SWRITE(y, 1);
    if (kt + 3 < nk) GLOAD(y, kt + 3);
    __syncthreads();
    COMPUTE(1);
    if (kt + 2 < nk) { SWRITE(x, 0); if (kt + 4 < nk) GLOAD(x, kt + 4); }
    __syncthreads();
  }
#undef COMPUTE
#undef GLOAD
#undef SWRITE
}
__device__ __forceinline__ void store_tile_bf16(const f32x16 (&acc)[2][2], u16* __restrict__ C, int ldc, int ncols) {
  const int wid = tidx() >> 6, lane = tidx() & 63, r32 = lane & 31, hi = lane >> 5, wm = wid >> 1, wn = wid & 1;
#pragma unroll
  for (int mi = 0; mi < 2; ++mi)
#pragma unroll
    for (int ni = 0; ni < 2; ++ni) {
      const int col = wn * 64 + ni * 32 + r32;
      if (col < ncols) {
#pragma unroll
        for (int r = 0; r < 16; ++r) C[(size_t)(wm * 64 + mi * 32 + crow(r, hi)) * ldc + col] = f2bf(acc[mi][ni][r]);
      }
    }
}

namespace att {
constexpr int D = 128, NW = 8, QBLK = 32, KVBLK = 64;
constexpr float SCALE = 0.088388347648318440f;
constexpr float THR = 8.f;
constexpr int LDQ = LDP, LDK = LDP;
constexpr size_t SHM_V = KVBLK * D * 2, SHM_K = KVBLK * D * 2, SHM_ATTN = 2 * SHM_V + 2 * SHM_K + NW * 64 * 4;
#define KSWZ(row, colB) ((row) * 256 + ((colB) ^ (((row) & 7) << 4)))
#define SBAR() __builtin_amdgcn_sched_barrier(0)
__device__ __forceinline__ unsigned cvtpk(float lo, float hi) {
  unsigned r; asm volatile("v_cvt_pk_bf16_f32 %0, %1, %2" : "=v"(r) : "v"(lo), "v"(hi)); return r;
}
__device__ __forceinline__ bf16x8 ld8(const bf16* p) { return *reinterpret_cast<const bf16x8*>(p); }
__device__ __forceinline__ void partialSM(f32x16& p0, f32x16& p1, float& m_reg, float& mn, float& alpha) {
  constexpr float C = SCALE * 1.4426950408889634f;
  float pmax = p0[0]; for (int r = 1; r < 16; ++r) pmax = fmaxf(pmax, p0[r]); for (int r = 0; r < 16; ++r) pmax = fmaxf(pmax, p1[r]);
  { auto rr = __builtin_amdgcn_permlane32_swap(__float_as_uint(pmax), __float_as_uint(pmax), false, false);
    pmax = fmaxf(__uint_as_float(rr[0]), __uint_as_float(rr[1])); }
  if (__builtin_expect(__all(pmax - m_reg <= THR / SCALE), 1)) { mn = m_reg; alpha = 1.f; }
  else { mn = fmaxf(m_reg, pmax); alpha = __builtin_amdgcn_exp2f((m_reg - mn) * C); m_reg = mn; }
  float mnC = -mn * C;
  for (int r = 0; r < 16; ++r) p0[r] = fmaf(p0[r], C, mnC); for (int r = 0; r < 16; ++r) p1[r] = fmaf(p1[r], C, mnC);
  for (int r = 0; r < 16; ++r) p0[r] = __builtin_amdgcn_exp2f(p0[r]);
}
__device__ __forceinline__ void finishSM(f32x16& p0, f32x16& p1, float alpha, float& l_reg, bf16x8& pa0, bf16x8& pa1, bf16x8& pa2, bf16x8& pa3) {
  for (int r = 0; r < 16; ++r) p1[r] = __builtin_amdgcn_exp2f(p1[r]);
  float ps = 0; for (int r = 0; r < 16; ++r) ps += p0[r]; for (int r = 0; r < 16; ++r) ps += p1[r];
  { auto rr = __builtin_amdgcn_permlane32_swap(__float_as_uint(ps), __float_as_uint(ps), false, false);
    ps = __uint_as_float(rr[0]) + __uint_as_float(rr[1]); }
  l_reg = l_reg * alpha + ps;
#define PK4(P, BASE, OUT) do { unsigned a0 = cvtpk(P[BASE + 0], P[BASE + 1]), a1 = cvtpk(P[BASE + 2], P[BASE + 3]);   \
    unsigned b0 = cvtpk(P[BASE + 4], P[BASE + 5]), b1 = cvtpk(P[BASE + 6], P[BASE + 7]);                              \
    auto r0 = __builtin_amdgcn_permlane32_swap(a0, b0, false, false); auto r1 = __builtin_amdgcn_permlane32_swap(a1, b1, false, false); \
    u32x4 w = {r0[0], r1[0], r0[1], r1[1]}; OUT = *reinterpret_cast<bf16x8*>(&w); } while (0)
  PK4(p0, 0, pa0); PK4(p0, 8, pa1); PK4(p1, 0, pa2); PK4(p1, 8, pa3);
#undef PK4
}
__device__ __forceinline__ void qkt(f32x16& p0, f32x16& p1, const bf16* Ks, const bf16x8* qr, int r32, int hi) {
  p0 = f32x16{}; p1 = f32x16{};
  for (int d0 = 0; d0 < 8; ++d0) { int cb = (d0 * 16 + hi * 8) * 2;
    bf16x8 b0 = *reinterpret_cast<const bf16x8*>((const char*)Ks + KSWZ(r32, cb));
    bf16x8 b1 = *reinterpret_cast<const bf16x8*>((const char*)Ks + KSWZ(32 + r32, cb));
    p0 = __builtin_amdgcn_mfma_f32_32x32x16_bf16(b0, qr[d0], p0, 0, 0, 0);
    p1 = __builtin_amdgcn_mfma_f32_32x32x16_bf16(b1, qr[d0], p1, 0, 0, 0); }
}
__device__ __forceinline__ int v_st(int k, int c) { const int kk = (k & ~0xC) | ((k & 4) << 1) | ((k & 8) >> 1); return ((kk >> 3) * 4 + (c >> 5)) * 512 + ((kk & 7) * 32 + (c & 31)) * 2; }
__device__ __forceinline__ int v_rd_base(int lane) { return ((lane & 3) << 3) | (((lane >> 2) & 3) << 6) | (((lane >> 4) & 1) << 5) | (((lane >> 5) & 1) << 8); }
constexpr int v_rd_off(int d0, int ks, int half) { return d0 * 512 + ks * 4096 + half * 2048; }
template <int OFF> __device__ __forceinline__ s16x4 tr_read(int vb) {
  s16x4 r; asm volatile("ds_read_b64_tr_b16 %0, %1 offset:%2" : "=&v"(r) : "v"(vb), "i"(OFF) : "memory"); return r;
}
template <int D0> __device__ __forceinline__ void pv_one(f32x16& od, int vb, bf16x8 pa0, bf16x8 pa1, bf16x8 pa2, bf16x8 pa3) {
  const s16x4 l0 = tr_read<v_rd_off(D0, 0, 0)>(vb), h0 = tr_read<v_rd_off(D0, 0, 1)>(vb), l1 = tr_read<v_rd_off(D0, 1, 0)>(vb), h1 = tr_read<v_rd_off(D0, 1, 1)>(vb);
  const s16x4 l2 = tr_read<v_rd_off(D0, 2, 0)>(vb), h2 = tr_read<v_rd_off(D0, 2, 1)>(vb), l3 = tr_read<v_rd_off(D0, 3, 0)>(vb), h3 = tr_read<v_rd_off(D0, 3, 1)>(vb);
  asm volatile("s_waitcnt lgkmcnt(0)" ::: "memory"); SBAR();
#define PK(L, H) (bf16x8){L[0], L[1], L[2], L[3], H[0], H[1], H[2], H[3]}
  od = __builtin_amdgcn_mfma_f32_32x32x16_bf16(pa0, PK(l0, h0), od, 0, 0, 0);
  od = __builtin_amdgcn_mfma_f32_32x32x16_bf16(pa1, PK(l1, h1), od, 0, 0, 0);
  od = __builtin_amdgcn_mfma_f32_32x32x16_bf16(pa2, PK(l2, h2), od, 0, 0, 0);
  od = __builtin_amdgcn_mfma_f32_32x32x16_bf16(pa3, PK(l3, h3), od, 0, 0, 0);
#undef PK
}
__device__ __forceinline__ void pv_d0(f32x16* o, int vb, bf16x8 pa0, bf16x8 pa1, bf16x8 pa2, bf16x8 pa3) {
  pv_one<0>(o[0], vb, pa0, pa1, pa2, pa3); pv_one<1>(o[1], vb, pa0, pa1, pa2, pa3); pv_one<2>(o[2], vb, pa0, pa1, pa2, pa3); pv_one<3>(o[3], vb, pa0, pa1, pa2, pa3);
}
__device__ __forceinline__ void attn_dense_body(const bf16* Qb, const bf16* __restrict__ Kh, const bf16* __restrict__ Vh,
                                                const u16* __restrict__ Gb, u16* Yb, int seq, char* lds) {
  const int tid = tidx(), wid = tid >> 6, lane = tid & 63, r32 = lane & 31, hi = lane >> 5;
  bf16* V_lds = (bf16*)lds; bf16* K_lds = (bf16*)(lds + 2 * SHM_V);
  float* ws = (float*)(lds + 2 * SHM_V + 2 * SHM_K) + wid * 64; float* li_l = ws; float* al_l = ws + 32;
  float m_reg = -1e30f, l_reg = 0; f32x16 o[4] = {}; bf16x8 qr[8];
  const bf16* Qw = Qb + (long)(wid * QBLK + r32) * LDQ + hi * 8;
#pragma unroll
  for (int d0 = 0; d0 < 8; ++d0) qr[d0] = ld8(Qw + d0 * 16);
  const int sr = tid >> 4, sc = (tid & 15) * 8, vst0 = v_st(sr, sc), vst1 = v_st(32 + sr, sc);
  const int vb0 = (int)(uintptr_t)V_lds + v_rd_base(lane);
  struct { bf16x8 vs0, vs1, ks0, ks1; } sr_[2];
#define SLOAD(i, k0) do { sr_[i].vs0 = ld8(&Vh[(long)((k0) + sr) * LDK + sc]); sr_[i].vs1 = ld8(&Vh[(long)((k0) + 32 + sr) * LDK + sc]); \
    sr_[i].ks0 = ld8(&Kh[(long)((k0) + sr) * LDK + sc]); sr_[i].ks1 = ld8(&Kh[(long)((k0) + 32 + sr) * LDK + sc]); } while (0)
#define SWRITE(b, i) do { *(bf16x8*)((char*)V_lds + (b) * SHM_V + vst0) = sr_[i].vs0;          \
    *(bf16x8*)((char*)V_lds + (b) * SHM_V + vst1) = sr_[i].vs1; int kc = sc * 2;               \
    *(bf16x8*)((char*)K_lds + (b) * SHM_K + KSWZ(sr, kc)) = sr_[i].ks0;                       \
    *(bf16x8*)((char*)K_lds + (b) * SHM_K + KSWZ(32 + sr, kc)) = sr_[i].ks1; } while (0)
#define SWAIT() do { asm volatile("s_waitcnt vmcnt(4)" ::: "memory"); } while (0)
#define RESC(a) do { if (__any((a) < 1.f)) { if (hi == 0) al_l[r32] = (a); asm volatile("s_waitcnt lgkmcnt(0)" ::: "memory"); \
    for (int d = 0; d < 4; ++d) for (int r = 0; r < 16; ++r) o[d][r] *= al_l[crow(r, hi)]; } } while (0)
  f32x16 pA0, pA1, pB0, pB1; float mnA, mnB, alA, alB; bf16x8 pa0, pa1, pa2, pa3; const int NT = seq / KVBLK;
  constexpr int SE = 0, SO = 1;
  SLOAD(SE, 0); asm volatile("s_waitcnt vmcnt(0)" ::: "memory"); SWRITE(0, SE); __syncthreads();
  qkt(pA0, pA1, K_lds, qr, r32, hi); partialSM(pA0, pA1, m_reg, mnA, alA);
  SLOAD(SO, KVBLK); if (2 < NT) SLOAD(SE, 2 * KVBLK);
  SWAIT(); SWRITE(1, SO); __syncthreads();
  for (int j = 1; j + 1 < NT; j += 2) {
    SBAR(); qkt(pB0, pB1, (bf16*)((char*)K_lds + SHM_K), qr, r32, hi);
    finishSM(pA0, pA1, alA, l_reg, pa0, pa1, pa2, pa3); SBAR();
    SLOAD(SO, (j + 2) * KVBLK); SBAR();
    pv_d0(o, vb0, pa0, pa1, pa2, pa3); partialSM(pB0, pB1, m_reg, mnB, alB);
    __syncthreads(); SWAIT(); SWRITE(0, SE);
    RESC(alB); __syncthreads();
    SBAR(); qkt(pA0, pA1, K_lds, qr, r32, hi);
    finishSM(pB0, pB1, alB, l_reg, pa0, pa1, pa2, pa3); SBAR();
    if (j + 3 < NT) SLOAD(SE, (j + 3) * KVBLK); SBAR();
    pv_d0(o, vb0 + (int)SHM_V, pa0, pa1, pa2, pa3); partialSM(pA0, pA1, m_reg, mnA, alA);
    __syncthreads(); SWAIT(); SWRITE(1, SO);
    RESC(alA); __syncthreads();
  }
  SBAR(); qkt(pB0, pB1, (bf16*)((char*)K_lds + SHM_K), qr, r32, hi);
  finishSM(pA0, pA1, alA, l_reg, pa0, pa1, pa2, pa3); SBAR();
  pv_d0(o, vb0, pa0, pa1, pa2, pa3); partialSM(pB0, pB1, m_reg, mnB, alB);
  __syncthreads(); RESC(alB);
  finishSM(pB0, pB1, alB, l_reg, pa0, pa1, pa2, pa3); SBAR();
  pv_d0(o, vb0 + (int)SHM_V, pa0, pa1, pa2, pa3);
  if (hi == 0) li_l[r32] = l_reg; asm volatile("s_waitcnt lgkmcnt(0)" ::: "memory");
  float rli[16];
#pragma unroll
  for (int r = 0; r < 16; ++r) rli[r] = __builtin_amdgcn_rcpf(li_l[crow(r, hi)]);
#pragma unroll
  for (int r = 0; r < 16; ++r) { const long orow = wid * QBLK + crow(r, hi);
#pragma unroll
    for (int d0 = 0; d0 < 4; ++d0) {
      const float gt = bf2f(Gb[orow * LDQ + d0 * 32 + r32]);
      Yb[orow * LDQ + d0 * 32 + r32] = f2bf(o[d0][r] * rli[r] * siluf_(gt));
    } }
  __syncthreads();
#undef SLOAD
#undef SWRITE
#undef SWAIT
#undef RESC
}
}

__device__ __forceinline__ const float* xrow_ptr(KParams p, int l, int r) {
  const int b = r / SB, s = r % SB;
  if (s < T) return (l == 0 ? p->x : (const float*)p->out) + ((size_t)b * T + s) * DM;
  return (l == 0 ? p->ctx : (const float*)p->xc1) + ((size_t)b * TC + (s - T)) * DM;
}
__device__ __forceinline__ void hrow_write(const float4 (&v)[4], const float* __restrict__ g_pre, const float* __restrict__ md, u16* dst, int lane) {
  float ss = 0.f;
#pragma unroll
  for (int i = 0; i < 4; ++i) ss += v[i].x * v[i].x + v[i].y * v[i].y + v[i].z * v[i].z + v[i].w * v[i].w;
  ss = wave_sum(ss);
  const float rstd = rsqrtf(ss * (1.f / 1024.f) + 1e-6f);
#pragma unroll
  for (int i = 0; i < 4; ++i) {
    const int col = i * 256 + lane * 4;
    const float4 g = *(const float4*)(g_pre + col), sc = *(const float4*)(md + 1024 + col), sh = *(const float4*)(md + col);
    ushort4 o;
    o.x = f2bf(v[i].x * rstd * g.x * (1.f + sc.x) + sh.x); o.y = f2bf(v[i].y * rstd * g.y * (1.f + sc.y) + sh.y);
    o.z = f2bf(v[i].z * rstd * g.z * (1.f + sc.z) + sh.z); o.w = f2bf(v[i].w * rstd * g.w * (1.f + sc.w) + sh.w);
    *(ushort4*)(dst + col) = o;
  }
}

__device__ __forceinline__ void transpose_tile(const float* __restrict__ src, u16* __restrict__ dst, int K, int N, int nt, int kt, char* smem) {
  float* tile = (float*)smem;
  const int n0 = nt * 64, k0 = kt * 64, tx = tidx() & 63, ty = tidx() >> 6;
  __syncthreads();
#pragma unroll
  for (int i = 0; i < 8; ++i) { const int k = i * 8 + ty, n = n0 + tx; tile[k * 65 + tx] = (n < N) ? src[(size_t)(k0 + k) * N + n] : 0.f; }
  __syncthreads();
#pragma unroll
  for (int i = 0; i < 8; ++i) { const int n = i * 8 + ty; dst[(size_t)(n0 + n) * K + k0 + tx] = f2bf(tile[tx * 65 + n]); }
}
__device__ __forceinline__ void mod_item(KParams p, int item, char* smem) {
  float* sc = (float*)smem;
  float* red = sc + 17 * 512;
  const int l = item / 48, cgp = item % 48, tid = tidx(), kg = tid >> 6, jl = tid & 63, j = cgp * 64 + jl;
  const float* W = p->w_mod + (size_t)l * 1024 * 3072;
  float acc[17];
#pragma unroll
  for (int i = 0; i < 17; ++i) acc[i] = 0.f;
  for (int half = 0; half < 2; ++half) {
    __syncthreads();
    for (int e = tid; e < 17 * 512; e += 512) { const int i = e >> 9, k = e & 511; const float v = (i < 16) ? p->c[i * 1024 + half * 512 + k] : p->c_ctx[half * 512 + k]; sc[e] = siluf_(v); }
    __syncthreads();
    for (int kk = 0; kk < 64; ++kk) {
      const int k = kg * 64 + kk;
      const float w = W[(size_t)(half * 512 + k) * 3072 + j];
#pragma unroll
      for (int i = 0; i < 17; ++i) acc[i] += sc[i * 512 + k] * w;
    }
  }
#pragma unroll
  for (int i = 0; i < 17; ++i) red[(kg * 17 + i) * 64 + jl] = acc[i];
  __syncthreads();
  for (int e = tid; e < 17 * 64; e += 512) { const int i = e >> 6, jj = e & 63;
    float v = p->b_mod[l * 3072 + cgp * 64 + jj];
#pragma unroll
    for (int g = 0; g < 8; ++g) v += red[(g * 17 + i) * 64 + jj];
    p->mod[((size_t)l * 17 + i) * 3072 + cgp * 64 + jj] = v; }
}
__device__ __forceinline__ void phase_prologue(KParams p, char* smem) {
  constexpr int N_IN = 2 * 134 * 16, N_O = 2 * 3 * 16 * 8, N_OUT = 2 * 16 * 16, N_MOD = 96;
  for (int it = blockIdx.x; it < N_IN + N_O + N_OUT + N_MOD; it += gridDim.x) {
    if (it < N_MOD) mod_item(p, it, smem);
    else if (it < N_MOD + N_IN) { const int u = it - N_MOD, l = u / (134 * 16), v = u % (134 * 16);
      transpose_tile(p->w_in + (size_t)l * 1024 * DIN, p->Wt_in + (size_t)l * DINP * 1024, 1024, DIN, v % 134, v / 134, smem); }
    else if (it < N_MOD + N_IN + N_O) { const int u = it - N_MOD - N_IN, li = u / 128, v = u % 128, l = li / 3, i = li % 3;
      const float* src = (i == 0 ? p->w_o_gla : i == 1 ? p->w_o_att : p->w_o_rwkv) + (size_t)l * 512 * 1024;
      transpose_tile(src, p->Wt_o + (size_t)li * 1024 * 512, 512, 1024, v % 16, v / 16, smem); }
    else { const int u = it - N_MOD - N_IN - N_O, l = u / 256, v = u % 256;
      transpose_tile(p->w_out + (size_t)l * 1024 * 1024, p->Wt_out + (size_t)l * 1024 * 1024, 1024, 1024, v % 16, v / 16, smem); }
  }
}

__device__ __forceinline__ void phase_a0(KParams p) {
  const int wid = tidx() >> 6, lane = tidx() & 63;
  for (int r = blockIdx.x * 8 + wid; r < R; r += gridDim.x * 8) {
    const int b = r / SB, s = r % SB;
    const float* src = xrow_ptr(p, 0, r);
    float4 v[4];
#pragma unroll
    for (int i = 0; i < 4; ++i) v[i] = *(const float4*)(src + i * 256 + lane * 4);
    hrow_write(v, p->g_pre, p->mod + (size_t)((s < T) ? b : 16) * 3072, p->SH + (size_t)r * 1024, lane);
  }
}
__device__ __forceinline__ bool xcd_tile(int i, int nrt, int nnt, int& rt, int& nt) {
  const int x = blockIdx.x & 7, j = blockIdx.x >> 3, nb = gridDim.x >> 3;
  const int rpx = nrt >> 3;
  const int q = i * nb + j;
  if (q >= rpx * nnt) return false;
  const int g = q / (4 * nnt), r = q % (4 * nnt);
  const int gs = (rpx - g * 4) < 4 ? (rpx - g * 4) : 4;
  rt = x * rpx + g * 4 + r % gs; nt = r / gs;
  return true;
}
__device__ __forceinline__ void phase_a1(KParams p, int l, char* smem) {
  const u16* W = p->Wt_in + (size_t)l * DINP * 1024;
  int mt, nt;
  for (int i = 0; xcd_tile(i, R / 256, NT_P, mt, nt); ++i) {
    f32x16 acc[2][2];
    gemm_kloop(p->SH + (size_t)mt * 256 * 1024, 1024, W + (size_t)nt * 128 * 1024, 1024, 1024, smem, acc);
    store_tile_bf16(acc, p->P + (size_t)mt * 256 * LDP + nt * 128, LDP, LDP - nt * 128);
  }
}

__device__ __forceinline__ void attn_prep_all(KParams p, int l) {
  const float* qn = p->att_qnorm + l * 128; const float* kn = p->att_knorm + l * 128;
  const int tid = tidx(), k = tid & 15;
  const float inv0 = exp2f(-(float)(2 * k) * (13.287712379549449f / 32.f)), inv1 = exp2f(-(float)(2 * k + 1) * (13.287712379549449f / 32.f));
  for (long item = (long)blockIdx.x * 32 + (tid >> 4); item < (long)R * 6; item += (long)gridDim.x * 32) {
    const int r = (int)(item / 6), hh = (int)(item % 6), s = r % SB;
    const int col = (hh < 4) ? C_AQ + hh * 128 : C_AK + (hh - 4) * 128;
    const float* gw = (hh < 4) ? qn : kn;
    unsigned* pp = (unsigned*)(p->P + (size_t)r * LDP + col);
    const unsigned w0 = pp[k], w1 = pp[16 + k], w2 = pp[32 + k], w3 = pp[48 + k];
    float a0 = __uint_as_float(w0 << 16), a1 = __uint_as_float(w0 & 0xffff0000u), b0 = __uint_as_float(w1 << 16), b1 = __uint_as_float(w1 & 0xffff0000u);
    float c0 = __uint_as_float(w2 << 16), c1 = __uint_as_float(w2 & 0xffff0000u), d0 = __uint_as_float(w3 << 16), d1 = __uint_as_float(w3 & 0xffff0000u);
    const float ss = red16(a0 * a0 + a1 * a1 + b0 * b0 + b1 * b1 + c0 * c0 + c1 * c1 + d0 * d0 + d1 * d1);
    const float rstd = rsqrtf(ss * (1.f / 128.f) + 1e-6f);
    const float2 ga = *(const float2*)(gw + 2 * k), gb = *(const float2*)(gw + 32 + 2 * k), gc = *(const float2*)(gw + 64 + 2 * k), gd = *(const float2*)(gw + 96 + 2 * k);
    a0 *= rstd * ga.x; a1 *= rstd * ga.y; b0 *= rstd * gb.x; b1 *= rstd * gb.y; c0 *= rstd * gc.x; c1 *= rstd * gc.y; d0 *= rstd * gd.x; d1 *= rstd * gd.y;
    if (s < T) {
      const float pr = (float)(s >> 6), pc = (float)(s & 63);
      const float cr0 = __cosf(pr * inv0), sr0 = __sinf(pr * inv0), cr1 = __cosf(pr * inv1), sr1 = __sinf(pr * inv1);
      const float cc0 = __cosf(pc * inv0), sc0 = __sinf(pc * inv0), cc1 = __cosf(pc * inv1), sc1 = __sinf(pc * inv1);
      const float na0 = a0 * cr0 - b0 * sr0, nb0 = b0 * cr0 + a0 * sr0, na1 = a1 * cr1 - b1 * sr1, nb1 = b1 * cr1 + a1 * sr1;
      const float nc0 = c0 * cc0 - d0 * sc0, nd0 = d0 * cc0 + c0 * sc0, nc1 = c1 * cc1 - d1 * sc1, nd1 = d1 * cc1 + c1 * sc1;
      a0 = na0; b0 = nb0; a1 = na1; b1 = nb1; c0 = nc0; d0 = nd0; c1 = nc1; d1 = nd1;
    }
    pp[k] = pack2(a0, a1); pp[16 + k] = pack2(b0, b1); pp[32 + k] = pack2(c0, c1); pp[48 + k] = pack2(d0, d1);
  }
}

__device__ __forceinline__ float logsig16(float x) { return (fminf(x, 0.f) - log1pf(__expf(-fabsf(x)))) * (1.f / 16.f); }
__device__ __forceinline__ void gla_state_unit(KParams p, int l, int unit, char* smem) {
  const int dir = unit & 1, h = (unit >> 1) & 3, b = unit >> 3;
  float* gc = (float*)smem;
  float* segtot = gc + 4096;
  float* lr = segtot + 512;
  float* dec = lr + 1024;
  u16* KT = (u16*)(dec + 64);
  u16* VT = KT + 64 * 72;
  const int tid = tidx(), wid = tid >> 6, lane = tid & 63, r32 = lane & 31, hi = lane >> 5, mi = wid >> 2, ni = wid & 3;
  const int dd = tid & 63, seg = tid >> 6;
  const int ts = tid >> 3, td0 = (tid & 7) * 8;
  const float* wup = (dir ? p->gla_wup_b : p->gla_wup_f) + l * 16 * 256 + h * 64 + dd;
  float wu[16];
#pragma unroll
  for (int i = 0; i < 16; ++i) wu[i] = wup[i * 256];
  const float bia = ((dir ? p->gla_b_b : p->gla_b_f) + l * 256 + h * 64)[dd];
  f32x16 acc;
#pragma unroll
  for (int r = 0; r < 16; ++r) acc[r] = 0.f;
  uint4 kreg, vreg0, vreg1, lreg = make_uint4(0, 0, 0, 0);
#define GS_BASE(pi) (dir == 0 ? ((pi) < 4 ? T + 64 * (pi) : 64 * ((pi) - 4)) : ((pi) < 4 ? T + 64 * (3 - (pi)) : 64 * (67 - (pi))))
#define GS_LOAD(pi) do { const u16* Pr_ = p->P + (size_t)(b * SB + GS_BASE(pi) + ts) * LDP; \
    kreg = *(const uint4*)(Pr_ + C_GK + h * 64 + td0); vreg0 = *(const uint4*)(Pr_ + C_GV + h * 128 + td0); vreg1 = *(const uint4*)(Pr_ + C_GV + h * 128 + 64 + td0); \
    if (tid < 128) lreg = *(const uint4*)(p->P + (size_t)(b * SB + GS_BASE(pi) + (tid >> 1)) * LDP + C_GWF + dir * 16 + (tid & 1) * 8); } while (0)
  GS_LOAD(0);
  __syncthreads();
  for (int pi = 0; pi < 68; ++pi) {
    const int cid = GS_BASE(pi) >> 6;
    if (tid < 128) unpack8(lreg, lr + (tid >> 1) * 16 + (tid & 1) * 8);
    { const u16* v0 = (const u16*)&vreg0; const u16* v1 = (const u16*)&vreg1;
#pragma unroll
      for (int j = 0; j < 8; ++j) { VT[(td0 + j) * 72 + ts] = v0[j]; VT[(64 + td0 + j) * 72 + ts] = v1[j]; } }
    __syncthreads();
    float gv[8]; float run = 0.f;
#pragma unroll
    for (int j = 0; j < 8; ++j) { const int i = seg * 8 + j, c = dir ? 63 - i : i;
      float x = bia;
#pragma unroll
      for (int q = 0; q < 16; ++q) x += lr[c * 16 + q] * wu[q];
      run += logsig16(x); gv[j] = run; }
    segtot[seg * 64 + dd] = run;
    __syncthreads();
    { float offs = 0.f, tot = 0.f;
#pragma unroll
      for (int q = 0; q < 8; ++q) { const float t_ = segtot[q * 64 + dd]; tot += t_; if (q < seg) offs += t_; }
#pragma unroll
      for (int j = 0; j < 8; ++j) { const int i = seg * 8 + j, c = dir ? 63 - i : i; gc[c * 64 + dd] = gv[j] + offs; }
      if (seg == 0) dec[dd] = tot; }
    __syncthreads();
    { float kf[8]; unpack8(kreg, kf);
      const float4 g0 = *(const float4*)(gc + ts * 64 + td0), g1 = *(const float4*)(gc + ts * 64 + td0 + 4);
      const float4 t0 = *(const float4*)(dec + td0), t1 = *(const float4*)(dec + td0 + 4);
      const float gg[8] = {g0.x, g0.y, g0.z, g0.w, g1.x, g1.y, g1.z, g1.w}, tt[8] = {t0.x, t0.y, t0.z, t0.w, t1.x, t1.y, t1.z, t1.w};
#pragma unroll
      for (int j = 0; j < 8; ++j) KT[(td0 + j) * 72 + ts] = f2bf(kf[j] * __expf(tt[j] - gg[j])); }
    if (pi + 1 < 68) GS_LOAD(pi + 1);
    __syncthreads();
    { u16* ST = p->SH + ((((size_t)(b * 4 + h) * 2 + dir) * 68 + cid) * 128 + 32 * ni + r32) * 64 + 32 * mi + 4 * hi;
#pragma unroll
      for (int rg = 0; rg < 4; ++rg) *(uint2*)(ST + 8 * rg) = make_uint2(pack2(acc[4 * rg], acc[4 * rg + 1]), pack2(acc[4 * rg + 2], acc[4 * rg + 3]));
#pragma unroll
      for (int r = 0; r < 16; ++r) acc[r] *= __expf(dec[32 * mi + crow(r, hi)]);
#pragma unroll
      for (int ks = 0; ks < 4; ++ks) {
        const bf16x8 a = *(const bf16x8*)(KT + (32 * mi + r32) * 72 + ks * 16 + hi * 8), bb = *(const bf16x8*)(VT + (32 * ni + r32) * 72 + ks * 16 + hi * 8);
        acc = __builtin_amdgcn_mfma_f32_32x32x16_bf16(a, bb, acc, 0, 0, 0);
      } }
    __syncthreads();
  }
#undef GS_LOAD
#undef GS_BASE
}
__device__ __forceinline__ void gla_out_tile(KParams p, int l, int b, int h, int cid, char* smem) {
  u16* X = (u16*)smem;
  u16* VT = X + 64 * 200;
  char* U = smem + 76800;
  float* Gf = (float*)U; float* Gb = Gf + 4096; float* segtot = Gb + 4096;
  u16* KI = (u16*)(U + 36864);
  float* O = (float*)U;
  float* lr = (float*)(smem + 76800 + 55296);
  const int tid = tidx(), wid = tid >> 6, lane = tid & 63, r32 = lane & 31, hi = lane >> 5;
  const int dd = tid & 63, seg = tid >> 6, ts = tid >> 3, td0 = (tid & 7) * 8;
  u16* Pr = p->P + (size_t)(b * SB + cid * 64) * LDP;
  const uint4 qreg = *(const uint4*)(Pr + (size_t)ts * LDP + C_GQ + h * 64 + td0), kreg = *(const uint4*)(Pr + (size_t)ts * LDP + C_GK + h * 64 + td0);
  const uint4 vreg0 = *(const uint4*)(Pr + (size_t)ts * LDP + C_GV + h * 128 + td0), vreg1 = *(const uint4*)(Pr + (size_t)ts * LDP + C_GV + h * 128 + 64 + td0);
  uint4 lreg = make_uint4(0, 0, 0, 0);
  if (tid < 256) lreg = *(const uint4*)(Pr + (size_t)(tid >> 2) * LDP + C_GWF + (tid & 3) * 8);
  const u16* STf = p->SH + ((((size_t)(b * 4 + h) * 2 + 0) * 68 + cid) * 128) * 64;
  const u16* STb = p->SH + ((((size_t)(b * 4 + h) * 2 + 1) * 68 + cid) * 128) * 64;
  const uint4 sf0 = *(const uint4*)(STf + (size_t)tid * 8), sf1 = *(const uint4*)(STf + (size_t)(tid + 512) * 8);
  const uint4 sb0 = *(const uint4*)(STb + (size_t)tid * 8), sb1 = *(const uint4*)(STb + (size_t)(tid + 512) * 8);
  float wuf[16], wub[16];
  { const float* wf = p->gla_wup_f + l * 4096 + h * 64 + dd; const float* wb = p->gla_wup_b + l * 4096 + h * 64 + dd;
#pragma unroll
    for (int i = 0; i < 16; ++i) { wuf[i] = wf[i * 256]; wub[i] = wb[i * 256]; } }
  const float biaf = p->gla_b_f[l * 256 + h * 64 + dd], biab = p->gla_b_b[l * 256 + h * 64 + dd];
  __syncthreads();
  if (tid < 256) unpack8(lreg, lr + (tid >> 2) * 32 + (tid & 3) * 8);
  { const u16* v0 = (const u16*)&vreg0; const u16* v1 = (const u16*)&vreg1;
#pragma unroll
    for (int j = 0; j < 8; ++j) { VT[(td0 + j) * 200 + ts] = v0[j]; VT[(64 + td0 + j) * 200 + ts] = v1[j]; } }
  *(uint4*)(VT + (tid >> 3) * 200 + 64 + (tid & 7) * 8) = sf0; *(uint4*)(VT + (64 + (tid >> 3)) * 200 + 64 + (tid & 7) * 8) = sf1;
  *(uint4*)(VT + (tid >> 3) * 200 + 128 + (tid & 7) * 8) = sb0; *(uint4*)(VT + (64 + (tid >> 3)) * 200 + 128 + (tid & 7) * 8) = sb1;
  __syncthreads();
  { float gfv[8], gbv[8];
#pragma unroll
    for (int j = 0; j < 8; ++j) { const int c = seg * 8 + j; float xf = biaf, xb = biab;
#pragma unroll
      for (int q = 0; q < 16; ++q) { xf += lr[c * 32 + q] * wuf[q]; xb += lr[c * 32 + 16 + q] * wub[q]; }
      gfv[j] = logsig16(xf); gbv[j] = logsig16(xb); }
#pragma unroll
    for (int j = 1; j < 8; ++j) gfv[j] += gfv[j - 1];
#pragma unroll
    for (int j = 6; j >= 0; --j) gbv[j] += gbv[j + 1];
    segtot[seg * 64 + dd] = gfv[7]; segtot[512 + seg * 64 + dd] = gbv[0];
    __syncthreads();
    float of = 0.f, ob = 0.f;
#pragma unroll
    for (int q = 0; q < 8; ++q) { if (q < seg) of += segtot[q * 64 + dd]; if (q > seg) ob += segtot[512 + q * 64 + dd]; }
#pragma unroll
    for (int j = 0; j < 8; ++j) { Gf[(seg * 8 + j) * 64 + dd] = gfv[j] + of; Gb[(seg * 8 + j) * 64 + dd] = gbv[j] + ob; } }
  __syncthreads();
  { float qf[8], kf[8]; unpack8(qreg, qf); unpack8(kreg, kf);
    const float4 a0 = *(const float4*)(Gf + ts * 64 + td0), a1 = *(const float4*)(Gf + ts * 64 + td0 + 4), c0 = *(const float4*)(Gb + ts * 64 + td0), c1 = *(const float4*)(Gb + ts * 64 + td0 + 4);
    const float gf8[8] = {a0.x, a0.y, a0.z, a0.w, a1.x, a1.y, a1.z, a1.w}, gb8[8] = {c0.x, c0.y, c0.z, c0.w, c1.x, c1.y, c1.z, c1.w};
    unsigned o0[4], o1[4], o2[4], o3[4];
#pragma unroll
    for (int j = 0; j < 8; j += 2) { const float q0 = qf[j] * 0.125f, q1 = qf[j + 1] * 0.125f;
      o0[j >> 1] = pack2(q0 * __expf(gf8[j]), q1 * __expf(gf8[j + 1])); o1[j >> 1] = pack2(q0 * __expf(gb8[j]), q1 * __expf(gb8[j + 1]));
      o2[j >> 1] = pack2(kf[j] * __expf(-gf8[j]), kf[j + 1] * __expf(-gf8[j + 1])); o3[j >> 1] = pack2(kf[j] * __expf(-gb8[j]), kf[j + 1] * __expf(-gb8[j + 1])); }
    *(uint4*)(X + ts * 200 + 64 + td0) = make_uint4(o0[0], o0[1], o0[2], o0[3]); *(uint4*)(X + ts * 200 + 128 + td0) = make_uint4(o1[0], o1[1], o1[2], o1[3]);
    *(uint4*)(KI + ts * 72 + td0) = make_uint4(o2[0], o2[1], o2[2], o2[3]); *(uint4*)(KI + 64 * 72 + ts * 72 + td0) = make_uint4(o3[0], o3[1], o3[2], o3[3]); }
  __syncthreads();
  if (wid < 4) {
    const int mi = wid >> 1, ni = wid & 1;
    f32x16 af, ab;
#pragma unroll
    for (int r = 0; r < 16; ++r) { af[r] = 0.f; ab[r] = 0.f; }
#pragma unroll
    for (int ks = 0; ks < 4; ++ks) {
      const bf16x8 qa = *(const bf16x8*)(X + (32 * mi + r32) * 200 + 64 + ks * 16 + hi * 8), qb = *(const bf16x8*)(X + (32 * mi + r32) * 200 + 128 + ks * 16 + hi * 8);
      const bf16x8 ka = *(const bf16x8*)(KI + (32 * ni + r32) * 72 + ks * 16 + hi * 8), kb = *(const bf16x8*)(KI + 64 * 72 + (32 * ni + r32) * 72 + ks * 16 + hi * 8);
      af = __builtin_amdgcn_mfma_f32_32x32x16_bf16(qa, ka, af, 0, 0, 0);
      ab = __builtin_amdgcn_mfma_f32_32x32x16_bf16(qb, kb, ab, 0, 0, 0);
    }
    const int sidx = 32 * ni + r32;
#pragma unroll
    for (int r = 0; r < 16; ++r) { const int c = 32 * mi + crow(r, hi); X[c * 200 + sidx] = f2bf((sidx <= c ? af[r] : 0.f) + (sidx >= c ? ab[r] : 0.f)); }
  }
  __syncthreads();
  { const int mi = wid >> 2, ni = wid & 3;
    f32x16 acc;
#pragma unroll
    for (int r = 0; r < 16; ++r) acc[r] = 0.f;
#pragma unroll
    for (int ks = 0; ks < 12; ++ks) {
      const bf16x8 a = *(const bf16x8*)(X + (32 * mi + r32) * 200 + ks * 16 + hi * 8), bb = *(const bf16x8*)(VT + (32 * ni + r32) * 200 + ks * 16 + hi * 8);
      acc = __builtin_amdgcn_mfma_f32_32x32x16_bf16(a, bb, acc, 0, 0, 0);
    }
#pragma unroll
    for (int r = 0; r < 16; ++r) O[(32 * mi + crow(r, hi)) * 132 + 32 * ni + r32] = acc[r]; }
  __syncthreads();
  { const int c = tid >> 3, e0 = (tid & 7) * 16;
    float ov[16];
#pragma unroll
    for (int j = 0; j < 16; j += 4) { const float4 t4 = *(const float4*)(O + c * 132 + e0 + j); ov[j] = t4.x; ov[j + 1] = t4.y; ov[j + 2] = t4.z; ov[j + 3] = t4.w; }
    float ss = 0.f;
#pragma unroll
    for (int j = 0; j < 16; ++j) ss += ov[j] * ov[j];
    ss = red8(ss);
    const float rstd = rsqrtf(ss * (1.f / 128.f) + 1e-6f);
    float gt[16];
    unpack8(*(const uint4*)(Pr + (size_t)c * LDP + C_GG + h * 128 + e0), gt); unpack8(*(const uint4*)(Pr + (size_t)c * LDP + C_GG + h * 128 + e0 + 8), gt + 8);
    const float* gn = p->gla_norm + l * 512 + h * 128 + e0;
    unsigned ow[8];
#pragma unroll
    for (int j = 0; j < 16; j += 2) ow[j >> 1] = pack2(ov[j] * rstd * gn[j] * siluf_(gt[j]), ov[j + 1] * rstd * gn[j + 1] * siluf_(gt[j + 1]));
    u16* dst = Pr + (size_t)c * LDP + C_GV + h * 128 + e0;
    *(uint4*)dst = make_uint4(ow[0], ow[1], ow[2], ow[3]); *(uint4*)(dst + 8) = make_uint4(ow[4], ow[5], ow[6], ow[7]); }
}

constexpr int RCH = 32, RNCH = (TC + T) / RCH;
__device__ __forceinline__ float fast_tanh(float x) { const float e = __expf(2.f * x); return 1.f - 2.f * __builtin_amdgcn_rcpf(e + 1.f); }
__device__ __forceinline__ int rwkv_gcol(int gidx, int h, int dir) { return gidx == 0 ? h * 64 : gidx == 1 ? 512 + h * 64 : gidx == 2 ? 1024 + h * 64 : gidx == 3 ? 2048 + dir * 64 : 2176 + dir * 64; }
__device__ __forceinline__ void rwkv_scan_unit(KParams p, int l, int unit, char* smem) {
  const int dir = unit & 1, h = (unit >> 1) & 7, b = unit >> 4;
  const int tid = tidx(), wid = tid >> 6, lane = tid & 63;
  float* sR = (float*)smem; float* sK = sR + 2048; float* sV = sK + 2048; float* sW = sV + 2048; float* sA = sW + 2048; float* sKK = sA + 2048; float* sY = sKK + 2048;
  u16* tTW = (u16*)(smem + 7 * 8192); u16* tAD = tTW + 32 * 72; u16* wupT = tAD + 32 * 72; u16* aupT = wupT + 64 * 72;
  float* smu = (float*)(aupT + 64 * 72);
  const float* wup = (dir ? p->rwkv_wup_b : p->rwkv_wup_f) + l * 64 * 512; const float* aup = (dir ? p->rwkv_aup_b : p->rwkv_aup_f) + l * 64 * 512;
  const float* w0 = (dir ? p->rwkv_w0_b : p->rwkv_w0_f) + l * 512 + h * 64; const float* a0 = (dir ? p->rwkv_a0_b : p->rwkv_a0_f) + l * 512 + h * 64;
  const float* kkw = p->rwkv_kk + l * 512 + h * 64; const float* kaw = p->rwkv_ka + l * 512 + h * 64; const float* rkw = p->rwkv_rk + l * 512 + h * 64;
  const u16* Pb = p->P + (size_t)b * SB * LDP + C_RW;
  __syncthreads();
  for (int e = tid; e < 4096; e += 512) { const int n = e & 63, i = e >> 6; wupT[n * 72 + i] = f2bf(wup[i * 512 + h * 64 + n]); aupT[n * 72 + i] = f2bf(aup[i * 512 + h * 64 + n]); }
  if (tid < 320) smu[tid] = p->rwkv_mu[l * 2304 + rwkv_gcol(tid >> 6, h, dir) + (tid & 63)];
  const int rp = tid >> 4, kq = tid & 15;
  float S0[4], S1[4];
#pragma unroll
  for (int j = 0; j < 4; ++j) { S0[j] = 0.f; S1[j] = 0.f; }
  uint4 rg[3][3];
#define RW_T0(c, base, len, t0) do { const int ci_ = (c) < 8 ? (c) : (c) - 8; base = (c) < 8 ? T : 0; len = (c) < 8 ? TC : T; t0 = dir ? base + len - (ci_ + 1) * RCH : base + ci_ * RCH; } while (0)
#define RW_LOAD(c) do { int base_, len_, t0_; RW_T0(c, base_, len_, t0_); \
    _Pragma("unroll") for (int it = 0; it < 3; ++it) { const int e = tid + it * 512; \
      if (e < 1280) { const int tl = e / 40, v = e % 40; const int t = t0_ + tl; const u16* src = Pb + (size_t)t * LDP + rwkv_gcol(v >> 3, h, dir) + (v & 7) * 8; \
        rg[it][1] = *(const uint4*)src; \
        rg[it][0] = (t > base_) ? *(const uint4*)(src - LDP) : make_uint4(0, 0, 0, 0); \
        rg[it][2] = (t + 1 < base_ + len_) ? *(const uint4*)(src + LDP) : make_uint4(0, 0, 0, 0); } } } while (0)
  RW_LOAD(0);
  __syncthreads();
  for (int c = 0; c < RNCH; ++c) {
    int base, len, t0; RW_T0(c, base, len, t0);
    const size_t row0 = (size_t)b * SB + t0;
#pragma unroll
    for (int it = 0; it < 3; ++it) { const int e = tid + it * 512;
      if (e < 1280) { const int tl = e / 40, v = e % 40, gidx = v >> 3, n0 = (v & 7) * 8;
        float cc[8], ll[8], nn[8], val[8];
        unpack8(rg[it][1], cc); unpack8(rg[it][0], ll); unpack8(rg[it][2], nn);
        const float4 m0 = *(const float4*)(smu + gidx * 64 + n0), m1 = *(const float4*)(smu + gidx * 64 + n0 + 4);
        const float mm[8] = {m0.x, m0.y, m0.z, m0.w, m1.x, m1.y, m1.z, m1.w};
#pragma unroll
        for (int j = 0; j < 8; ++j) val[j] = cc[j] + mm[j] * (0.5f * (ll[j] + nn[j]) - cc[j]);
        if (gidx < 3) { float* dst = (gidx == 0 ? sR : gidx == 1 ? sK : sV) + tl * 64 + n0;
          *(float4*)dst = make_float4(val[0], val[1], val[2], val[3]); *(float4*)(dst + 4) = make_float4(val[4], val[5], val[6], val[7]); }
        else { if (gidx == 3) {
#pragma unroll
            for (int j = 0; j < 8; ++j) val[j] = fast_tanh(val[j]); }
          *(uint4*)((gidx == 3 ? tTW : tAD) + tl * 72 + n0) = make_uint4(pack2(val[0], val[1]), pack2(val[2], val[3]), pack2(val[4], val[5]), pack2(val[6], val[7])); } } }
    if (c + 1 < RNCH) RW_LOAD(c + 1);
    __syncthreads();
    if (wid < 4) {
      const int gsel = wid >> 1, ni = wid & 1, r32 = lane & 31, hi = lane >> 5;
      const u16* At = gsel ? tAD : tTW; const u16* Bt = gsel ? aupT : wupT;
      f32x16 acc;
#pragma unroll
      for (int r = 0; r < 16; ++r) acc[r] = 0.f;
#pragma unroll
      for (int ks = 0; ks < 4; ++ks) {
        const bf16x8 a = *(const bf16x8*)(At + r32 * 72 + ks * 16 + hi * 8), bb = *(const bf16x8*)(Bt + (ni * 32 + r32) * 72 + ks * 16 + hi * 8);
        acc = __builtin_amdgcn_mfma_f32_32x32x16_bf16(a, bb, acc, 0, 0, 0);
      }
      const int n = ni * 32 + r32;
      if (gsel == 0) { const float w0n = w0[n];
#pragma unroll
        for (int r = 0; r < 16; ++r) sW[crow(r, hi) * 64 + n] = __expf(-0.6065306597f * sigmoidf_(w0n + acc[r])); }
      else { const float a0n = a0[n];
#pragma unroll
        for (int r = 0; r < 16; ++r) sA[crow(r, hi) * 64 + n] = sigmoidf_(a0n + acc[r]); }
    }
    __syncthreads();
    { const int tl = tid >> 4, n0 = (tid & 15) * 4;
      const float4 k4 = *(const float4*)(sK + tl * 64 + n0), a4 = *(const float4*)(sA + tl * 64 + n0), r4 = *(const float4*)(sR + tl * 64 + n0);
      const float4 ka4 = *(const float4*)(kaw + n0), kw4 = *(const float4*)(kkw + n0), rk4 = *(const float4*)(rkw + n0);
      const float kk_[4] = {k4.x * kw4.x, k4.y * kw4.y, k4.z * kw4.z, k4.w * kw4.w};
      const float kd[4] = {k4.x * (1.f + (a4.x - 1.f) * ka4.x), k4.y * (1.f + (a4.y - 1.f) * ka4.y), k4.z * (1.f + (a4.z - 1.f) * ka4.z), k4.w * (1.f + (a4.w - 1.f) * ka4.w)};
      const float ss = red16(kk_[0] * kk_[0] + kk_[1] * kk_[1] + kk_[2] * kk_[2] + kk_[3] * kk_[3]);
      const float bs = red16(r4.x * kd[0] * rk4.x + r4.y * kd[1] * rk4.y + r4.z * kd[2] * rk4.z + r4.w * kd[3] * rk4.w);
      const float rn = rsqrtf(ss + 1e-12f);
      *(float4*)(sK + tl * 64 + n0) = make_float4(kd[0], kd[1], kd[2], kd[3]);
      *(float4*)(sKK + tl * 64 + n0) = make_float4(kk_[0] * rn, kk_[1] * rn, kk_[2] * rn, kk_[3] * rn);
      *(float4*)(sA + tl * 64 + n0) = make_float4(kk_[0] * rn * a4.x, kk_[1] * rn * a4.y, kk_[2] * rn * a4.z, kk_[3] * rn * a4.w);
      if ((tid & 15) == 0) p->bon[((size_t)dir * R + row0 + tl) * 8 + h] = bs; }
    __syncthreads();
    for (int i = 0; i < RCH; ++i) {
      const int tl = dir ? RCH - 1 - i : i;
      const float4 k4 = *(const float4*)(sKK + tl * 64 + kq * 4);
      const float4 w4 = *(const float4*)(sW + tl * 64 + kq * 4), d4 = *(const float4*)(sK + tl * 64 + kq * 4);
      const float4 b4 = *(const float4*)(sA + tl * 64 + kq * 4), r4 = *(const float4*)(sR + tl * 64 + kq * 4);
      const float2 vv = *(const float2*)(sV + tl * 64 + rp * 2);
      float sa0 = S0[0] * k4.x + S0[1] * k4.y + S0[2] * k4.z + S0[3] * k4.w;
      float sa1 = S1[0] * k4.x + S1[1] * k4.y + S1[2] * k4.z + S1[3] * k4.w;
      sa0 = red16(sa0); sa1 = red16(sa1);
      S0[0] = S0[0] * w4.x + (vv.x * d4.x - sa0 * b4.x); S0[1] = S0[1] * w4.y + (vv.x * d4.y - sa0 * b4.y);
      S0[2] = S0[2] * w4.z + (vv.x * d4.z - sa0 * b4.z); S0[3] = S0[3] * w4.w + (vv.x * d4.w - sa0 * b4.w);
      S1[0] = S1[0] * w4.x + (vv.y * d4.x - sa1 * b4.x); S1[1] = S1[1] * w4.y + (vv.y * d4.y - sa1 * b4.y);
      S1[2] = S1[2] * w4.z + (vv.y * d4.z - sa1 * b4.z); S1[3] = S1[3] * w4.w + (vv.y * d4.w - sa1 * b4.w);
      float y0 = S0[0] * r4.x + S0[1] * r4.y + S0[2] * r4.z + S0[3] * r4.w;
      float y1 = S1[0] * r4.x + S1[1] * r4.y + S1[2] * r4.z + S1[3] * r4.w;
      y0 = red16(y0); y1 = red16(y1);
      if (kq == 0) *(float2*)(sY + tl * 64 + rp * 2) = make_float2(y0, y1);
    }
    __syncthreads();
    { const int tl = tid >> 4, n4 = (tid & 15) * 4; const float4 yv = *(const float4*)(sY + tl * 64 + n4);
      uint2 o; o.x = pack2(yv.x, yv.y); o.y = pack2(yv.z, yv.w);
      *(uint2*)(p->SH + (row0 + tl) * 1024 + dir * 512 + h * 64 + n4) = o; }
  }
#undef RW_LOAD
#undef RW_T0
}

__device__ __forceinline__ void phase_f0(KParams p, int l) {
  const int tid = tidx(), wid = tid >> 6, lane = tid & 63;
  const float* mu = p->rwkv_mu + l * 2304; const float* lng = p->rwkv_ln_g + l * 512; const float* lnb = p->rwkv_ln_b + l * 512;
  for (int it = blockIdx.x * 8 + wid; it < R * 2; it += gridDim.x * 8) {
    const int r = it >> 1, j = (it & 1) * 256 + lane * 4, s = r % SB;
    if (l == 1 && s >= T) continue;
    const bool first = (s == 0) || (s == T), last = (s == T - 1) || (s == SB - 1);
    const u16* p0 = p->P + (size_t)r * LDP + C_RW;
    u16* yrow = p->SH + (size_t)r * 1024;
    const uint2 yf = *(const uint2*)(yrow + j), yb = *(const uint2*)(yrow + 512 + j);
    const uint2 vc = *(const uint2*)(p0 + 1024 + j), gcn = *(const uint2*)(p0 + 1536 + j);
    uint2 vl = make_uint2(0, 0), vn = make_uint2(0, 0), gl = make_uint2(0, 0), gn = make_uint2(0, 0);
    if (!first) { vl = *(const uint2*)(p0 + 1024 + j - LDP); gl = *(const uint2*)(p0 + 1536 + j - LDP); }
    if (!last) { vn = *(const uint2*)(p0 + 1024 + j + LDP); gn = *(const uint2*)(p0 + 1536 + j + LDP); }
    const float4 muv = *(const float4*)(mu + 1024 + j), mug = *(const float4*)(mu + 1536 + j), lg = *(const float4*)(lng + j), lb = *(const float4*)(lnb + j);
    const int head = j >> 6;
    const float bonus = p->bon[(size_t)r * 8 + head] + p->bon[((size_t)R + r) * 8 + head];
#define U2F(u, i) ((i) == 0 ? __uint_as_float((u).x << 16) : (i) == 1 ? __uint_as_float((u).x & 0xffff0000u) : (i) == 2 ? __uint_as_float((u).y << 16) : __uint_as_float((u).y & 0xffff0000u))
    float y[4], vv[4], gg[4];
    const float mv[4] = {muv.x, muv.y, muv.z, muv.w}, mg[4] = {mug.x, mug.y, mug.z, mug.w};
#pragma unroll
    for (int i = 0; i < 4; ++i) { y[i] = U2F(yf, i) + U2F(yb, i);
      const float c1 = U2F(vc, i); vv[i] = c1 + mv[i] * (0.5f * (U2F(vl, i) + U2F(vn, i)) - c1);
      const float c2 = U2F(gcn, i); gg[i] = c2 + mg[i] * (0.5f * (U2F(gl, i) + U2F(gn, i)) - c2); }
#undef U2F
    const float mean = red16(y[0] + y[1] + y[2] + y[3]) * (1.f / 64.f);
    const float d0 = y[0] - mean, d1 = y[1] - mean, d2 = y[2] - mean, d3 = y[3] - mean;
    const float rs = rsqrtf(red16(d0 * d0 + d1 * d1 + d2 * d2 + d3 * d3) * (1.f / 64.f) + 64e-5f);
    const float o0 = (d0 * rs * lg.x + lb.x + bonus * vv[0]) * siluf_(gg[0]), o1 = (d1 * rs * lg.y + lb.y + bonus * vv[1]) * siluf_(gg[1]);
    const float o2 = (d2 * rs * lg.z + lb.z + bonus * vv[2]) * siluf_(gg[2]), o3 = (d3 * rs * lg.w + lb.w + bonus * vv[3]) * siluf_(gg[3]);
    *(uint2*)(yrow + j) = make_uint2(pack2(o0, o1), pack2(o2, o3));
  }
  const float* g_pre = p->g_pre + l * 1024; const float* modl = p->mod + (size_t)l * 17 * 3072;
  for (int r = blockIdx.x * 8 + wid; r < R; r += gridDim.x * 8) {
    const int b = r / SB, s = r % SB;
    if (l == 1 && s >= T) continue;
    const float* src = xrow_ptr(p, l, r);
    float4 v[4];
#pragma unroll
    for (int i = 0; i < 4; ++i) v[i] = *(const float4*)(src + i * 256 + lane * 4);
    hrow_write(v, g_pre, modl + (size_t)((s < T) ? b : 16) * 3072, p->P + (size_t)r * LDP + C_HRE, lane);
  }
}

__device__ __forceinline__ int rowtile_row0(int l, int i) { return l == 0 ? i * 256 : ((i >> 4) * 17 + (i & 15)) * 256; }
__device__ __forceinline__ int n_rowtiles(int l) { return l == 0 ? R / 256 : NB * 16; }

__device__ __forceinline__ void phase_f1(KParams p, int l, char* smem) {
  const u16* Wg = p->Wt_in + (size_t)l * DINP * 1024 + (size_t)C_MG * 1024;
  const u16* Wo = p->Wt_o + (size_t)l * 3 * 1024 * 512;
  uint4* park = (uint4*)(p->tmp + ((size_t)blockIdx.x * 512 + tidx()) * 32);
  int rti, nt;
  for (int it = 0; xcd_tile(it, n_rowtiles(l), 8, rti, nt); ++it) {
    const int row0 = rowtile_row0(l, rti);
    f32x16 accm[2][2];
#pragma unroll
    for (int mi = 0; mi < 2; ++mi)
#pragma unroll
      for (int ni = 0; ni < 2; ++ni)
#pragma unroll
        for (int r = 0; r < 16; ++r) accm[mi][ni][r] = 0.f;
#pragma unroll 1
    for (int i = 0; i < 3; ++i) {
      {
        f32x16 acc[2][2];
        gemm_kloop(p->P + (size_t)row0 * LDP + C_HRE, LDP, Wg + (size_t)(i * 1024 + nt * 128) * 1024, 1024, 1024, smem, acc);
#pragma unroll
        for (int mi = 0; mi < 2; ++mi)
#pragma unroll
          for (int ni = 0; ni < 2; ++ni)
#pragma unroll
            for (int r = 0; r < 16; r += 8) park[(mi * 2 + ni) * 2 + (r >> 3)] = make_uint4(pack2(sigmoidf_(acc[mi][ni][r]), sigmoidf_(acc[mi][ni][r + 1])), pack2(sigmoidf_(acc[mi][ni][r + 2]), sigmoidf_(acc[mi][ni][r + 3])),
                                                                                  pack2(sigmoidf_(acc[mi][ni][r + 4]), sigmoidf_(acc[mi][ni][r + 5])), pack2(sigmoidf_(acc[mi][ni][r + 6]), sigmoidf_(acc[mi][ni][r + 7])));
      }
      {
        f32x16 acc[2][2];
        const u16* Ai = (i == 0) ? p->P + (size_t)row0 * LDP + C_GV : (i == 1) ? p->P + (size_t)row0 * LDP + C_AQ : p->SH + (size_t)row0 * 1024;
        gemm_kloop(Ai, (i == 2) ? 1024 : LDP, Wo + (size_t)(i * 1024 + nt * 128) * 512, 512, 512, smem, acc);
#pragma unroll
        for (int mi = 0; mi < 2; ++mi)
#pragma unroll
          for (int ni = 0; ni < 2; ++ni)
#pragma unroll
            for (int r = 0; r < 16; r += 8) { const uint4 w = park[(mi * 2 + ni) * 2 + (r >> 3)];
              accm[mi][ni][r] += __uint_as_float(w.x << 16) * acc[mi][ni][r]; accm[mi][ni][r + 1] += __uint_as_float(w.x & 0xffff0000u) * acc[mi][ni][r + 1];
              accm[mi][ni][r + 2] += __uint_as_float(w.y << 16) * acc[mi][ni][r + 2]; accm[mi][ni][r + 3] += __uint_as_float(w.y & 0xffff0000u) * acc[mi][ni][r + 3];
              accm[mi][ni][r + 4] += __uint_as_float(w.z << 16) * acc[mi][ni][r + 4]; accm[mi][ni][r + 5] += __uint_as_float(w.z & 0xffff0000u) * acc[mi][ni][r + 5];
              accm[mi][ni][r + 6] += __uint_as_float(w.w << 16) * acc[mi][ni][r + 6]; accm[mi][ni][r + 7] += __uint_as_float(w.w & 0xffff0000u) * acc[mi][ni][r + 7]; }
      }
    }
    store_tile_bf16(accm, p->P + (size_t)row0 * LDP + C_M + nt * 128, LDP, 128);
  }
}
__device__ __forceinline__ void phase_f2(KParams p, int l, char* smem) {
  const u16* W = p->Wt_out + (size_t)l * 1024 * 1024;
  int rti, nt;
  for (int it = 0; xcd_tile(it, n_rowtiles(l), 8, rti, nt); ++it) {
    const int row0 = rowtile_row0(l, rti);
    f32x16 acc[2][2];
    gemm_kloop(p->P + (size_t)row0 * LDP + C_M, LDP, W + (size_t)nt * 128 * 1024, 1024, 1024, smem, acc);
    store_tile_bf16(acc, p->SH + (size_t)row0 * 1024 + nt * 128, 1024, 128);
  }
}
__device__ __forceinline__ void phase_f3(KParams p, int l) {
  const int wid = tidx() >> 6, lane = tidx() & 63;
  const float* g_post = p->g_post + l * 1024; const float* modl = p->mod + (size_t)l * 17 * 3072;
  for (int r = blockIdx.x * 8 + wid; r < R; r += gridDim.x * 8) {
    const int b = r / SB, s = r % SB;
    if (l == 1 && s >= T) continue;
    const float* src = xrow_ptr(p, l, r);
    float* dst = (s < T) ? p->out + ((size_t)b * T + s) * DM : p->xc1 + ((size_t)b * TC + (s - T)) * DM;
    const float* gate = modl + (size_t)((s < T) ? b : 16) * 3072 + 2048;
    u16* zrow = p->SH + (size_t)r * 1024;
    float z[4][4]; float ss = 0.f;
#pragma unroll
    for (int i = 0; i < 4; ++i) { const ushort4 u = *(const ushort4*)(zrow + i * 256 + lane * 4); z[i][0] = bf2f(u.x); z[i][1] = bf2f(u.y); z[i][2] = bf2f(u.z); z[i][3] = bf2f(u.w);
      ss += z[i][0] * z[i][0] + z[i][1] * z[i][1] + z[i][2] * z[i][2] + z[i][3] * z[i][3]; }
    ss = wave_sum(ss);
    const float rstd = rsqrtf(ss * (1.f / 1024.f) + 1e-6f);
    float4 o[4];
#pragma unroll
    for (int i = 0; i < 4; ++i) {
      const int col = i * 256 + lane * 4;
      const float4 g = *(const float4*)(g_post + col), gt = *(const float4*)(gate + col), xv = *(const float4*)(src + col);
      o[i].x = xv.x + gt.x * (z[i][0] * rstd * g.x); o[i].y = xv.y + gt.y * (z[i][1] * rstd * g.y);
      o[i].z = xv.z + gt.z * (z[i][2] * rstd * g.z); o[i].w = xv.w + gt.w * (z[i][3] * rstd * g.w);
      *(float4*)(dst + col) = o[i];
    }
    if (l == 0) hrow_write(o, p->g_pre + 1024, p->mod + (size_t)17 * 3072 + (size_t)((s < T) ? b : 16) * 3072, zrow, lane);
  }
}

constexpr int N_PHASES = 18;
#define LOADP() KParams p = kp; asm volatile("" : "+s"(p))
__global__ __launch_bounds__(512, 1) void megakernel(Params praw) {
  extern __shared__ __attribute__((aligned(16))) char smem[];
  const KParams kp = (KParams)__builtin_amdgcn_kernarg_segment_ptr();
  const int ph0 = praw.p0, ph1 = praw.p1;
  for (int ph = ph0; ph < ph1; ++ph) {
    const int l = (ph - 2) >> 3, sub = (ph - 2) & 7;
    if (ph == 0) { LOADP(); phase_prologue(p, smem); }
    else if (ph == 1) { LOADP(); phase_a0(p); }
    else if (sub == 0) { LOADP(); phase_a1(p, l, smem); }
    else if (sub == 1) { LOADP();
      for (int u = blockIdx.x; u < 128; u += gridDim.x) gla_state_unit(p, l, u, smem);
      attn_prep_all(p, l);
    } else if (sub == 2) {
      const int natt = 1024 + (l == 0 ? 64 : 0), nch = (l == 0 ? 68 : 64);
      for (int it = blockIdx.x; it < natt + NB * 4 * nch; it += gridDim.x) {
        if (it < natt) {
          int b, h, qrow0, krow0, seq;
          if (it < 1024) { b = it >> 6; h = (it >> 4) & 3; qrow0 = (it & 15) * 256; krow0 = 0; seq = SB; }
          else { const int u = it - 1024; b = u >> 2; h = u & 3; qrow0 = T; krow0 = T; seq = TC; }
          const int kvh = h >> 1;
          KParams q_ = kp; asm volatile("" : "+s"(q_)); u16* Pbase = q_->P;
          u16* Pq = Pbase + (size_t)(b * SB + qrow0) * LDP; const u16* Pk = Pbase + (size_t)(b * SB + krow0) * LDP;
          att::attn_dense_body((const bf16*)(Pq + C_AQ + h * 128), (const bf16*)(Pk + C_AK + kvh * 128), (const bf16*)(Pk + C_AV + kvh * 128),
                               Pq + C_AG + h * 128, Pq + C_AQ + h * 128, seq, smem);
        } else { LOADP(); const int g = it - natt; gla_out_tile(p, l, g / (nch * 4), (g / nch) & 3, g % nch, smem); }
      }
    } else if (sub == 3) { LOADP(); for (int u = blockIdx.x; u < 256; u += gridDim.x) rwkv_scan_unit(p, l, u, smem); }
    else if (sub == 4) { LOADP(); phase_f0(p, l); }
    else if (sub == 5) { LOADP(); phase_f1(p, l, smem); }
    else if (sub == 6) { LOADP(); phase_f2(p, l, smem); }
    else { LOADP(); phase_f3(p, l); }
    if (ph + 1 < ph1) cg::this_grid().sync();
  }
}

#ifndef MK_LAUNCHES
#define MK_LAUNCHES 1
#endif
static inline size_t al256(size_t x) { return (x + 255) / 256 * 256; }
extern "C" void kernel_launch(void* const* d_in, const int* in_sizes, int n_in, void* d_out, int out_size, void* d_ws, size_t ws_size, hipStream_t stream) {
  Params p{};
  const float** pf = (const float**)&p;
  for (int i = 0; i < 34; ++i) pf[i] = (const float*)d_in[i];
  p.out = (float*)d_out;
  char* ws = (char*)d_ws; size_t off = 0;
  auto take = [&](size_t bytes) { char* q = ws + off; off += al256(bytes); return q; };
  p.Wt_in = (u16*)take((size_t)2 * DINP * 1024 * 2);
  p.Wt_o = (u16*)take((size_t)2 * 3 * 1024 * 512 * 2);
  p.Wt_out = (u16*)take((size_t)2 * 1024 * 1024 * 2);
  p.mod = (float*)take((size_t)2 * 17 * 3072 * 4);
  p.bon = (float*)take((size_t)2 * R * 8 * 4);
  p.xc1 = (float*)take((size_t)NB * TC * DM * 4);
  p.SH = (u16*)take((size_t)R * 1024 * 2);
  p.P = (u16*)take((size_t)R * LDP * 2);
  p.tmp = (unsigned*)take((size_t)512 * 32 * 512 * 4);
  if (off > ws_size) { fprintf(stderr, "kernel_launch: workspace too small (%zu > %zu)\n", off, ws_size); return; }

  static int grid_blocks = 0;
  if (!grid_blocks) {
    if (hipFuncSetAttribute((const void*)megakernel, hipFuncAttributeMaxDynamicSharedMemorySize, SMEM_BYTES) != hipSuccess) { fprintf(stderr, "kernel_launch: LDS attribute failed\n"); return; }
    int dev = 0, cus = 0, per_cu = 0;
    (void)hipGetDevice(&dev);
    (void)hipDeviceGetAttribute(&cus, hipDeviceAttributeMultiprocessorCount, dev);
    (void)hipOccupancyMaxActiveBlocksPerMultiprocessor(&per_cu, megakernel, 512, SMEM_BYTES);
    if (per_cu < 1) { fprintf(stderr, "kernel_launch: occupancy query returned %d\n", per_cu); return; }
    grid_blocks = (cus * (per_cu > 1 ? 1 : per_cu)) / 8 * 8;
  }
#if MK_LAUNCHES == 1
  p.p0 = 0; p.p1 = N_PHASES;
  void* args[] = {&p};
  hipError_t e = hipLaunchCooperativeKernel((void*)megakernel, dim3(grid_blocks), dim3(512), args, SMEM_BYTES, stream);
  if (e != hipSuccess) fprintf(stderr, "cooperative launch failed: %s (grid %d)\n", hipGetErrorString(e), grid_blocks);
#else
  for (int ph = 0; ph < N_PHASES; ++ph) { p.p0 = ph; p.p1 = ph + 1; hipLaunchKernelGGL(megakernel, dim3(grid_blocks), dim3(512), SMEM_BYTES, stream, p); }
#endif
}
```

```cpp
#include <hip/hip_runtime.h>
#include <hip/hip_bf16.h>
#include <hip/hip_cooperative_groups.h>
#include <stdint.h>
#include <cstdio>
namespace cg = cooperative_groups;

typedef unsigned short u16;
using bf16 = __hip_bfloat16;
using bf16x8 = __attribute__((ext_vector_type(8))) short;
using s16x4  = __attribute__((ext_vector_type(4))) short;
using f32x16 = __attribute__((ext_vector_type(16))) float;
using f32x8  = __attribute__((ext_vector_type(8))) float;
using f32x4  = __attribute__((ext_vector_type(4))) float;
using f32x2  = __attribute__((ext_vector_type(2))) float;
using u32x4  = __attribute__((ext_vector_type(4))) unsigned;

constexpr int NB = 16, T = 4096, TC = 256, SB = T + TC;
constexpr int R = NB * SB;
constexpr int DM = 1024, DIN = 8480, DINP = 8576;
constexpr int LDP = 5408;
constexpr int NT_P = 43;
constexpr int C_GQ = 0, C_GK = 256, C_GV = 512, C_GG = 1024, C_GWF = 1536;
constexpr int C_AQ = 1568, C_AK = 2080, C_AV = 2336, C_AG = 2592;
constexpr int C_RW = 3104;
constexpr int C_MG = 5408;
constexpr int C_HRE = C_AK;
constexpr int C_M = C_RW;
constexpr int SMEM_BYTES = 147456;

struct Params {
  const float *x, *c, *ctx, *c_ctx, *w_mod, *b_mod, *g_pre, *w_in, *gla_wup_f, *gla_b_f, *gla_wup_b, *gla_b_b, *gla_norm, *att_qnorm, *att_knorm,
      *rwkv_mu, *rwkv_w0_f, *rwkv_wup_f, *rwkv_w0_b, *rwkv_wup_b, *rwkv_a0_f, *rwkv_aup_f, *rwkv_a0_b, *rwkv_aup_b, *rwkv_kk, *rwkv_ka, *rwkv_rk,
      *rwkv_ln_g, *rwkv_ln_b, *w_o_gla, *w_o_att, *w_o_rwkv, *w_out, *g_post;
  float* out; u16* Wt_in; u16* Wt_o; u16* Wt_out; float* mod; float* bon; float* xc1; u16* SH; u16* P; unsigned* tmp; unsigned* bar;
  int p0, p1;
};
typedef const __attribute__((address_space(4))) Params* KParams;

__device__ __forceinline__ int tidx() { int t = threadIdx.x; asm volatile("" : "+v"(t)); return t; }
__device__ __forceinline__ float bf2f(u16 v) { return __uint_as_float(((unsigned)v) << 16); }
typedef __bf16 bf16v2_t __attribute__((ext_vector_type(2)));
__device__ __forceinline__ unsigned cvtpk_bf16(float lo, float hi) { const f32x2 v = {lo, hi}; return __builtin_bit_cast(unsigned, __builtin_convertvector(v, bf16v2_t)); }
__device__ __forceinline__ u16 f2bf(float x) { return __builtin_bit_cast(u16, (__bf16)x); }
__device__ __forceinline__ float shfl_xor_f(float v, int m) { const int lane = tidx() & 63; return __builtin_bit_cast(float, __builtin_amdgcn_ds_bpermute((lane ^ m) << 2, __builtin_bit_cast(int, v))); }
__device__ __forceinline__ float wave_sum(float v);
__device__ __forceinline__ float sigmoidf_(float x) { return __builtin_amdgcn_rcpf(1.f + __expf(-x)); }
__device__ __forceinline__ float siluf_(float x) { return x * __builtin_amdgcn_rcpf(1.f + __expf(-x)); }
__device__ __forceinline__ int crow(int r, int hi) { return (r & 3) + 8 * (r >> 2) + 4 * hi; }
__device__ __forceinline__ void unpack8(uint4 u, float* f) {
  f[0] = __uint_as_float(u.x << 16); f[1] = __uint_as_float(u.x & 0xffff0000u); f[2] = __uint_as_float(u.y << 16); f[3] = __uint_as_float(u.y & 0xffff0000u);
  f[4] = __uint_as_float(u.z << 16); f[5] = __uint_as_float(u.z & 0xffff0000u); f[6] = __uint_as_float(u.w << 16); f[7] = __uint_as_float(u.w & 0xffff0000u);
}
__device__ __forceinline__ unsigned pack2(float a, float b) { return cvtpk_bf16(a, b); }
template <int CTRL> __device__ __forceinline__ float dpp_f(float x) {
  return __builtin_bit_cast(float, __builtin_amdgcn_update_dpp(0, __builtin_bit_cast(int, x), CTRL, 0xF, 0xF, true));
}
__device__ __forceinline__ float red4(float x) { x += dpp_f<0xB1>(x); x += dpp_f<0x4E>(x); return x; }
__device__ __forceinline__ float red8(float x) { x = red4(x); x += dpp_f<0x141>(x); return x; }
__device__ __forceinline__ float red16(float x) { x += dpp_f<0xB1>(x); x += dpp_f<0x4E>(x); x += dpp_f<0x141>(x); x += dpp_f<0x140>(x); return x; }
__device__ __forceinline__ float wave_sum(float v) {
  v = red16(v);
  { auto r1 = __builtin_amdgcn_permlane16_swap(__float_as_uint(v), __float_as_uint(v), false, false); v = __uint_as_float(r1[0]) + __uint_as_float(r1[1]); }
  { auto r2 = __builtin_amdgcn_permlane32_swap(__float_as_uint(v), __float_as_uint(v), false, false); v = __uint_as_float(r2[0]) + __uint_as_float(r2[1]); }
  return v;
}
__device__ __forceinline__ void red16x4(float& a, float& b, float& c, float& d) {
#define DPPA(r, ctl) "v_add_f32_dpp " r ", " r ", " r " " ctl " row_mask:0xf bank_mask:0xf bound_ctrl:1\n\t"
  asm volatile("s_nop 1\n\t"
               DPPA("%0", "quad_perm:[1,0,3,2]") DPPA("%1", "quad_perm:[1,0,3,2]") DPPA("%2", "quad_perm:[1,0,3,2]") DPPA("%3", "quad_perm:[1,0,3,2]")
               DPPA("%0", "quad_perm:[2,3,0,1]") DPPA("%1", "quad_perm:[2,3,0,1]") DPPA("%2", "quad_perm:[2,3,0,1]") DPPA("%3", "quad_perm:[2,3,0,1]")
               DPPA("%0", "row_half_mirror") DPPA("%1", "row_half_mirror") DPPA("%2", "row_half_mirror") DPPA("%3", "row_half_mirror")
               DPPA("%0", "row_mirror") DPPA("%1", "row_mirror") DPPA("%2", "row_mirror") DPPA("%3", "row_mirror")
               "s_nop 1"
               : "+v"(a), "+v"(b), "+v"(c), "+v"(d));
#undef DPPA
}

constexpr int GLS = 72;
constexpr int GEMM_SMEM = 2 * (256 * GLS + 128 * GLS) * 2;
__device__ __forceinline__ void gemm_kloop(const u16* __restrict__ A, int lda, const u16* __restrict__ Bt, int ldb, int K, char* smem, f32x16 (&acc)[2][2]) {
  u16* As = (u16*)smem; u16* Bs = As + 2 * 256 * GLS;
  const int tid = tidx(), wid = tid >> 6, lane = tid & 63, r32 = lane & 31, hi = lane >> 5;
  const int wm = wid >> 1, wn = wid & 1;
#pragma unroll
  for (int mi = 0; mi < 2; ++mi)
#pragma unroll
    for (int ni = 0; ni < 2; ++ni)
#pragma unroll
      for (int r = 0; r < 16; ++r) acc[mi][ni][r] = 0.f;
  uint4 xa0, xa1, xa2, xa3, xb0, xb1, ya0, ya1, ya2, ya3, yb0, yb1;
  const int nk = K / 64;
  const int lrow = tid >> 3, lkc = tid & 7;
  const u16* gA = A + (size_t)lrow * lda + lkc * 8;
  const u16* gB = Bt + (size_t)lrow * ldb + lkc * 8;
  const size_t sA = (size_t)64 * lda, sB = (size_t)64 * ldb;
  u16* wA = As + lrow * GLS + lkc * 8; u16* wB = Bs + lrow * GLS + lkc * 8;
#define GLOAD(R, kt) do { const u16* pa_ = gA + (kt) * 64; const u16* pb_ = gB + (kt) * 64; \
    R##a0 = *(const uint4*)(pa_); R##a1 = *(const uint4*)(pa_ + sA); R##a2 = *(const uint4*)(pa_ + 2 * sA); R##a3 = *(const uint4*)(pa_ + 3 * sA); \
    R##b0 = *(const uint4*)(pb_); R##b1 = *(const uint4*)(pb_ + sB); } while (0)
#define SWRITE(R, buf) do { u16* qa_ = wA + (buf) * 256 * GLS; u16* qb_ = wB + (buf) * 128 * GLS; \
    *(uint4*)(qa_) = R##a0; *(uint4*)(qa_ + 64 * GLS) = R##a1; *(uint4*)(qa_ + 128 * GLS) = R##a2; *(uint4*)(qa_ + 192 * GLS) = R##a3; \
    *(uint4*)(qb_) = R##b0; *(uint4*)(qb_ + 64 * GLS) = R##b1; } while (0)
#define COMPUTE(buf) do { const u16* Ab = As + (buf) * 256 * GLS + (wm * 64 + r32) * GLS + hi * 8; const u16* Bb = Bs + (buf) * 128 * GLS + (wn * 64 + r32) * GLS + hi * 8; \
    _Pragma("unroll") for (int ks = 0; ks < 4; ++ks) { \
      bf16x8 a0 = *(const bf16x8*)(Ab + ks * 16), a1 = *(const bf16x8*)(Ab + 32 * GLS + ks * 16); \
      bf16x8 b0 = *(const bf16x8*)(Bb + ks * 16), b1 = *(const bf16x8*)(Bb + 32 * GLS + ks * 16); \
      acc[0][0] = __builtin_amdgcn_mfma_f32_32x32x16_bf16(a0, b0, acc[0][0], 0, 0, 0); \
      acc[0][1] = __builtin_amdgcn_mfma_f32_32x32x16_bf16(a0, b1, acc[0][1], 0, 0, 0); \
      acc[1][0] = __builtin_amdgcn_mfma_f32_32x32x16_bf16(a1, b0, acc[1][0], 0, 0, 0); \
      acc[1][1] = __builtin_amdgcn_mfma_f32_32x32x16_bf16(a1, b1, acc[1][1], 0, 0, 0); } } while (0)
  GLOAD(x, 0); GLOAD(y, 1);
  SWRITE(x, 0); GLOAD(x, 2);
  __syncthreads();
  for (int kt = 0; kt < nk; kt += 2) {
    COMPUTE(0);
    SWRITE(y, 1);
    if (kt + 3 < nk) GLOAD(y, kt + 3);
    __syncthreads();
    COMPUTE(1);
    if (kt + 2 < nk) { SWRITE(x, 0); if (kt + 4 < nk) GLOAD(x, kt + 4); }
    __syncthreads();
  }
#undef COMPUTE
#undef GLOAD
#undef SWRITE
}
template <int NB>
__device__ __forceinline__ void gemm_kloop64(const u16* __restrict__ A, int lda, const u16* __restrict__ Bt, int ldb, size_t bstride, int K, char* smem, f32x16 (&acc)[NB][2]) {
  u16* As = (u16*)smem; u16* Bs = As + 2 * 256 * GLS;
  const int tid = tidx(), wid = tid >> 6, lane = tid & 63, r32 = lane & 31, hi = lane >> 5;
  const int wm = wid >> 1, wn = wid & 1;
#pragma unroll
  for (int ib = 0; ib < NB; ++ib)
#pragma unroll
    for (int mi = 0; mi < 2; ++mi)
#pragma unroll
      for (int r = 0; r < 16; ++r) acc[ib][mi][r] = 0.f;
  uint4 xa0, xa1, xa2, xa3, xb0, xb1, xb2, ya0, ya1, ya2, ya3, yb0, yb1, yb2;
  const int nk = K / 64;
  const int lrow = tid >> 3, lkc = tid & 7;
  const u16* gA = A + (size_t)lrow * lda + lkc * 8;
  const u16* gB = Bt + (size_t)lrow * ldb + lkc * 8;
  const size_t sA = (size_t)64 * lda;
  u16* wA = As + lrow * GLS + lkc * 8; u16* wB = Bs + lrow * GLS + lkc * 8;
#define GLOAD(R, kt) do { const u16* pa_ = gA + (kt) * 64; const u16* pb_ = gB + (kt) * 64; \
    R##a0 = *(const uint4*)(pa_); R##a1 = *(const uint4*)(pa_ + sA); R##a2 = *(const uint4*)(pa_ + 2 * sA); R##a3 = *(const uint4*)(pa_ + 3 * sA); \
    R##b0 = *(const uint4*)(pb_); if (NB > 1) R##b1 = *(const uint4*)(pb_ + bstride); if (NB > 2) R##b2 = *(const uint4*)(pb_ + 2 * bstride); } while (0)
#define SWRITE(R, buf) do { u16* qa_ = wA + (buf) * 256 * GLS; u16* qb_ = wB + (buf) * NB * 64 * GLS; \
    *(uint4*)(qa_) = R##a0; *(uint4*)(qa_ + 64 * GLS) = R##a1; *(uint4*)(qa_ + 128 * GLS) = R##a2; *(uint4*)(qa_ + 192 * GLS) = R##a3; \
    *(uint4*)(qb_) = R##b0; if (NB > 1) *(uint4*)(qb_ + 64 * GLS) = R##b1; if (NB > 2) *(uint4*)(qb_ + 128 * GLS) = R##b2; } while (0)
#define COMPUTE(buf) do { const u16* Ab = As + (buf) * 256 * GLS + (wm * 64 + r32) * GLS + hi * 8; const u16* Bb = Bs + (buf) * NB * 64 * GLS + (wn * 32 + r32) * GLS + hi * 8; \
    _Pragma("unroll") for (int ks = 0; ks < 4; ++ks) { \
      const bf16x8 fa0 = *(const bf16x8*)(Ab + ks * 16), fa1 = *(const bf16x8*)(Ab + 32 * GLS + ks * 16); \
      _Pragma("unroll") for (int ib = 0; ib < NB; ++ib) { \
        const bf16x8 fb = *(const bf16x8*)(Bb + ib * 64 * GLS + ks * 16); \
        acc[ib][0] = __builtin_amdgcn_mfma_f32_32x32x16_bf16(fa0, fb, acc[ib][0], 0, 0, 0); \
        acc[ib][1] = __builtin_amdgcn_mfma_f32_32x32x16_bf16(fa1, fb, acc[ib][1], 0, 0, 0); } } } while (0)
  GLOAD(x, 0); GLOAD(y, 1);
  SWRITE(x, 0); GLOAD(x, 2);
  __syncthreads();
  for (int kt = 0; kt < nk; kt += 2) {
    COMPUTE(0);
    SWRITE(y, 1);
    if (kt + 3 < nk) GLOAD(y, kt + 3);
    __syncthreads();
    COMPUTE(1);
    if (kt + 2 < nk) { SWRITE(x, 0); if (kt + 4 < nk) GLOAD(x, kt + 4); }
    __syncthreads();
  }
#undef COMPUTE
#undef GLOAD
#undef SWRITE
}
__device__ __forceinline__ void gemm_kloop256(const u16* __restrict__ A, int lda, const u16* __restrict__ Bt, int ldb, int K, char* smem, f32x16 (&acc)[4][2]) {
  u16* As = (u16*)smem; u16* Bs = As + 2 * 256 * GLS;
  const int tid = tidx(), wid = tid >> 6, lane = tid & 63, r32 = lane & 31, hi = lane >> 5;
  const int wm = wid >> 2, wn = wid & 3;
#pragma unroll
  for (int mi = 0; mi < 4; ++mi)
#pragma unroll
    for (int ni = 0; ni < 2; ++ni)
#pragma unroll
      for (int r = 0; r < 16; ++r) acc[mi][ni][r] = 0.f;
  uint4 a0, a1, a2, a3, b0, b1, b2, b3;
  const int nk = K / 64;
  const int lrow = tid >> 3, lkc = tid & 7;
  const u16* gA = A + (size_t)lrow * lda + lkc * 8;
  const u16* gB = Bt + (size_t)lrow * ldb + lkc * 8;
  const size_t sA = (size_t)64 * lda, sB = (size_t)64 * ldb;
  u16* wA = As + lrow * GLS + lkc * 8; u16* wB = Bs + lrow * GLS + lkc * 8;
#define GLOAD(kt) do { const u16* pa_ = gA + (kt) * 64; const u16* pb_ = gB + (kt) * 64; \
    a0 = *(const uint4*)(pa_); a1 = *(const uint4*)(pa_ + sA); a2 = *(const uint4*)(pa_ + 2 * sA); a3 = *(const uint4*)(pa_ + 3 * sA); \
    b0 = *(const uint4*)(pb_); b1 = *(const uint4*)(pb_ + sB); b2 = *(const uint4*)(pb_ + 2 * sB); b3 = *(const uint4*)(pb_ + 3 * sB); } while (0)
#define SWRITE(buf) do { u16* qa_ = wA + (buf) * 256 * GLS; u16* qb_ = wB + (buf) * 256 * GLS; \
    *(uint4*)(qa_) = a0; *(uint4*)(qa_ + 64 * GLS) = a1; *(uint4*)(qa_ + 128 * GLS) = a2; *(uint4*)(qa_ + 192 * GLS) = a3; \
    *(uint4*)(qb_) = b0; *(uint4*)(qb_ + 64 * GLS) = b1; *(uint4*)(qb_ + 128 * GLS) = b2; *(uint4*)(qb_ + 192 * GLS) = b3; } while (0)
  GLOAD(0); SWRITE(0); GLOAD(1);
  __syncthreads();
  for (int kt = 0; kt < nk; ++kt) {
    const int buf = kt & 1;
    const u16* Ab = As + buf * 256 * GLS + (wm * 128 + r32) * GLS + hi * 8;
    const u16* Bb = Bs + buf * 256 * GLS + (wn * 64 + r32) * GLS + hi * 8;
#pragma unroll
    for (int ks = 0; ks < 4; ++ks) {
      const bf16x8 fb0 = *(const bf16x8*)(Bb + ks * 16), fb1 = *(const bf16x8*)(Bb + 32 * GLS + ks * 16);
#pragma unroll
      for (int mi = 0; mi < 4; ++mi) {
        const bf16x8 fa = *(const bf16x8*)(Ab + mi * 32 * GLS + ks * 16);
        acc[mi][0] = __builtin_amdgcn_mfma_f32_32x32x16_bf16(fa, fb0, acc[mi][0], 0, 0, 0);
        acc[mi][1] = __builtin_amdgcn_mfma_f32_32x32x16_bf16(fa, fb1, acc[mi][1], 0, 0, 0);
      }
    }
    if (kt + 1 < nk) { SWRITE(buf ^ 1); if (kt + 2 < nk) GLOAD(kt + 2); }
    __syncthreads();
  }
#undef GLOAD
#undef SWRITE
}
__device__ __forceinline__ void store_tile256_bf16(const f32x16 (&acc)[4][2], u16* __restrict__ C, int ldc, int ncols) {
  const int wid = tidx() >> 6, lane = tidx() & 63, r32 = lane & 31, hi = lane >> 5, wm = wid >> 2, wn = wid & 3;
#pragma unroll
  for (int mi = 0; mi < 4; ++mi)
#pragma unroll
    for (int ni = 0; ni < 2; ++ni) {
      const int col = wn * 64 + ni * 32 + r32;
      if (col < ncols) {
#pragma unroll
        for (int r = 0; r < 16; ++r) C[(size_t)(wm * 128 + mi * 32 + crow(r, hi)) * ldc + col] = f2bf(acc[mi][ni][r]);
      }
    }
}
__device__ __forceinline__ void store_tile_bf16(const f32x16 (&acc)[2][2], u16* __restrict__ C, int ldc, int ncols) {
  const int wid = tidx() >> 6, lane = tidx() & 63, r32 = lane & 31, hi = lane >> 5, wm = wid >> 1, wn = wid & 1;
#pragma unroll
  for (int mi = 0; mi < 2; ++mi)
#pragma unroll
    for (int ni = 0; ni < 2; ++ni) {
      const int col = wn * 64 + ni * 32 + r32;
      if (col < ncols) {
#pragma unroll
        for (int r = 0; r < 16; ++r) C[(size_t)(wm * 64 + mi * 32 + crow(r, hi)) * ldc + col] = f2bf(acc[mi][ni][r]);
      }
    }
}

namespace att {
constexpr int D = 128, NW = 8, QBLK = 32, KVBLK = 64;
constexpr float SCALE = 0.088388347648318440f;
constexpr float THR = 8.f;
constexpr int LDQ = LDP, LDK = LDP;
constexpr size_t SHM_V = KVBLK * D * 2, SHM_K = KVBLK * D * 2, SHM_ATTN = 2 * SHM_V + 2 * SHM_K + NW * 64 * 4;
#define KSWZ(row, colB) ((row) * 256 + ((colB) ^ (((row) & 7) << 4)))
#define SBAR() __builtin_amdgcn_sched_barrier(0)
__device__ __forceinline__ unsigned cvtpk(float lo, float hi) {
  unsigned r; asm volatile("v_cvt_pk_bf16_f32 %0, %1, %2" : "=v"(r) : "v"(lo), "v"(hi)); return r;
}
__device__ __forceinline__ bf16x8 ld8(const bf16* p) { return *reinterpret_cast<const bf16x8*>(p); }
__device__ __forceinline__ void partialSM(f32x16& p0, f32x16& p1, float& m_reg, float& mn, float& alpha) {
  constexpr float C = SCALE * 1.4426950408889634f;
  float pmax = p0[0]; for (int r = 1; r < 16; ++r) pmax = fmaxf(pmax, p0[r]); for (int r = 0; r < 16; ++r) pmax = fmaxf(pmax, p1[r]);
  { auto rr = __builtin_amdgcn_permlane32_swap(__float_as_uint(pmax), __float_as_uint(pmax), false, false);
    pmax = fmaxf(__uint_as_float(rr[0]), __uint_as_float(rr[1])); }
  if (__builtin_expect(__all(pmax - m_reg <= THR / SCALE), 1)) { mn = m_reg; alpha = 1.f; }
  else { mn = fmaxf(m_reg, pmax); alpha = __builtin_amdgcn_exp2f((m_reg - mn) * C); m_reg = mn; }
  float mnC = -mn * C;
  for (int r = 0; r < 16; ++r) p0[r] = fmaf(p0[r], C, mnC); for (int r = 0; r < 16; ++r) p1[r] = fmaf(p1[r], C, mnC);
  for (int r = 0; r < 16; ++r) p0[r] = __builtin_amdgcn_exp2f(p0[r]);
}
__device__ __forceinline__ void finishSM(f32x16& p0, f32x16& p1, float alpha, float& l_reg, bf16x8& pa0, bf16x8& pa1, bf16x8& pa2, bf16x8& pa3) {
  for (int r = 0; r < 16; ++r) p1[r] = __builtin_amdgcn_exp2f(p1[r]);
  float ps = 0; for (int r = 0; r < 16; ++r) ps += p0[r]; for (int r = 0; r < 16; ++r) ps += p1[r];
  { auto rr = __builtin_amdgcn_permlane32_swap(__float_as_uint(ps), __float_as_uint(ps), false, false);
    ps = __uint_as_float(rr[0]) + __uint_as_float(rr[1]); }
  l_reg = l_reg * alpha + ps;
#define PK4(P, BASE, OUT) do { unsigned a0 = cvtpk(P[BASE + 0], P[BASE + 1]), a1 = cvtpk(P[BASE + 2], P[BASE + 3]);   \
    unsigned b0 = cvtpk(P[BASE + 4], P[BASE + 5]), b1 = cvtpk(P[BASE + 6], P[BASE + 7]);                              \
    auto r0 = __builtin_amdgcn_permlane32_swap(a0, b0, false, false); auto r1 = __builtin_amdgcn_permlane32_swap(a1, b1, false, false); \
    u32x4 w = {r0[0], r1[0], r0[1], r1[1]}; OUT = *reinterpret_cast<bf16x8*>(&w); } while (0)
  PK4(p0, 0, pa0); PK4(p0, 8, pa1); PK4(p1, 0, pa2); PK4(p1, 8, pa3);
#undef PK4
}
__device__ __forceinline__ void qkt(f32x16& p0, f32x16& p1, const bf16* Ks, const bf16x8* qr, int r32, int hi) {
  p0 = f32x16{}; p1 = f32x16{};
  for (int d0 = 0; d0 < 8; ++d0) { int cb = (d0 * 16 + hi * 8) * 2;
    bf16x8 b0 = *reinterpret_cast<const bf16x8*>((const char*)Ks + KSWZ(r32, cb));
    bf16x8 b1 = *reinterpret_cast<const bf16x8*>((const char*)Ks + KSWZ(32 + r32, cb));
    p0 = __builtin_amdgcn_mfma_f32_32x32x16_bf16(b0, qr[d0], p0, 0, 0, 0);
    p1 = __builtin_amdgcn_mfma_f32_32x32x16_bf16(b1, qr[d0], p1, 0, 0, 0); }
}
__device__ __forceinline__ int v_st(int k, int c) { const int kk = (k & ~0xC) | ((k & 4) << 1) | ((k & 8) >> 1); return ((kk >> 3) * 4 + (c >> 5)) * 512 + ((kk & 7) * 32 + (c & 31)) * 2; }
__device__ __forceinline__ int v_rd_base(int lane) { return ((lane & 3) << 3) | (((lane >> 2) & 3) << 6) | (((lane >> 4) & 1) << 5) | (((lane >> 5) & 1) << 8); }
constexpr int v_rd_off(int d0, int ks, int half) { return d0 * 512 + ks * 4096 + half * 2048; }
template <int OFF> __device__ __forceinline__ s16x4 tr_read(int vb) {
  s16x4 r; asm volatile("ds_read_b64_tr_b16 %0, %1 offset:%2" : "=&v"(r) : "v"(vb), "i"(OFF) : "memory"); return r;
}
template <int D0> __device__ __forceinline__ void pv_one(f32x16& od, int vb, bf16x8 pa0, bf16x8 pa1, bf16x8 pa2, bf16x8 pa3) {
  const s16x4 l0 = tr_read<v_rd_off(D0, 0, 0)>(vb), h0 = tr_read<v_rd_off(D0, 0, 1)>(vb), l1 = tr_read<v_rd_off(D0, 1, 0)>(vb), h1 = tr_read<v_rd_off(D0, 1, 1)>(vb);
  const s16x4 l2 = tr_read<v_rd_off(D0, 2, 0)>(vb), h2 = tr_read<v_rd_off(D0, 2, 1)>(vb), l3 = tr_read<v_rd_off(D0, 3, 0)>(vb), h3 = tr_read<v_rd_off(D0, 3, 1)>(vb);
  asm volatile("s_waitcnt lgkmcnt(0)" ::: "memory"); SBAR();
#define PK(L, H) (bf16x8){L[0], L[1], L[2], L[3], H[0], H[1], H[2], H[3]}
  od = __builtin_amdgcn_mfma_f32_32x32x16_bf16(pa0, PK(l0, h0), od, 0, 0, 0);
  od = __builtin_amdgcn_mfma_f32_32x32x16_bf16(pa1, PK(l1, h1), od, 0, 0, 0);
  od = __builtin_amdgcn_mfma_f32_32x32x16_bf16(pa2, PK(l2, h2), od, 0, 0, 0);
  od = __builtin_amdgcn_mfma_f32_32x32x16_bf16(pa3, PK(l3, h3), od, 0, 0, 0);
#undef PK
}
__device__ __forceinline__ void pv_d0(f32x16* o, int vb, bf16x8 pa0, bf16x8 pa1, bf16x8 pa2, bf16x8 pa3) {
  pv_one<0>(o[0], vb, pa0, pa1, pa2, pa3); pv_one<1>(o[1], vb, pa0, pa1, pa2, pa3); pv_one<2>(o[2], vb, pa0, pa1, pa2, pa3); pv_one<3>(o[3], vb, pa0, pa1, pa2, pa3);
}
__device__ __forceinline__ void attn_dense_body(const bf16* Qb, const bf16* __restrict__ Kh, const bf16* __restrict__ Vh,
                                                const u16* __restrict__ Gb, u16* Yb, int seq, char* lds) {
  const int tid = tidx(), wid = tid >> 6, lane = tid & 63, r32 = lane & 31, hi = lane >> 5;
  bf16* V_lds = (bf16*)lds; bf16* K_lds = (bf16*)(lds + 2 * SHM_V);
  float* ws = (float*)(lds + 2 * SHM_V + 2 * SHM_K) + wid * 64; float* li_l = ws; float* al_l = ws + 32;
  float m_reg = -1e30f, l_reg = 0; f32x16 o[4] = {}; bf16x8 qr[8];
  const bf16* Qw = Qb + (long)(wid * QBLK + r32) * LDQ + hi * 8;
#pragma unroll
  for (int d0 = 0; d0 < 8; ++d0) qr[d0] = ld8(Qw + d0 * 16);
  const int sr = tid >> 4, sc = (tid & 15) * 8, vst0 = v_st(sr, sc), vst1 = v_st(32 + sr, sc);
  const int vb0 = (int)(uintptr_t)V_lds + v_rd_base(lane);
  struct { bf16x8 vs0, vs1, ks0, ks1; } sr_[2];
#define SLOAD(i, k0) do { sr_[i].vs0 = ld8(&Vh[(long)((k0) + sr) * LDK + sc]); sr_[i].vs1 = ld8(&Vh[(long)((k0) + 32 + sr) * LDK + sc]); \
    sr_[i].ks0 = ld8(&Kh[(long)((k0) + sr) * LDK + sc]); sr_[i].ks1 = ld8(&Kh[(long)((k0) + 32 + sr) * LDK + sc]); } while (0)
#define SWRITE(b, i) do { *(bf16x8*)((char*)V_lds + (b) * SHM_V + vst0) = sr_[i].vs0;          \
    *(bf16x8*)((char*)V_lds + (b) * SHM_V + vst1) = sr_[i].vs1; int kc = sc * 2;               \
    *(bf16x8*)((char*)K_lds + (b) * SHM_K + KSWZ(sr, kc)) = sr_[i].ks0;                       \
    *(bf16x8*)((char*)K_lds + (b) * SHM_K + KSWZ(32 + sr, kc)) = sr_[i].ks1; } while (0)
#define SWAIT() do { asm volatile("s_waitcnt vmcnt(4)" ::: "memory"); } while (0)
#define RESC(a) do { if (__any((a) < 1.f)) { if (hi == 0) al_l[r32] = (a); asm volatile("s_waitcnt lgkmcnt(0)" ::: "memory"); \
    for (int d = 0; d < 4; ++d) for (int r = 0; r < 16; ++r) o[d][r] *= al_l[crow(r, hi)]; } } while (0)
  f32x16 pA0, pA1, pB0, pB1; float mnA, mnB, alA, alB; bf16x8 pa0, pa1, pa2, pa3; const int NT = seq / KVBLK;
  constexpr int SE = 0, SO = 1;
  SLOAD(SE, 0); asm volatile("s_waitcnt vmcnt(0)" ::: "memory"); SWRITE(0, SE); __syncthreads();
  qkt(pA0, pA1, K_lds, qr, r32, hi); partialSM(pA0, pA1, m_reg, mnA, alA);
  SLOAD(SO, KVBLK); if (2 < NT) SLOAD(SE, 2 * KVBLK);
  SWAIT(); SWRITE(1, SO); __syncthreads();
  for (int j = 1; j + 1 < NT; j += 2) {
    SBAR(); qkt(pB0, pB1, (bf16*)((char*)K_lds + SHM_K), qr, r32, hi);
    finishSM(pA0, pA1, alA, l_reg, pa0, pa1, pa2, pa3); SBAR();
    SLOAD(SO, (j + 2) * KVBLK); SBAR();
    pv_d0(o, vb0, pa0, pa1, pa2, pa3); partialSM(pB0, pB1, m_reg, mnB, alB);
    __syncthreads(); SWAIT(); SWRITE(0, SE);
    RESC(alB); __syncthreads();
    SBAR(); qkt(pA0, pA1, K_lds, qr, r32, hi);
    finishSM(pB0, pB1, alB, l_reg, pa0, pa1, pa2, pa3); SBAR();
    if (j + 3 < NT) SLOAD(SE, (j + 3) * KVBLK); SBAR();
    pv_d0(o, vb0 + (int)SHM_V, pa0, pa1, pa2, pa3); partialSM(pA0, pA1, m_reg, mnA, alA);
    __syncthreads(); SWAIT(); SWRITE(1, SO);
    RESC(alA); __syncthreads();
  }
  SBAR(); qkt(pB0, pB1, (bf16*)((char*)K_lds + SHM_K), qr, r32, hi);
  finishSM(pA0, pA1, alA, l_reg, pa0, pa1, pa2, pa3); SBAR();
  pv_d0(o, vb0, pa0, pa1, pa2, pa3); partialSM(pB0, pB1, m_reg, mnB, alB);
  __syncthreads(); RESC(alB);
  finishSM(pB0, pB1, alB, l_reg, pa0, pa1, pa2, pa3); SBAR();
  pv_d0(o, vb0 + (int)SHM_V, pa0, pa1, pa2, pa3);
  if (hi == 0) li_l[r32] = l_reg; asm volatile("s_waitcnt lgkmcnt(0)" ::: "memory");
  float rli[16];
#pragma unroll
  for (int r = 0; r < 16; ++r) rli[r] = __builtin_amdgcn_rcpf(li_l[crow(r, hi)]);
#pragma unroll
  for (int r = 0; r < 16; ++r) { const long orow = wid * QBLK + crow(r, hi);
#pragma unroll
    for (int d0 = 0; d0 < 4; ++d0) {
      const float gt = bf2f(Gb[orow * LDQ + d0 * 32 + r32]);
      Yb[orow * LDQ + d0 * 32 + r32] = f2bf(o[d0][r] * rli[r] * siluf_(gt));
    } }
  __syncthreads();
#undef SLOAD
#undef SWRITE
#undef SWAIT
#undef RESC
}
}

__device__ __forceinline__ const float* xrow_ptr(KParams p, int l, int r) {
  const int b = r / SB, s = r % SB;
  if (s < T) return (l == 0 ? p->x : (const float*)p->out) + ((size_t)b * T + s) * DM;
  return (l == 0 ? p->ctx : (const float*)p->xc1) + ((size_t)b * TC + (s - T)) * DM;
}
__device__ __forceinline__ void hrow_write(const float4 (&v)[4], const float* __restrict__ g_pre, const float* __restrict__ md, u16* dst, int lane) {
  float ss = 0.f;
#pragma unroll
  for (int i = 0; i < 4; ++i) ss += v[i].x * v[i].x + v[i].y * v[i].y + v[i].z * v[i].z + v[i].w * v[i].w;
  ss = wave_sum(ss);
  const float rstd = rsqrtf(ss * (1.f / 1024.f) + 1e-6f);
#pragma unroll
  for (int i = 0; i < 4; ++i) {
    const int col = i * 256 + lane * 4;
    const float4 g = *(const float4*)(g_pre + col), sc = *(const float4*)(md + 1024 + col), sh = *(const float4*)(md + col);
    ushort4 o;
    o.x = f2bf(v[i].x * rstd * g.x * (1.f + sc.x) + sh.x); o.y = f2bf(v[i].y * rstd * g.y * (1.f + sc.y) + sh.y);
    o.z = f2bf(v[i].z * rstd * g.z * (1.f + sc.z) + sh.z); o.w = f2bf(v[i].w * rstd * g.w * (1.f + sc.w) + sh.w);
    *(ushort4*)(dst + col) = o;
  }
}

__device__ __forceinline__ void transpose_tile(const float* __restrict__ src, u16* __restrict__ dst, int K, int N, int nt, int kt, char* smem) {
  float* tile = (float*)smem;
  const int n0 = nt * 64, k0 = kt * 64, tx = tidx() & 63, ty = tidx() >> 6;
  __syncthreads();
#pragma unroll
  for (int i = 0; i < 8; ++i) { const int k = i * 8 + ty, n = n0 + tx; tile[k * 65 + tx] = (n < N) ? src[(size_t)(k0 + k) * N + n] : 0.f; }
  __syncthreads();
#pragma unroll
  for (int i = 0; i < 8; ++i) { const int n = i * 8 + ty; dst[(size_t)(n0 + n) * K + k0 + tx] = f2bf(tile[tx * 65 + n]); }
}
__device__ __forceinline__ void mod_item(KParams p, int item, char* smem) {
  float* sc = (float*)smem;
  float* red = sc + 17 * 512;
  const int l = item / 48, cgp = item % 48, tid = tidx(), kg = tid >> 6, jl = tid & 63, j = cgp * 64 + jl;
  const float* W = p->w_mod + (size_t)l * 1024 * 3072;
  float acc[17];
#pragma unroll
  for (int i = 0; i < 17; ++i) acc[i] = 0.f;
  for (int half = 0; half < 2; ++half) {
    __syncthreads();
    for (int e = tid; e < 17 * 512; e += 512) { const int i = e >> 9, k = e & 511; const float v = (i < 16) ? p->c[i * 1024 + half * 512 + k] : p->c_ctx[half * 512 + k]; sc[e] = siluf_(v); }
    __syncthreads();
    for (int kk = 0; kk < 64; ++kk) {
      const int k = kg * 64 + kk;
      const float w = W[(size_t)(half * 512 + k) * 3072 + j];
#pragma unroll
      for (int i = 0; i < 17; ++i) acc[i] += sc[i * 512 + k] * w;
    }
  }
#pragma unroll
  for (int i = 0; i < 17; ++i) red[(kg * 17 + i) * 64 + jl] = acc[i];
  __syncthreads();
  for (int e = tid; e < 17 * 64; e += 512) { const int i = e >> 6, jj = e & 63;
    float v = p->b_mod[l * 3072 + cgp * 64 + jj];
#pragma unroll
    for (int g = 0; g < 8; ++g) v += red[(g * 17 + i) * 64 + jj];
    p->mod[((size_t)l * 17 + i) * 3072 + cgp * 64 + jj] = v; }
}
__device__ __forceinline__ void phase_prologue(KParams p, char* smem) {
  constexpr int N_IN = 2 * 134 * 16, N_O = 2 * 3 * 16 * 8, N_OUT = 2 * 16 * 16, N_MOD = 96;
  for (int it = blockIdx.x; it < N_IN + N_O + N_OUT + N_MOD; it += gridDim.x) {
    if (it < N_MOD) mod_item(p, it, smem);
    else if (it < N_MOD + N_IN) { const int u = it - N_MOD, l = u / (134 * 16), v = u % (134 * 16);
      transpose_tile(p->w_in + (size_t)l * 1024 * DIN, p->Wt_in + (size_t)l * DINP * 1024, 1024, DIN, v % 134, v / 134, smem); }
    else if (it < N_MOD + N_IN + N_O) { const int u = it - N_MOD - N_IN, li = u / 128, v = u % 128, l = li / 3, i = li % 3;
      const float* src = (i == 0 ? p->w_o_gla : i == 1 ? p->w_o_att : p->w_o_rwkv) + (size_t)l * 512 * 1024;
      transpose_tile(src, p->Wt_o + (size_t)li * 1024 * 512, 512, 1024, v % 16, v / 16, smem); }
    else { const int u = it - N_MOD - N_IN - N_O, l = u / 256, v = u % 256;
      transpose_tile(p->w_out + (size_t)l * 1024 * 1024, p->Wt_out + (size_t)l * 1024 * 1024, 1024, 1024, v % 16, v / 16, smem); }
  }
}

__device__ __forceinline__ void phase_a0(KParams p) {
  const int wid = tidx() >> 6, lane = tidx() & 63;
  for (int r = blockIdx.x * 8 + wid; r < R; r += gridDim.x * 8) {
    const int b = r / SB, s = r % SB;
    const float* src = xrow_ptr(p, 0, r);
    float4 v[4];
#pragma unroll
    for (int i = 0; i < 4; ++i) v[i] = *(const float4*)(src + i * 256 + lane * 4);
    hrow_write(v, p->g_pre, p->mod + (size_t)((s < T) ? b : 16) * 3072, p->SH + (size_t)r * 1024, lane);
  }
}

namespace pg8 {
#define PG8_LAS __attribute__((address_space(3)))
typedef unsigned short bf16_t;
typedef short bf16x8 __attribute__((ext_vector_type(8)));
typedef float f32x4 __attribute__((ext_vector_type(4)));
typedef unsigned u32x4 __attribute__((ext_vector_type(4)));
constexpr int BM = 256, BK = 64, HALF = 128, HTB = HALF * BK * 2  , STAGE_BYTES = 8 * HTB, NXCD = 8, WGM = 8;

__host__ __device__ __forceinline__ int lds_byte(int r, int c) { const int st = (r >> 4) * 2 + (c >> 5), rr = r & 15, cc = c & 31, ob = rr * 64 + cc * 2; return st * 1024 + (ob ^ (((ob >> 9) & 1) << 5)); }
__host__ __device__ __forceinline__ void stage_rc(int b, int& R, int& C) { const int st = b / 1024, sb = b % 1024, swz = sb ^ (((sb >> 9) & 1) << 5); R = (st >> 1) * 16 + swz / 64; C = (st & 1) * 32 + (swz % 64) / 2; }
__host__ __device__ __forceinline__ int perm32(int rho) { const int n = rho >> 4, i = rho & 15; return 8 * (i >> 2) + 4 * n + (i & 3); }

struct Unit { int pm, pn; };
struct Gemm { const bf16_t* A; const bf16_t* Bt; int M, N, K; };

struct StaticOrder {
    int nM, nN, nwg, G, c;
    __host__ __device__ void init(int M, int N, int G_, int c_) { nM = M / BM; nN = N / BM; nwg = nM * nN; G = G_; c = c_; }
    __host__ __device__ bool next(int i, Unit& u) const {
        const long L = (long)i * G + c; if (L >= nwg) return false;
        int wgid = (int)L; { const int q = nwg / NXCD, r = nwg % NXCD, xcd = wgid % NXCD, off = wgid / NXCD; wgid = (xcd < r ? xcd * (q + 1) : r * (q + 1) + (xcd - r) * q) + off; }
        const int nig = WGM * nN, gid = wgid / nig, fm = gid * WGM, gsz = (nM - fm) < WGM ? (nM - fm) : WGM;
        u.pm = fm + ((wgid % nig) % gsz); u.pn = (wgid % nig) / gsz; return true;
    }
    __device__ __forceinline__ void a_ready(const Unit&) const {}
    __device__ __forceinline__ void done(const Unit&) const {}
};
struct EpiProj {
    static constexpr bool PERM = true, AFTER_DRAIN = false;
    bf16_t* O; int ldc; int ncols;
    __device__ __forceinline__ void operator()(const f32x4 (&acc)[2][2][4][2], const Unit& u, int wr, int wc, int fr, int fq) const {
        const int row0 = u.pm * BM + wr * 64 + fr, col0 = u.pn * BM + wc * 32 + 8 * fq;
#pragma unroll
        for (int ai = 0; ai < 2; ++ai)
#pragma unroll
            for (int m = 0; m < 4; ++m) { bf16_t* rowp = O + (size_t)(row0 + ai * HALF + m * 16) * ldc + col0;
#pragma unroll
                for (int bj = 0; bj < 2; ++bj) if (col0 + bj * HALF < ncols) { const f32x4 v0 = acc[ai][bj][m][0], v1 = acc[ai][bj][m][1];
                    u32x4 w; w.x = pack2(v0[0], v0[1]); w.y = pack2(v0[2], v0[3]); w.z = pack2(v1[0], v1[1]); w.w = pack2(v1[2], v1[3]);
                    *(u32x4*)(rowp + bj * HALF) = w; } }
    }
};
template <class Epi, class Sched, bool STAMP = false>
__device__ __forceinline__ void gemm_phase(PG8_LAS unsigned char* lds, const Gemm g, const Sched& S, const Epi& E, unsigned long long* stamps) {
    const int tid = tidx(), wid = __builtin_amdgcn_readfirstlane(tid >> 6), lane = tid & 63, wr = wid >> 2, wc = wid & 3, fr = lane & 15, fq = lane >> 4;
    const int K = g.K, nt = K / BK;
    int ts_lo = 0, ts_hi = 0, nts = 0; const unsigned long long rt_entry = STAMP ? (unsigned long long)wall_clock64() : 0ull;
#define PG8_STAMP() do { if (STAMP && wid == 0 && nts < 64) { const unsigned long long _c = (unsigned long long)clock64(); \
        ts_lo = (lane == nts) ? (int)(unsigned)_c : ts_lo; ts_hi = (lane == nts) ? (int)(unsigned)(_c >> 32) : ts_hi; ++nts; } } while (0)
    PG8_STAMP();
    unsigned voffA[2], voffB[2];
#pragma unroll
    for (int i = 0; i < 2; ++i) { int R, C; stage_rc(tid * 16 + i * 8192, R, C); const int Rb = Epi::PERM ? ((R & ~31) + perm32(R & 31)) : R;
        voffA[i] = (unsigned)(R * K + C) * 2u; voffB[i] = (unsigned)(Rb * K + C) * 2u; }
    const size_t kstep = (size_t)(BK * 2);
    const size_t hstep = (size_t)HALF * K * 2;
    const size_t tstep = 2 * hstep;
    const unsigned ldsw = (unsigned)wid * 1024u;
    const int aoff = lds_byte(wr * 64 + fr, fq * 8), boff = lds_byte(wc * 32 + fr, fq * 8);
#define PG8_SA(b, h) (((b) * 2 + (h)) * HTB)
#define PG8_SB(b, h) ((4 + (b) * 2 + (h)) * HTB)
#define PG8_STAGE(bufoff, gbase, voff) do { _Pragma("unroll") for (int _i = 0; _i < 2; ++_i) \
        __builtin_amdgcn_global_load_lds((const unsigned*)((const char*)(gbase) + (voff)[_i]), (PG8_LAS unsigned*)(lds + (bufoff) + ldsw + _i * 8192), 16, 0, 0); } while (0)
#define PG8_LDA(dst, b, h) do { _Pragma("unroll") for (int m = 0; m < 4; ++m) _Pragma("unroll") for (int k = 0; k < 2; ++k) dst[m][k] = *(const PG8_LAS bf16x8*)(lds + PG8_SA(b, h) + aoff + m * 2048 + k * 1024); } while (0)
#define PG8_LDB(dst, b, h) do { _Pragma("unroll") for (int n = 0; n < 2; ++n) _Pragma("unroll") for (int k = 0; k < 2; ++k) dst[n][k] = *(const PG8_LAS bf16x8*)(lds + PG8_SB(b, h) + boff + n * 2048 + k * 1024); } while (0)
#define PG8_MMA(ai, bj, At, Bt) do { __builtin_amdgcn_s_setprio(1); _Pragma("unroll") for (int m = 0; m < 4; ++m) _Pragma("unroll") for (int n = 0; n < 2; ++n) _Pragma("unroll") for (int k = 0; k < 2; ++k) \
        acc[ai][bj][m][n] = __builtin_amdgcn_mfma_f32_16x16x32_bf16(Bt[n][k], At[m][k], acc[ai][bj][m][n], 0, 0, 0); __builtin_amdgcn_s_setprio(0); } while (0)
#define PG8_WAIT_V(n) asm volatile("s_waitcnt vmcnt(" #n ")" ::: "memory")
#define PG8_WAIT_L(n) asm volatile("s_waitcnt lgkmcnt(" #n ")" ::: "memory")
#define PG8_BAR __builtin_amdgcn_s_barrier()
#define PG8_SCHED __builtin_amdgcn_sched_barrier(0)
    Unit cur, nxt; int ui = 0;
    if (!S.next(0, cur)) return;
    f32x4 acc[2][2][4][2];
#pragma unroll
    for (int a = 0; a < 2; ++a)
#pragma unroll
        for (int b = 0; b < 2; ++b)
#pragma unroll
            for (int m = 0; m < 4; ++m)
#pragma unroll
                for (int n = 0; n < 2; ++n) acc[a][b][m][n] = (f32x4){0.f, 0.f, 0.f, 0.f};
    bf16x8 At[4][2], B0[2][2], B1[2][2];
    const char* cA = (const char*)g.A + (size_t)cur.pm * tstep; const char* cB = (const char*)g.Bt + (size_t)cur.pn * tstep;
    S.a_ready(cur);
    PG8_STAGE(PG8_SB(0, 0), cB, voffB); PG8_STAGE(PG8_SA(0, 0), cA, voffA); PG8_STAGE(PG8_SB(0, 1), cB + hstep, voffB); PG8_STAGE(PG8_SA(0, 1), cA + hstep, voffA);
    if (wr == 1) PG8_BAR;
    PG8_WAIT_V(4); PG8_BAR;
    PG8_STAGE(PG8_SB(1, 0), cB + kstep, voffB); PG8_STAGE(PG8_SA(1, 0), cA + kstep, voffA); PG8_STAGE(PG8_SB(1, 1), cB + hstep + kstep, voffB);
    PG8_WAIT_V(6); PG8_BAR;
    PG8_STAMP();
    for (;;) {
        const bool has_next = S.next(ui + 1, nxt);
        const char* nA = has_next ? (const char*)g.A + (size_t)nxt.pm * tstep : cA; const char* nB = has_next ? (const char*)g.Bt + (size_t)nxt.pn * tstep : cB;
        for (int t = 0; t < nt; t += 2) {
            const bool last = (t == nt - 2);
            const char* a1 = cA + (size_t)(t + 1) * kstep;
            const char* a2 = last ? nA : cA + (size_t)(t + 2) * kstep; const char* b2 = last ? nB : cB + (size_t)(t + 2) * kstep;
            const char* a3 = a2 + kstep; const char* b3 = b2 + kstep;
            if (last && has_next) S.a_ready(nxt);
            PG8_LDB(B0, 0, 0); PG8_SCHED; PG8_LDA(At, 0, 0); PG8_STAGE(PG8_SA(1, 1), a1 + hstep, voffA);
            PG8_WAIT_L(8); PG8_BAR; PG8_WAIT_L(0); PG8_MMA(0, 0, At, B0); PG8_BAR; PG8_SCHED;
            PG8_LDB(B1, 0, 1); PG8_STAGE(PG8_SB(0, 0), b2, voffB);
            PG8_BAR; PG8_WAIT_L(0); PG8_MMA(0, 1, At, B1); PG8_BAR;
            PG8_LDA(At, 0, 1); PG8_STAGE(PG8_SA(0, 0), a2, voffA);
            PG8_BAR; PG8_WAIT_L(0); PG8_MMA(1, 0, At, B0); PG8_BAR; PG8_SCHED;
            PG8_STAGE(PG8_SB(0, 1), b2 + hstep, voffB);
            PG8_WAIT_V(6); PG8_BAR; PG8_MMA(1, 1, At, B1); PG8_BAR;
            PG8_LDB(B0, 1, 0); PG8_SCHED; PG8_LDA(At, 1, 0); PG8_STAGE(PG8_SA(0, 1), a2 + hstep, voffA);
            PG8_WAIT_L(8); PG8_BAR; PG8_WAIT_L(0); PG8_MMA(0, 0, At, B0); PG8_BAR; PG8_SCHED;
            PG8_LDB(B1, 1, 1); PG8_STAGE(PG8_SB(1, 0), b3, voffB);
            PG8_BAR; PG8_WAIT_L(0); PG8_MMA(0, 1, At, B1); PG8_BAR;
            PG8_LDA(At, 1, 1); PG8_STAGE(PG8_SA(1, 0), a3, voffA);
            PG8_BAR; PG8_WAIT_L(0); PG8_MMA(1, 0, At, B0); PG8_BAR; PG8_SCHED;
            PG8_STAGE(PG8_SB(1, 1), b3 + hstep, voffB);
            PG8_WAIT_V(6); PG8_BAR; PG8_MMA(1, 1, At, B1); PG8_BAR;
        }
        PG8_STAMP();
        if constexpr (!Epi::AFTER_DRAIN) { E(acc, cur, wr, wc, fr, fq); S.done(cur); }
        PG8_STAMP();
        if (!has_next) break;
#pragma unroll
        for (int a = 0; a < 2; ++a)
#pragma unroll
            for (int b = 0; b < 2; ++b)
#pragma unroll
                for (int m = 0; m < 4; ++m)
#pragma unroll
                    for (int n = 0; n < 2; ++n) acc[a][b][m][n] = (f32x4){0.f, 0.f, 0.f, 0.f};
        cur = nxt; cA = nA; cB = nB; ++ui;
    }
    PG8_WAIT_V(0);
    if (wr == 0) PG8_BAR;
    PG8_BAR;
    if constexpr (Epi::AFTER_DRAIN) { E.fused(acc, cur, wr, wc, fr, fq, lds, wid, lane); S.done(cur); }
    PG8_STAMP();
    if (STAMP && wid == 0) { stamps[lane] = lane < nts ? (((unsigned long long)(unsigned)ts_hi << 32) | (unsigned)ts_lo) : 0ull;
        if (lane == 62) stamps[62] = rt_entry; if (lane == 63) stamps[63] = (unsigned long long)wall_clock64(); }
#undef PG8_STAMP
#undef PG8_SA
#undef PG8_SB
#undef PG8_STAGE
#undef PG8_LDA
#undef PG8_LDB
#undef PG8_MMA
#undef PG8_WAIT_V
#undef PG8_WAIT_L
#undef PG8_BAR
#undef PG8_SCHED
}
}
__device__ __forceinline__ bool xcd_tile(int i, int nrt, int nnt, int& rt, int& nt) {
  const int x = blockIdx.x & 7, j = blockIdx.x >> 3, nb = gridDim.x >> 3;
  const int rpx = nrt >> 3;
  const int q = i * nb + j;
  if (q >= rpx * nnt) return false;
  const int g = q / (4 * nnt), r = q % (4 * nnt);
  const int gs = (rpx - g * 4) < 4 ? (rpx - g * 4) : 4;
  rt = x * rpx + g * 4 + r % gs; nt = r / gs;
  return true;
}
__device__ __forceinline__ void phase_a1(KParams p, int l, char* smem) {
  pg8::Gemm g; g.A = p->SH; g.Bt = p->Wt_in + (size_t)l * DINP * 1024; g.M = R; g.N = 22 * 256; g.K = 1024;
  pg8::StaticOrder S; S.init(g.M, g.N, (int)gridDim.x, (int)blockIdx.x);
  pg8::EpiProj E; E.O = p->P; E.ldc = LDP; E.ncols = LDP;
  pg8::gemm_phase<pg8::EpiProj, pg8::StaticOrder, false>((PG8_LAS unsigned char*)smem, g, S, E, nullptr);
}

__device__ __forceinline__ void attn_prep_all(KParams p, int l) {
  const float* qn = p->att_qnorm + l * 128; const float* kn = p->att_knorm + l * 128;
  const int tid = tidx(), k = tid & 15;
  const float inv0 = exp2f(-(float)(2 * k) * (13.287712379549449f / 32.f)), inv1 = exp2f(-(float)(2 * k + 1) * (13.287712379549449f / 32.f));
  for (long item = (long)blockIdx.x * 32 + (tid >> 4); item < (long)R * 6; item += (long)gridDim.x * 32) {
    const int r = (int)(item / 6), hh = (int)(item % 6), s = r % SB;
    const int col = (hh < 4) ? C_AQ + hh * 128 : C_AK + (hh - 4) * 128;
    const float* gw = (hh < 4) ? qn : kn;
    unsigned* pp = (unsigned*)(p->P + (size_t)r * LDP + col);
    const unsigned w0 = pp[k], w1 = pp[16 + k], w2 = pp[32 + k], w3 = pp[48 + k];
    float a0 = __uint_as_float(w0 << 16), a1 = __uint_as_float(w0 & 0xffff0000u), b0 = __uint_as_float(w1 << 16), b1 = __uint_as_float(w1 & 0xffff0000u);
    float c0 = __uint_as_float(w2 << 16), c1 = __uint_as_float(w2 & 0xffff0000u), d0 = __uint_as_float(w3 << 16), d1 = __uint_as_float(w3 & 0xffff0000u);
    const float ss = red16(a0 * a0 + a1 * a1 + b0 * b0 + b1 * b1 + c0 * c0 + c1 * c1 + d0 * d0 + d1 * d1);
    const float rstd = rsqrtf(ss * (1.f / 128.f) + 1e-6f);
    const float2 ga = *(const float2*)(gw + 2 * k), gb = *(const float2*)(gw + 32 + 2 * k), gc = *(const float2*)(gw + 64 + 2 * k), gd = *(const float2*)(gw + 96 + 2 * k);
    a0 *= rstd * ga.x; a1 *= rstd * ga.y; b0 *= rstd * gb.x; b1 *= rstd * gb.y; c0 *= rstd * gc.x; c1 *= rstd * gc.y; d0 *= rstd * gd.x; d1 *= rstd * gd.y;
    if (s < T) {
      const float pr = (float)(s >> 6), pc = (float)(s & 63);
      const float cr0 = __cosf(pr * inv0), sr0 = __sinf(pr * inv0), cr1 = __cosf(pr * inv1), sr1 = __sinf(pr * inv1);
      const float cc0 = __cosf(pc * inv0), sc0 = __sinf(pc * inv0), cc1 = __cosf(pc * inv1), sc1 = __sinf(pc * inv1);
      const float na0 = a0 * cr0 - b0 * sr0, nb0 = b0 * cr0 + a0 * sr0, na1 = a1 * cr1 - b1 * sr1, nb1 = b1 * cr1 + a1 * sr1;
      const float nc0 = c0 * cc0 - d0 * sc0, nd0 = d0 * cc0 + c0 * sc0, nc1 = c1 * cc1 - d1 * sc1, nd1 = d1 * cc1 + c1 * sc1;
      a0 = na0; b0 = nb0; a1 = na1; b1 = nb1; c0 = nc0; d0 = nd0; c1 = nc1; d1 = nd1;
    }
    pp[k] = pack2(a0, a1); pp[16 + k] = pack2(b0, b1); pp[32 + k] = pack2(c0, c1); pp[48 + k] = pack2(d0, d1);
  }
}

__device__ __forceinline__ float logsig16(float x) { return (fminf(x, 0.f) - __logf(1.f + __expf(-fabsf(x)))) * (1.f / 16.f); }
__device__ __forceinline__ void gla_state_unit(KParams p, int l, int unit, char* smem) {
  const int dir = unit & 1, h = (unit >> 1) & 3, b = unit >> 3;
  float* gc = (float*)smem;
  float* segtot = gc + 4096;
  float* lr = segtot + 512;
  float* dec = lr + 1024;
  float* edec = dec + 64;
  u16* KT = (u16*)(edec + 64);
  u16* VT = KT + 64 * 72;
  const int tid = tidx(), wid = tid >> 6, lane = tid & 63, r32 = lane & 31, hi = lane >> 5, mi = wid >> 2, ni = wid & 3;
  const int dd = tid & 63, seg = tid >> 6;
  const int ts = tid >> 3, td0 = (tid & 7) * 8;
  const float* wup = (dir ? p->gla_wup_b : p->gla_wup_f) + l * 16 * 256 + h * 64 + dd;
  float wu[16];
#pragma unroll
  for (int i = 0; i < 16; ++i) wu[i] = wup[i * 256];
  const float bia = ((dir ? p->gla_b_b : p->gla_b_f) + l * 256 + h * 64)[dd];
  f32x16 acc;
#pragma unroll
  for (int r = 0; r < 16; ++r) acc[r] = 0.f;
  uint4 kreg, vreg0, vreg1, lreg = make_uint4(0, 0, 0, 0);
#define GS_BASE(pi) (dir == 0 ? ((pi) < 4 ? T + 64 * (pi) : 64 * ((pi) - 4)) : ((pi) < 4 ? T + 64 * (3 - (pi)) : 64 * (67 - (pi))))
#define GS_LOAD(pi) do { const u16* Pr_ = p->P + (size_t)(b * SB + GS_BASE(pi) + ts) * LDP; \
    kreg = *(const uint4*)(Pr_ + C_GK + h * 64 + td0); vreg0 = *(const uint4*)(Pr_ + C_GV + h * 128 + td0); vreg1 = *(const uint4*)(Pr_ + C_GV + h * 128 + 64 + td0); \
    if (tid < 128) lreg = *(const uint4*)(p->P + (size_t)(b * SB + GS_BASE(pi) + (tid >> 1)) * LDP + C_GWF + dir * 16 + (tid & 1) * 8); } while (0)
  GS_LOAD(0);
  __syncthreads();
  for (int pi = 0; pi < 68; ++pi) {
    const int cid = GS_BASE(pi) >> 6;
    if (tid < 128) unpack8(lreg, lr + (tid >> 1) * 16 + (tid & 1) * 8);
    { const u16* v0 = (const u16*)&vreg0; const u16* v1 = (const u16*)&vreg1;
#pragma unroll
      for (int j = 0; j < 8; ++j) { VT[(td0 + j) * 72 + ts] = v0[j]; VT[(64 + td0 + j) * 72 + ts] = v1[j]; } }
    __syncthreads();
    float gv[8]; float run = 0.f;
#pragma unroll
    for (int j = 0; j < 8; ++j) { const int i = seg * 8 + j, c = dir ? 63 - i : i;
      float x = bia;
#pragma unroll
      for (int q = 0; q < 16; ++q) x += lr[c * 16 + q] * wu[q];
      run += logsig16(x); gv[j] = run; }
    segtot[seg * 64 + dd] = run;
    __syncthreads();
    { float offs = 0.f, tot = 0.f;
#pragma unroll
      for (int q = 0; q < 8; ++q) { const float t_ = segtot[q * 64 + dd]; tot += t_; if (q < seg) offs += t_; }
#pragma unroll
      for (int j = 0; j < 8; ++j) { const int i = seg * 8 + j, c = dir ? 63 - i : i; gc[c * 64 + dd] = gv[j] + offs; }
      if (seg == 0) { dec[dd] = tot; edec[dd] = __expf(tot); } }
    __syncthreads();
    { float kf[8]; unpack8(kreg, kf);
      const float4 g0 = *(const float4*)(gc + ts * 64 + td0), g1 = *(const float4*)(gc + ts * 64 + td0 + 4);
      const float4 t0 = *(const float4*)(dec + td0), t1 = *(const float4*)(dec + td0 + 4);
      const float gg[8] = {g0.x, g0.y, g0.z, g0.w, g1.x, g1.y, g1.z, g1.w}, tt[8] = {t0.x, t0.y, t0.z, t0.w, t1.x, t1.y, t1.z, t1.w};
#pragma unroll
      for (int j = 0; j < 8; ++j) KT[(td0 + j) * 72 + ts] = f2bf(kf[j] * __expf(tt[j] - gg[j])); }
    if (pi + 1 < 68) GS_LOAD(pi + 1);
    __syncthreads();
    { u16* ST = p->SH + ((((size_t)(b * 4 + h) * 2 + dir) * 68 + cid) * 128 + 32 * ni + r32) * 64 + 32 * mi + 4 * hi;
#pragma unroll
      for (int rg = 0; rg < 4; ++rg) *(uint2*)(ST + 8 * rg) = make_uint2(pack2(acc[4 * rg], acc[4 * rg + 1]), pack2(acc[4 * rg + 2], acc[4 * rg + 3]));
#pragma unroll
      for (int r = 0; r < 16; ++r) acc[r] *= edec[32 * mi + crow(r, hi)];
#pragma unroll
      for (int ks = 0; ks < 4; ++ks) {
        const bf16x8 a = *(const bf16x8*)(KT + (32 * mi + r32) * 72 + ks * 16 + hi * 8), bb = *(const bf16x8*)(VT + (32 * ni + r32) * 72 + ks * 16 + hi * 8);
        acc = __builtin_amdgcn_mfma_f32_32x32x16_bf16(a, bb, acc, 0, 0, 0);
      } }
    __syncthreads();
  }
#undef GS_LOAD
#undef GS_BASE
}
__device__ __forceinline__ void gla_out_tile(KParams p, int l, int b, int h, int cid, char* smem) {
  u16* X = (u16*)smem;
  u16* VT = X + 64 * 200;
  char* U = smem + 76800;
  float* Gf = (float*)U; float* Gb = Gf + 4096; float* segtot = Gb + 4096;
  u16* KI = (u16*)(U + 36864);
  float* O = (float*)U;
  float* lr = (float*)(smem + 76800 + 55296);
  const int tid = tidx(), wid = tid >> 6, lane = tid & 63, r32 = lane & 31, hi = lane >> 5;
  const int dd = tid & 63, seg = tid >> 6, ts = tid >> 3, td0 = (tid & 7) * 8;
  u16* Pr = p->P + (size_t)(b * SB + cid * 64) * LDP;
  const uint4 qreg = *(const uint4*)(Pr + (size_t)ts * LDP + C_GQ + h * 64 + td0), kreg = *(const uint4*)(Pr + (size_t)ts * LDP + C_GK + h * 64 + td0);
  const uint4 vreg0 = *(const uint4*)(Pr + (size_t)ts * LDP + C_GV + h * 128 + td0), vreg1 = *(const uint4*)(Pr + (size_t)ts * LDP + C_GV + h * 128 + 64 + td0);
  uint4 lreg = make_uint4(0, 0, 0, 0);
  if (tid < 256) lreg = *(const uint4*)(Pr + (size_t)(tid >> 2) * LDP + C_GWF + (tid & 3) * 8);
  const u16* STf = p->SH + ((((size_t)(b * 4 + h) * 2 + 0) * 68 + cid) * 128) * 64;
  const u16* STb = p->SH + ((((size_t)(b * 4 + h) * 2 + 1) * 68 + cid) * 128) * 64;
  const uint4 sf0 = *(const uint4*)(STf + (size_t)tid * 8), sf1 = *(const uint4*)(STf + (size_t)(tid + 512) * 8);
  const uint4 sb0 = *(const uint4*)(STb + (size_t)tid * 8), sb1 = *(const uint4*)(STb + (size_t)(tid + 512) * 8);
  float wuf[16], wub[16];
  { const float* wf = p->gla_wup_f + l * 4096 + h * 64 + dd; const float* wb = p->gla_wup_b + l * 4096 + h * 64 + dd;
#pragma unroll
    for (int i = 0; i < 16; ++i) { wuf[i] = wf[i * 256]; wub[i] = wb[i * 256]; } }
  const float biaf = p->gla_b_f[l * 256 + h * 64 + dd], biab = p->gla_b_b[l * 256 + h * 64 + dd];
  __syncthreads();
  if (tid < 256) unpack8(lreg, lr + (tid >> 2) * 32 + (tid & 3) * 8);
  { const u16* v0 = (const u16*)&vreg0; const u16* v1 = (const u16*)&vreg1;
#pragma unroll
    for (int j = 0; j < 8; ++j) { VT[(td0 + j) * 200 + ts] = v0[j]; VT[(64 + td0 + j) * 200 + ts] = v1[j]; } }
  *(uint4*)(VT + (tid >> 3) * 200 + 64 + (tid & 7) * 8) = sf0; *(uint4*)(VT + (64 + (tid >> 3)) * 200 + 64 + (tid & 7) * 8) = sf1;
  *(uint4*)(VT + (tid >> 3) * 200 + 128 + (tid & 7) * 8) = sb0; *(uint4*)(VT + (64 + (tid >> 3)) * 200 + 128 + (tid & 7) * 8) = sb1;
  __syncthreads();
  { float gfv[8], gbv[8];
#pragma unroll
    for (int j = 0; j < 8; ++j) { const int c = seg * 8 + j; float xf = biaf, xb = biab;
#pragma unroll
      for (int q = 0; q < 16; ++q) { xf += lr[c * 32 + q] * wuf[q]; xb += lr[c * 32 + 16 + q] * wub[q]; }
      gfv[j] = logsig16(xf); gbv[j] = logsig16(xb); }
#pragma unroll
    for (int j = 1; j < 8; ++j) gfv[j] += gfv[j - 1];
#pragma unroll
    for (int j = 6; j >= 0; --j) gbv[j] += gbv[j + 1];
    segtot[seg * 64 + dd] = gfv[7]; segtot[512 + seg * 64 + dd] = gbv[0];
    __syncthreads();
    float of = 0.f, ob = 0.f;
#pragma unroll
    for (int q = 0; q < 8; ++q) { if (q < seg) of += segtot[q * 64 + dd]; if (q > seg) ob += segtot[512 + q * 64 + dd]; }
#pragma unroll
    for (int j = 0; j < 8; ++j) { Gf[(seg * 8 + j) * 64 + dd] = gfv[j] + of; Gb[(seg * 8 + j) * 64 + dd] = gbv[j] + ob; } }
  __syncthreads();
  { float qf[8], kf[8]; unpack8(qreg, qf); unpack8(kreg, kf);
    const float4 a0 = *(const float4*)(Gf + ts * 64 + td0), a1 = *(const float4*)(Gf + ts * 64 + td0 + 4), c0 = *(const float4*)(Gb + ts * 64 + td0), c1 = *(const float4*)(Gb + ts * 64 + td0 + 4);
    const float gf8[8] = {a0.x, a0.y, a0.z, a0.w, a1.x, a1.y, a1.z, a1.w}, gb8[8] = {c0.x, c0.y, c0.z, c0.w, c1.x, c1.y, c1.z, c1.w};
    unsigned o0[4], o1[4], o2[4], o3[4];
#pragma unroll
    for (int j = 0; j < 8; j += 2) { const float q0 = qf[j] * 0.125f, q1 = qf[j + 1] * 0.125f;
      o0[j >> 1] = pack2(q0 * __expf(gf8[j]), q1 * __expf(gf8[j + 1])); o1[j >> 1] = pack2(q0 * __expf(gb8[j]), q1 * __expf(gb8[j + 1]));
      o2[j >> 1] = pack2(kf[j] * __expf(-gf8[j]), kf[j + 1] * __expf(-gf8[j + 1])); o3[j >> 1] = pack2(kf[j] * __expf(-gb8[j]), kf[j + 1] * __expf(-gb8[j + 1])); }
    *(uint4*)(X + ts * 200 + 64 + td0) = make_uint4(o0[0], o0[1], o0[2], o0[3]); *(uint4*)(X + ts * 200 + 128 + td0) = make_uint4(o1[0], o1[1], o1[2], o1[3]);
    *(uint4*)(KI + ts * 72 + td0) = make_uint4(o2[0], o2[1], o2[2], o2[3]); *(uint4*)(KI + 64 * 72 + ts * 72 + td0) = make_uint4(o3[0], o3[1], o3[2], o3[3]); }
  __syncthreads();
  if (wid < 4) {
    const int mi = wid >> 1, ni = wid & 1;
    f32x16 af, ab;
#pragma unroll
    for (int r = 0; r < 16; ++r) { af[r] = 0.f; ab[r] = 0.f; }
#pragma unroll
    for (int ks = 0; ks < 4; ++ks) {
      const bf16x8 qa = *(const bf16x8*)(X + (32 * mi + r32) * 200 + 64 + ks * 16 + hi * 8), qb = *(const bf16x8*)(X + (32 * mi + r32) * 200 + 128 + ks * 16 + hi * 8);
      const bf16x8 ka = *(const bf16x8*)(KI + (32 * ni + r32) * 72 + ks * 16 + hi * 8), kb = *(const bf16x8*)(KI + 64 * 72 + (32 * ni + r32) * 72 + ks * 16 + hi * 8);
      af = __builtin_amdgcn_mfma_f32_32x32x16_bf16(qa, ka, af, 0, 0, 0);
      ab = __builtin_amdgcn_mfma_f32_32x32x16_bf16(qb, kb, ab, 0, 0, 0);
    }
    const int sidx = 32 * ni + r32;
#pragma unroll
    for (int r = 0; r < 16; ++r) { const int c = 32 * mi + crow(r, hi); X[c * 200 + sidx] = f2bf((sidx <= c ? af[r] : 0.f) + (sidx >= c ? ab[r] : 0.f)); }
  }
  __syncthreads();
  { const int mi = wid >> 2, ni = wid & 3;
    f32x16 acc;
#pragma unroll
    for (int r = 0; r < 16; ++r) acc[r] = 0.f;
#pragma unroll
    for (int ks = 0; ks < 12; ++ks) {
      const bf16x8 a = *(const bf16x8*)(X + (32 * mi + r32) * 200 + ks * 16 + hi * 8), bb = *(const bf16x8*)(VT + (32 * ni + r32) * 200 + ks * 16 + hi * 8);
      acc = __builtin_amdgcn_mfma_f32_32x32x16_bf16(a, bb, acc, 0, 0, 0);
    }
#pragma unroll
    for (int r = 0; r < 16; ++r) O[(32 * mi + crow(r, hi)) * 132 + 32 * ni + r32] = acc[r]; }
  __syncthreads();
  { const int c = tid >> 3, e0 = (tid & 7) * 16;
    float ov[16];
#pragma unroll
    for (int j = 0; j < 16; j += 4) { const float4 t4 = *(const float4*)(O + c * 132 + e0 + j); ov[j] = t4.x; ov[j + 1] = t4.y; ov[j + 2] = t4.z; ov[j + 3] = t4.w; }
    float ss = 0.f;
#pragma unroll
    for (int j = 0; j < 16; ++j) ss += ov[j] * ov[j];
    ss = red8(ss);
    const float rstd = rsqrtf(ss * (1.f / 128.f) + 1e-6f);
    float gt[16];
    unpack8(*(const uint4*)(Pr + (size_t)c * LDP + C_GG + h * 128 + e0), gt); unpack8(*(const uint4*)(Pr + (size_t)c * LDP + C_GG + h * 128 + e0 + 8), gt + 8);
    const float* gn = p->gla_norm + l * 512 + h * 128 + e0;
    unsigned ow[8];
#pragma unroll
    for (int j = 0; j < 16; j += 2) ow[j >> 1] = pack2(ov[j] * rstd * gn[j] * siluf_(gt[j]), ov[j + 1] * rstd * gn[j + 1] * siluf_(gt[j + 1]));
    u16* dst = Pr + (size_t)c * LDP + C_GV + h * 128 + e0;
    *(uint4*)dst = make_uint4(ow[0], ow[1], ow[2], ow[3]); *(uint4*)(dst + 8) = make_uint4(ow[4], ow[5], ow[6], ow[7]); }
}

constexpr int RCH = 32, RNCH = (TC + T) / RCH;
__device__ __forceinline__ float fast_tanh(float x) { const float e = __expf(2.f * x); return 1.f - 2.f * __builtin_amdgcn_rcpf(e + 1.f); }
__device__ __forceinline__ int rwkv_gcol(int gidx, int h, int dir) { return gidx == 0 ? h * 64 : gidx == 1 ? 512 + h * 64 : gidx == 2 ? 1024 + h * 64 : gidx == 3 ? 2048 + dir * 64 : 2176 + dir * 64; }
__device__ __forceinline__ void rwkv_scan_unit(KParams p, int l, int unit, char* smem) {
  const int dir = unit & 1, h = (unit >> 1) & 7, b = unit >> 4;
  const int tid = tidx(), lane = tid & 63;
  const int wid = __builtin_amdgcn_readfirstlane(tid >> 6);
  constexpr int SETF = 6 * 2048 + 64;
  float* setb = (float*)smem;
  float* sY = setb + 2 * SETF;
  u16* tTW = (u16*)(sY + 2048); u16* tAD = tTW + 32 * 72; u16* wupT = tAD + 32 * 72; u16* aupT = wupT + 64 * 72;
  float* smu = (float*)(aupT + 64 * 72);
  float* sZ = smu + 320;
  float* sPK = sZ + 64;
  const float* wup = (dir ? p->rwkv_wup_b : p->rwkv_wup_f) + l * 64 * 512; const float* aup = (dir ? p->rwkv_aup_b : p->rwkv_aup_f) + l * 64 * 512;
  const float* w0 = (dir ? p->rwkv_w0_b : p->rwkv_w0_f) + l * 512 + h * 64; const float* a0 = (dir ? p->rwkv_a0_b : p->rwkv_a0_f) + l * 512 + h * 64;
  const float* kkw = p->rwkv_kk + l * 512 + h * 64; const float* kaw = p->rwkv_ka + l * 512 + h * 64; const float* rkw = p->rwkv_rk + l * 512 + h * 64;
  const u16* Pb = p->P + (size_t)b * SB * LDP + C_RW;
  __syncthreads();
  for (int e = tid; e < 4096; e += 512) { const int n = e & 63, i = e >> 6; wupT[n * 72 + i] = f2bf(wup[i * 512 + h * 64 + n]); aupT[n * 72 + i] = f2bf(aup[i * 512 + h * 64 + n]); }
  if (tid < 320) smu[tid] = p->rwkv_mu[l * 2304 + rwkv_gcol(tid >> 6, h, dir) + (tid & 63)];
  if (tid < 64) { sZ[tid] = 0.f; sPK[tid] = kaw[tid]; sPK[64 + tid] = kkw[tid]; sPK[128 + tid] = rkw[tid]; }
#define RW_T0(c, base, len, t0) do { const int ci_ = (c) < 8 ? (c) : (c) - 8; base = (c) < 8 ? T : 0; len = (c) < 8 ? TC : T; t0 = dir ? base + len - (ci_ + 1) * RCH : base + ci_ * RCH; } while (0)
  __syncthreads();
  if (wid < 4) {
    const int sj = lane & 15, sg_ = lane >> 4;
    f32x4 S[4];
#pragma unroll
    for (int j = 0; j < 4; ++j) S[j] = f32x4{0.f, 0.f, 0.f, 0.f};
    const float* gp = p->g_pre + l * 1024;
    for (int c = -1; c < RNCH; ++c) {
      if (c >= 0) {
        int base, len, t0; RW_T0(c, base, len, t0);
        const size_t row0 = (size_t)b * SB + t0;
        const float* st = setb + (c & 1) * SETF;
        const float* sR = st, *sK = st + 2048, *sV = st + 4096, *sW = st + 6144, *sA = st + 8192, *sKK = st + 10240, *sSC = st + 12288;
        const float* abase = (sg_ == 0) ? sK : (sg_ == 1) ? sA : sZ; const int astr = (sg_ < 2) ? 64 : 0;
        const int hrow = unit * 272 + c * 2 + wid, hs = hrow % SB;
        const bool hdo = (wid < 2) && !(l == 1 && hs >= T);
        float4 hx0, hx1, hx2, hx3, hg0, hg1, hg2, hg3, hc0, hc1, hc2, hc3, hh0, hh1, hh2, hh3;
        if (hdo) { const float* src = xrow_ptr(p, l, hrow); const float* md = p->mod + ((size_t)l * 17 + (hs < T ? hrow / SB : 16)) * 3072;
          hx0 = *(const float4*)(src + lane * 4); hx1 = *(const float4*)(src + 256 + lane * 4); hx2 = *(const float4*)(src + 512 + lane * 4); hx3 = *(const float4*)(src + 768 + lane * 4);
          hg0 = *(const float4*)(gp + lane * 4); hg1 = *(const float4*)(gp + 256 + lane * 4); hg2 = *(const float4*)(gp + 512 + lane * 4); hg3 = *(const float4*)(gp + 768 + lane * 4);
          hc0 = *(const float4*)(md + 1024 + lane * 4); hc1 = *(const float4*)(md + 1280 + lane * 4); hc2 = *(const float4*)(md + 1536 + lane * 4); hc3 = *(const float4*)(md + 1792 + lane * 4);
          hh0 = *(const float4*)(md + lane * 4); hh1 = *(const float4*)(md + 256 + lane * 4); hh2 = *(const float4*)(md + 512 + lane * 4); hh3 = *(const float4*)(md + 768 + lane * 4); }
#define RW_LDV(tl_, K, W, Rr, A4, VV, SC) do { const int o_ = (tl_) * 64 + 4 * sg_; \
          _Pragma("unroll") for (int kt = 0; kt < 4; ++kt) { K[kt] = *(const f32x4*)(sKK + o_ + 16 * kt); W[kt] = *(const f32x4*)(sW + o_ + 16 * kt); Rr[kt] = *(const f32x4*)(sR + o_ + 16 * kt); \
 } \
          { const f32x4 a4_ = *(const f32x4*)(abase + (tl_) * astr + 4 * sj); A4[0] = a4_[0]; A4[1] = a4_[1]; A4[2] = a4_[2]; A4[3] = a4_[3]; } \
          VV = sV[(tl_) * 64 + 16 * wid + sj]; SC = *(const f32x2*)(sSC + (tl_) * 2); } while (0)
#define RW_STEP(tlc_, K, W, Rr, A4, VV, SC) do { \
          f32x4 ps = S[0] * K[0] + S[1] * K[1] + S[2] * K[2] + S[3] * K[3]; \
          f32x4 py = S[0] * Rr[0] + S[1] * Rr[1] + S[2] * Rr[2] + S[3] * Rr[3]; \
          float sa_ = (ps[0] + ps[1]) + (ps[2] + ps[3]), yp_ = (py[0] + py[1]) + (py[2] + py[3]); \
          { auto r1 = __builtin_amdgcn_permlane16_swap(__float_as_uint(sa_), __float_as_uint(sa_), false, false); sa_ = __uint_as_float(r1[0]) + __uint_as_float(r1[1]); \
            auto r2 = __builtin_amdgcn_permlane32_swap(__float_as_uint(sa_), __float_as_uint(sa_), false, false); sa_ = __uint_as_float(r2[0]) + __uint_as_float(r2[1]); } \
          { auto r1 = __builtin_amdgcn_permlane16_swap(__float_as_uint(yp_), __float_as_uint(yp_), false, false); yp_ = __uint_as_float(r1[0]) + __uint_as_float(r1[1]); \
            auto r2 = __builtin_amdgcn_permlane32_swap(__float_as_uint(yp_), __float_as_uint(yp_), false, false); yp_ = __uint_as_float(r2[0]) + __uint_as_float(r2[1]); } \
          if (sg_ == 0) sY[(tlc_) * 64 + 16 * wid + sj] = yp_ + VV * SC.x - sa_ * SC.y; \
          const float bop_ = (sg_ == 0) ? VV : sa_; \
          _Pragma("unroll") for (int kt = 0; kt < 4; ++kt) S[kt] = __builtin_amdgcn_mfma_f32_16x16x4f32(A4[kt], bop_, S[kt] * W[kt], 0, 0, 0); } while (0)
        f32x4 pK[4], pW[4], pR[4], qK[4], qW[4], qR[4]; float pA[4], qA[4], pvv, qvv; f32x2 psc, qsc;
        RW_LDV((dir ? RCH - 1 : 0), pK, pW, pR, pA, pvv, psc);
        for (int i = 0; i < RCH; i += 2) {
          const int ta = dir ? RCH - 1 - i : i, tb = dir ? RCH - 2 - i : i + 1;
          RW_LDV(tb, qK, qW, qR, qA, qvv, qsc);
          RW_STEP(ta, pK, pW, pR, pA, pvv, psc);
          if (i + 2 < RCH) { const int tn = dir ? RCH - 3 - i : i + 2; RW_LDV(tn, pK, pW, pR, pA, pvv, psc); }
          RW_STEP(tb, qK, qW, qR, qA, qvv, qsc);
          if (i == 14 || i == 20 || i == 28) __syncthreads();
        }
#undef RW_STEP
#undef RW_LDV
        { const int tl = lane >> 1, hf = lane & 1; const float* yp = sY + tl * 64 + 16 * wid + hf * 8;
          const float4 y0 = *(const float4*)yp, y1 = *(const float4*)(yp + 4);
          *(uint4*)(p->SH + (row0 + tl) * 1024 + dir * 512 + h * 64 + 16 * wid + hf * 8) = make_uint4(pack2(y0.x, y0.y), pack2(y0.z, y0.w), pack2(y1.x, y1.y), pack2(y1.z, y1.w)); }
        if (hdo) {
          float ss = hx0.x * hx0.x + hx0.y * hx0.y + hx0.z * hx0.z + hx0.w * hx0.w + hx1.x * hx1.x + hx1.y * hx1.y + hx1.z * hx1.z + hx1.w * hx1.w
                   + hx2.x * hx2.x + hx2.y * hx2.y + hx2.z * hx2.z + hx2.w * hx2.w + hx3.x * hx3.x + hx3.y * hx3.y + hx3.z * hx3.z + hx3.w * hx3.w;
          ss = wave_sum(ss);
          const float rstd = rsqrtf(ss * (1.f / 1024.f) + 1e-6f);
          u16* dst = p->P + (size_t)hrow * LDP + C_HRE + lane * 4;
#define HW(v, g_, c_, s_, off) *(uint2*)(dst + (off)) = make_uint2(pack2(v.x * rstd * g_.x * (1.f + c_.x) + s_.x, v.y * rstd * g_.y * (1.f + c_.y) + s_.y), pack2(v.z * rstd * g_.z * (1.f + c_.z) + s_.z, v.w * rstd * g_.w * (1.f + c_.w) + s_.w))
          HW(hx0, hg0, hc0, hh0, 0); HW(hx1, hg1, hc1, hh1, 256); HW(hx2, hg2, hc2, hh2, 512); HW(hx3, hg3, hc3, hh3, 768);
#undef HW
        }
      } else { __syncthreads(); __syncthreads(); __syncthreads(); }
      __syncthreads();
    }
  } else {
    const int ptid = tid - 256, pw = wid - 4;
    const float w0n_ = w0[(pw & 1) * 32 + (lane & 31)], a0n_ = a0[(pw & 1) * 32 + (lane & 31)];
    uint4 rg[5][3];
#define RW_LOAD(c) do { int base_, len_, t0_; RW_T0(c, base_, len_, t0_); \
      _Pragma("unroll") for (int it = 0; it < 5; ++it) { const int e = ptid + it * 256; \
        { const int tl = e / 40, v = e % 40; const int t = t0_ + tl; const u16* src = Pb + (size_t)t * LDP + rwkv_gcol(v >> 3, h, dir) + (v & 7) * 8; \
          rg[it][1] = *(const uint4*)src; \
          rg[it][0] = (t > base_) ? *(const uint4*)(src - LDP) : make_uint4(0, 0, 0, 0); \
          rg[it][2] = (t + 1 < base_ + len_) ? *(const uint4*)(src + LDP) : make_uint4(0, 0, 0, 0); } } } while (0)
    RW_LOAD(0);
    for (int c = -1; c < RNCH; ++c) {
      const int cn = c + 1;
      if (cn < RNCH) {
        int base, len, t0; RW_T0(cn, base, len, t0);
        const size_t row0 = (size_t)b * SB + t0;
        float* st = setb + (cn & 1) * SETF;
        float* sR = st, *sK = st + 2048, *sV = st + 4096, *sW = st + 6144, *sA = st + 8192, *sKK = st + 10240, *sSC = st + 12288;
#pragma unroll
        for (int it = 0; it < 5; ++it) { const int e = ptid + it * 256;
          { const int tl = e / 40, v = e % 40, gidx = v >> 3, n0 = (v & 7) * 8;
            float cc[8], ll[8], nn[8], val[8];
            unpack8(rg[it][1], cc); unpack8(rg[it][0], ll); unpack8(rg[it][2], nn);
            const float4 m0 = *(const float4*)(smu + gidx * 64 + n0), m1 = *(const float4*)(smu + gidx * 64 + n0 + 4);
            const float mm[8] = {m0.x, m0.y, m0.z, m0.w, m1.x, m1.y, m1.z, m1.w};
#pragma unroll
            for (int j = 0; j < 8; ++j) val[j] = cc[j] + mm[j] * (0.5f * (ll[j] + nn[j]) - cc[j]);
            if (gidx < 3) { float* dst = (gidx == 0 ? sR : gidx == 1 ? sK : sV) + tl * 64 + n0;
              *(float4*)dst = make_float4(val[0], val[1], val[2], val[3]); *(float4*)(dst + 4) = make_float4(val[4], val[5], val[6], val[7]); }
            else { if (gidx == 3) {
#pragma unroll
                for (int j = 0; j < 8; ++j) val[j] = fast_tanh(val[j]); }
              *(uint4*)((gidx == 3 ? tTW : tAD) + tl * 72 + n0) = make_uint4(pack2(val[0], val[1]), pack2(val[2], val[3]), pack2(val[4], val[5]), pack2(val[6], val[7])); } } }
        if (cn + 1 < RNCH) RW_LOAD(cn + 1);
        __syncthreads();
        { const int gsel = pw >> 1, ni = pw & 1, r32 = lane & 31, hi = lane >> 5;
          const u16* At = gsel ? tAD : tTW; const u16* Bt = gsel ? aupT : wupT;
          f32x16 acc;
#pragma unroll
          for (int r = 0; r < 16; ++r) acc[r] = 0.f;
#pragma unroll
          for (int ks = 0; ks < 4; ++ks) {
            const bf16x8 a = *(const bf16x8*)(At + r32 * 72 + ks * 16 + hi * 8), bb = *(const bf16x8*)(Bt + (ni * 32 + r32) * 72 + ks * 16 + hi * 8);
            acc = __builtin_amdgcn_mfma_f32_32x32x16_bf16(a, bb, acc, 0, 0, 0);
          }
          const int n = ni * 32 + r32;
          if (gsel == 0) {
#pragma unroll
            for (int r = 0; r < 16; ++r) sW[crow(r, hi) * 64 + n] = __expf(-0.6065306597f * sigmoidf_(w0n_ + acc[r])); }
          else {
#pragma unroll
            for (int r = 0; r < 16; ++r) sA[crow(r, hi) * 64 + n] = sigmoidf_(a0n_ + acc[r]); } }
        __syncthreads();
#pragma unroll 1
        for (int pass = 0; pass < 2; ++pass) { const int tl = (ptid >> 4) + 16 * pass, n0 = (ptid & 15) * 4;
          const float4 k4 = *(const float4*)(sK + tl * 64 + n0), a4 = *(const float4*)(sA + tl * 64 + n0), r4 = *(const float4*)(sR + tl * 64 + n0), w4 = *(const float4*)(sW + tl * 64 + n0);
          const float4 ka4 = *(const float4*)(sPK + n0), kw4 = *(const float4*)(sPK + 64 + n0), rk4 = *(const float4*)(sPK + 128 + n0);
          const float kk_[4] = {k4.x * kw4.x, k4.y * kw4.y, k4.z * kw4.z, k4.w * kw4.w};
          const float kd[4] = {k4.x * (1.f + (a4.x - 1.f) * ka4.x), k4.y * (1.f + (a4.y - 1.f) * ka4.y), k4.z * (1.f + (a4.z - 1.f) * ka4.z), k4.w * (1.f + (a4.w - 1.f) * ka4.w)};
          const float ss = red16(kk_[0] * kk_[0] + kk_[1] * kk_[1] + kk_[2] * kk_[2] + kk_[3] * kk_[3]);
          const float bs = red16(r4.x * kd[0] * rk4.x + r4.y * kd[1] * rk4.y + r4.z * kd[2] * rk4.z + r4.w * kd[3] * rk4.w);
          const float rn = rsqrtf(ss + 1e-12f);
          const float bq[4] = {kk_[0] * rn * a4.x, kk_[1] * rn * a4.y, kk_[2] * rn * a4.z, kk_[3] * rn * a4.w};
          const float kdr = red16(kd[0] * r4.x + kd[1] * r4.y + kd[2] * r4.z + kd[3] * r4.w);
          const float br = red16(bq[0] * r4.x + bq[1] * r4.y + bq[2] * r4.z + bq[3] * r4.w);
          { const int q_ = ptid & 15; float* tk = sK + tl * 64 + (q_ & 3) * 16 + (q_ >> 2); float* ta = sA + tl * 64 + (q_ & 3) * 16 + (q_ >> 2);
            tk[0] = kd[0]; tk[4] = kd[1]; tk[8] = kd[2]; tk[12] = kd[3]; ta[0] = -bq[0]; ta[4] = -bq[1]; ta[8] = -bq[2]; ta[12] = -bq[3]; }
          *(float4*)(sKK + tl * 64 + n0) = make_float4(kk_[0] * rn, kk_[1] * rn, kk_[2] * rn, kk_[3] * rn);
          *(float4*)(sR + tl * 64 + n0) = make_float4(r4.x * w4.x, r4.y * w4.y, r4.z * w4.z, r4.w * w4.w);
          if ((ptid & 15) == 0) { p->bon[((size_t)dir * R + row0 + tl) * 8 + h] = bs; *(float2*)(sSC + tl * 2) = make_float2(kdr, br); } }
        __syncthreads();
      } else { __syncthreads(); __syncthreads(); __syncthreads(); }
      __syncthreads();
    }
#undef RW_LOAD
  }
#undef RW_T0
}

__device__ __forceinline__ void phase_f0(KParams p, int l) {
  const int tid = tidx(), wid = tid >> 6, lane = tid & 63;
  const float* mu = p->rwkv_mu + l * 2304; const float* lng = p->rwkv_ln_g + l * 512; const float* lnb = p->rwkv_ln_b + l * 512;
  for (int r = blockIdx.x * 8 + wid; r < R; r += gridDim.x * 8) {
    const int s = r % SB, j = lane * 8;
    if (l == 1 && s >= T) continue;
    const bool first = (s == 0) || (s == T), last = (s == T - 1) || (s == SB - 1);
    const u16* p0 = p->P + (size_t)r * LDP + C_RW;
    u16* yrow = p->SH + (size_t)r * 1024;
    const uint4 yf = *(const uint4*)(yrow + j), yb = *(const uint4*)(yrow + 512 + j);
    const uint4 vc = *(const uint4*)(p0 + 1024 + j), gcn = *(const uint4*)(p0 + 1536 + j);
    uint4 vl = make_uint4(0, 0, 0, 0), vn = vl, gl = vl, gn = vl;
    if (!first) { vl = *(const uint4*)(p0 + 1024 + j - LDP); gl = *(const uint4*)(p0 + 1536 + j - LDP); }
    if (!last) { vn = *(const uint4*)(p0 + 1024 + j + LDP); gn = *(const uint4*)(p0 + 1536 + j + LDP); }
    const int head = lane >> 3;
    const float bonus = p->bon[(size_t)r * 8 + head] + p->bon[((size_t)R + r) * 8 + head];
    float a[8], bq[8], y[8], c1[8], l1[8], n1[8], c2[8], l2[8], n2[8], vv[8], gg[8];
    unpack8(yf, a); unpack8(yb, bq); unpack8(vc, c1); unpack8(vl, l1); unpack8(vn, n1); unpack8(gcn, c2); unpack8(gl, l2); unpack8(gn, n2);
    float sum = 0.f;
#pragma unroll
    for (int i = 0; i < 8; ++i) { y[i] = a[i] + bq[i]; sum += y[i];
      vv[i] = c1[i] + mu[1024 + j + i] * (0.5f * (l1[i] + n1[i]) - c1[i]);
      gg[i] = c2[i] + mu[1536 + j + i] * (0.5f * (l2[i] + n2[i]) - c2[i]); }
    const float mean = red8(sum) * (1.f / 64.f);
    float sq = 0.f;
#pragma unroll
    for (int i = 0; i < 8; ++i) { y[i] -= mean; sq += y[i] * y[i]; }
    const float rs = rsqrtf(red8(sq) * (1.f / 64.f) + 64e-5f);
    unsigned ow[4];
#pragma unroll
    for (int i = 0; i < 8; i += 2) ow[i >> 1] = pack2((y[i] * rs * lng[j + i] + lnb[j + i] + bonus * vv[i]) * siluf_(gg[i]), (y[i + 1] * rs * lng[j + i + 1] + lnb[j + i + 1] + bonus * vv[i + 1]) * siluf_(gg[i + 1]));
    *(uint4*)(yrow + j) = make_uint4(ow[0], ow[1], ow[2], ow[3]);
  }
}

__device__ __forceinline__ int rowtile_row0(int l, int i) { return l == 0 ? i * 256 : ((i >> 4) * 17 + (i & 15)) * 256; }
__device__ __forceinline__ int n_rowtiles(int l) { return l == 0 ? R / 256 : NB * 16; }

__device__ __forceinline__ void phase_f1(KParams p, int l, char* smem) {
  const u16* Wg = p->Wt_in + (size_t)l * DINP * 1024 + (size_t)C_MG * 1024;
  const u16* Wo = p->Wt_o + (size_t)l * 3 * 1024 * 512;
  int rti, nt;
  for (int it = 0; xcd_tile(it, n_rowtiles(l), 16, rti, nt); ++it) {
    const int row0 = rowtile_row0(l, rti);
    unsigned sg[3][2][8];
    {
      f32x16 accg[3][2];
      gemm_kloop64<3>(p->P + (size_t)row0 * LDP + C_HRE, LDP, Wg + (size_t)(nt * 64) * 1024, 1024, (size_t)1024 * 1024, 1024, smem, accg);
#pragma unroll
      for (int i = 0; i < 3; ++i)
#pragma unroll
        for (int mi = 0; mi < 2; ++mi)
#pragma unroll
          for (int r = 0; r < 16; r += 2) sg[i][mi][r >> 1] = pack2(sigmoidf_(accg[i][mi][r]), sigmoidf_(accg[i][mi][r + 1]));
    }
    f32x16 accm[2];
#pragma unroll
    for (int mi = 0; mi < 2; ++mi)
#pragma unroll
      for (int r = 0; r < 16; ++r) accm[mi][r] = 0.f;
#pragma unroll
    for (int i = 0; i < 3; ++i) {
      f32x16 acc[1][2];
      const u16* Ai = (i == 0) ? p->P + (size_t)row0 * LDP + C_GV : (i == 1) ? p->P + (size_t)row0 * LDP + C_AQ : p->SH + (size_t)row0 * 1024;
      gemm_kloop64<1>(Ai, (i == 2) ? 1024 : LDP, Wo + (size_t)(i * 1024 + nt * 64) * 512, 512, 0, 512, smem, acc);
#pragma unroll
      for (int mi = 0; mi < 2; ++mi)
#pragma unroll
        for (int r = 0; r < 16; r += 2) { const unsigned w = sg[i][mi][r >> 1];
          accm[mi][r] += __uint_as_float(w << 16) * acc[0][mi][r]; accm[mi][r + 1] += __uint_as_float(w & 0xffff0000u) * acc[0][mi][r + 1]; }
    }
    { const int tid = tidx(), wid = tid >> 6, lane = tid & 63, r32 = lane & 31, hi = lane >> 5, wm = wid >> 1, wn = wid & 1;
      u16* C = p->P + (size_t)row0 * LDP + C_M + nt * 64 + wn * 32 + r32;
#pragma unroll
      for (int mi = 0; mi < 2; ++mi)
#pragma unroll
        for (int r = 0; r < 16; ++r) C[(size_t)(wm * 64 + mi * 32 + crow(r, hi)) * LDP] = f2bf(accm[mi][r]); }
  }
}
__device__ __forceinline__ void phase_f2(KParams p, int l, char* smem) {
  const u16* W = p->Wt_out + (size_t)l * 1024 * 1024;
  int rti, nt;
  for (int it = 0; xcd_tile(it, n_rowtiles(l), 8, rti, nt); ++it) {
    const int row0 = rowtile_row0(l, rti);
    f32x16 acc[2][2];
    gemm_kloop(p->P + (size_t)row0 * LDP + C_M, LDP, W + (size_t)nt * 128 * 1024, 1024, 1024, smem, acc);
    store_tile_bf16(acc, p->SH + (size_t)row0 * 1024 + nt * 128, 1024, 128);
  }
}
__device__ __forceinline__ void phase_f3(KParams p, int l) {
  const int wid = tidx() >> 6, lane = tidx() & 63;
  const float* g_post = p->g_post + l * 1024; const float* modl = p->mod + (size_t)l * 17 * 3072;
  for (int r = blockIdx.x * 8 + wid; r < R; r += gridDim.x * 8) {
    const int b = r / SB, s = r % SB;
    if (l == 1 && s >= T) continue;
    const float* src = xrow_ptr(p, l, r);
    float* dst = (s < T) ? p->out + ((size_t)b * T + s) * DM : p->xc1 + ((size_t)b * TC + (s - T)) * DM;
    const float* gate = modl + (size_t)((s < T) ? b : 16) * 3072 + 2048;
    u16* zrow = p->SH + (size_t)r * 1024;
    float z[4][4]; float ss = 0.f;
#pragma unroll
    for (int i = 0; i < 4; ++i) { const ushort4 u = *(const ushort4*)(zrow + i * 256 + lane * 4); z[i][0] = bf2f(u.x); z[i][1] = bf2f(u.y); z[i][2] = bf2f(u.z); z[i][3] = bf2f(u.w);
      ss += z[i][0] * z[i][0] + z[i][1] * z[i][1] + z[i][2] * z[i][2] + z[i][3] * z[i][3]; }
    ss = wave_sum(ss);
    const float rstd = rsqrtf(ss * (1.f / 1024.f) + 1e-6f);
    float4 o[4];
#pragma unroll
    for (int i = 0; i < 4; ++i) {
      const int col = i * 256 + lane * 4;
      const float4 g = *(const float4*)(g_post + col), gt = *(const float4*)(gate + col), xv = *(const float4*)(src + col);
      o[i].x = xv.x + gt.x * (z[i][0] * rstd * g.x); o[i].y = xv.y + gt.y * (z[i][1] * rstd * g.y);
      o[i].z = xv.z + gt.z * (z[i][2] * rstd * g.z); o[i].w = xv.w + gt.w * (z[i][3] * rstd * g.w);
      *(float4*)(dst + col) = o[i];
    }
    if (l == 0) hrow_write(o, p->g_pre + 1024, p->mod + (size_t)17 * 3072 + (size_t)((s < T) ? b : 16) * 3072, zrow, lane);
  }
}


#define XB_TMO      128
#define XB_XCNT(j)  (256  + 64 * (j))
#define XB_XSUB(j)  (1280 + 64 * (j))
#define XB_XGEN(j)  (2304 + 64 * (j))
#define XB_TOP      3328
#define XB_TOPGEN   3392
#define XCD_BAR_WORDS 3456
#define XB_SPIN_CAP (1u << 18)
#define LAS __attribute__((address_space(3)))
__device__ __forceinline__ unsigned xb_ld(unsigned* p)              { return __hip_atomic_load(p, __ATOMIC_RELAXED, __HIP_MEMORY_SCOPE_AGENT); }
__device__ __forceinline__ unsigned xb_add(unsigned* p, unsigned v) { return __hip_atomic_fetch_add(p, v, __ATOMIC_RELAXED, __HIP_MEMORY_SCOPE_AGENT); }
__device__ __forceinline__ unsigned xb_xcc_id() { return (unsigned)__builtin_amdgcn_s_getreg((3 << 11) | 20) & 0xFu; }
#define XB_SPIN(cond, bar) do { unsigned _sp = 0; while (cond) { __builtin_amdgcn_s_sleep(1); \
    if ((++_sp & 255u) == 0u) { if (xb_ld(&(bar)[XB_TMO])) break; if (_sp > XB_SPIN_CAP) { atomicAdd(&(bar)[XB_TMO], 1u); break; } } } } while (0)
__device__ __forceinline__ void xcd_barrier_complete(unsigned* bar, unsigned x, unsigned& nloc, unsigned& nx) {
    const unsigned G = gridDim.x * gridDim.y * gridDim.z;
    unsigned sum, cnt, mine, sp = 0u;
    for (;;) {
        sum = 0u; cnt = 0u; mine = 0u;
#pragma unroll
        for (unsigned j = 0; j < 16; ++j) { const unsigned c = xb_ld(&bar[XB_XCNT(j)]); sum += c; cnt += (c > 0u) ? 1u : 0u; mine = (j == x) ? c : mine; }
        if (sum == G) break;
        __builtin_amdgcn_s_sleep(1);
        if ((++sp & 255u) == 0u) { if (xb_ld(&bar[XB_TMO])) break; if (sp > XB_SPIN_CAP) { atomicAdd(&bar[XB_TMO], 1u); break; } }
    }
    nloc = mine > 0u ? mine : 1u; nx = cnt > 0u ? cnt : 1u;
}
__device__ __forceinline__ void xcd_barrier(unsigned* bar, unsigned x, volatile LAS unsigned* st) {
    asm volatile("s_waitcnt vmcnt(0)" ::: "memory");
    __syncthreads();
    if (threadIdx.x == 0) {
        __builtin_amdgcn_s_waitcnt(0);
        unsigned nloc = st[0], nx = st[1];
        if (nloc == 0u) { xcd_barrier_complete(bar, x, nloc, nx); st[0] = nloc; st[1] = nx; }
        const unsigned old = xb_add(&bar[XB_XSUB(x)], 1u);
        const unsigned gen = old / nloc;
        if (old + 1u == (gen + 1u) * nloc) {
            __builtin_amdgcn_fence(__ATOMIC_RELEASE, "agent");
            asm volatile("s_waitcnt vmcnt(0)" ::: "memory");
            const unsigned og = xb_add(&bar[XB_TOP], 1u);
            const unsigned tg = og / nx;
            if (og + 1u == (tg + 1u) * nx) xb_add(&bar[XB_TOPGEN], 1u);
            else XB_SPIN(xb_ld(&bar[XB_TOPGEN]) == tg, bar);
            __builtin_amdgcn_fence(__ATOMIC_ACQUIRE, "agent");
            xb_add(&bar[XB_XGEN(x)], 1u);
            asm volatile("s_waitcnt vmcnt(0)" ::: "memory");
        } else {
            XB_SPIN(xb_ld(&bar[XB_XGEN(x)]) == gen, bar);
            __builtin_amdgcn_fence(__ATOMIC_ACQUIRE, "agent");
            asm volatile("s_waitcnt vmcnt(0)" ::: "memory");
        }
    }
    __syncthreads();
}

constexpr int N_PHASES = 18;
#define LOADP() KParams p = kp; asm volatile("" : "+s"(p))
__global__ __launch_bounds__(512, 1) void megakernel(Params praw) {
  extern __shared__ __attribute__((aligned(16))) char smem[];
  __shared__ __attribute__((aligned(16))) unsigned xb_words[4];
  const KParams kp = (KParams)__builtin_amdgcn_kernarg_segment_ptr();
  const int ph0 = praw.p0, ph1 = praw.p1;
  unsigned* const bar = praw.bar;
  const unsigned xcc = xb_xcc_id();
  if (threadIdx.x < 4) xb_words[threadIdx.x] = 0u;
  __syncthreads();
  if (threadIdx.x == 0) (void)xb_add(&bar[XB_XCNT(xcc)], 1u);
  for (int ph = ph0; ph < ph1; ++ph) {
    const int l = (ph - 2) >> 3, sub = (ph - 2) & 7;
    if (ph == 0) { LOADP(); phase_prologue(p, smem); }
    else if (ph == 1) { LOADP(); phase_a0(p); }
    else if (sub == 0) { LOADP(); phase_a1(p, l, smem); }
    else if (sub == 1 || sub == 2) {
      const int natt = 1024 + (l == 0 ? 64 : 0), nch = (l == 0 ? 68 : 64), G = gridDim.x, half = G >> 1;
      int it0 = 0, it_end = 0, stride = 1;
      if (sub == 1) {
        { LOADP(); attn_prep_all(p, l); }
        xcd_barrier(bar, xcc, (volatile LAS unsigned*)xb_words);
        if ((int)blockIdx.x < half) { LOADP(); for (int u = blockIdx.x; u < 128; u += half) gla_state_unit(p, l, u, smem); }
        else { it0 = blockIdx.x - half; it_end = 256; stride = G - half; }
      } else { it0 = 256 + blockIdx.x; it_end = natt; stride = G; }
      for (int it = it0; it < it_end; it += stride) {
        int b, h, qrow0, krow0, seq;
        if (it < 1024) { b = it >> 6; h = (it >> 4) & 3; qrow0 = (it & 15) * 256; krow0 = 0; seq = SB; }
        else { const int u = it - 1024; b = u >> 2; h = u & 3; qrow0 = T; krow0 = T; seq = TC; }
        const int kvh = h >> 1;
        KParams q_ = kp; asm volatile("" : "+s"(q_)); u16* Pbase = q_->P;
        u16* Pq = Pbase + (size_t)(b * SB + qrow0) * LDP; const u16* Pk = Pbase + (size_t)(b * SB + krow0) * LDP;
        att::attn_dense_body((const bf16*)(Pq + C_AQ + h * 128), (const bf16*)(Pk + C_AK + kvh * 128), (const bf16*)(Pk + C_AV + kvh * 128),
                             Pq + C_AG + h * 128, Pq + C_AQ + h * 128, seq, smem);
      }
      if (sub == 2) { LOADP();
        const int first = 0;
        const int gb = ((int)blockIdx.x >= first) ? (int)blockIdx.x - first : -1, gstride = G - first;
        if (gb >= 0) for (int g = gb; g < NB * 4 * nch; g += gstride) gla_out_tile(p, l, g / (nch * 4), (g / nch) & 3, g % nch, smem);
      }
    } else if (sub == 3) { LOADP(); for (int u = blockIdx.x; u < 256; u += gridDim.x) rwkv_scan_unit(p, l, u, smem); }
    else if (sub == 4) { LOADP(); phase_f0(p, l); }
    else if (sub == 5) { LOADP(); phase_f1(p, l, smem); }
    else if (sub == 6) { LOADP(); phase_f2(p, l, smem); }
    else { LOADP(); phase_f3(p, l); }
    if (ph + 1 < ph1) { if (ph == 0) cg::this_grid().sync(); else xcd_barrier(bar, xcc, (volatile LAS unsigned*)xb_words); }
  }
}

#ifndef MK_LAUNCHES
#define MK_LAUNCHES 1
#endif
static inline size_t al256(size_t x) { return (x + 255) / 256 * 256; }
extern "C" void kernel_launch(void* const* d_in, const int* in_sizes, int n_in, void* d_out, int out_size, void* d_ws, size_t ws_size, hipStream_t stream) {
  Params p{};
  const float** pf = (const float**)&p;
  for (int i = 0; i < 34; ++i) pf[i] = (const float*)d_in[i];
  p.out = (float*)d_out;
  char* ws = (char*)d_ws; size_t off = 0;
  auto take = [&](size_t bytes) { char* q = ws + off; off += al256(bytes); return q; };
  p.Wt_in = (u16*)take((size_t)2 * DINP * 1024 * 2);
  p.Wt_o = (u16*)take((size_t)2 * 3 * 1024 * 512 * 2);
  p.Wt_out = (u16*)take((size_t)2 * 1024 * 1024 * 2);
  p.mod = (float*)take((size_t)2 * 17 * 3072 * 4);
  p.bon = (float*)take((size_t)2 * R * 8 * 4);
  p.xc1 = (float*)take((size_t)NB * TC * DM * 4);
  p.SH = (u16*)take((size_t)R * 1024 * 2);
  p.P = (u16*)take((size_t)R * LDP * 2);
  p.tmp = (unsigned*)take((size_t)512 * 32 * 512 * 4);
  p.bar = (unsigned*)take((size_t)XCD_BAR_WORDS * 4);
  if (off > ws_size) { fprintf(stderr, "kernel_launch: workspace too small (%zu > %zu)\n", off, ws_size); return; }

  static int grid_blocks = 0;
  if (!grid_blocks) {
    if (hipFuncSetAttribute((const void*)megakernel, hipFuncAttributeMaxDynamicSharedMemorySize, SMEM_BYTES) != hipSuccess) { fprintf(stderr, "kernel_launch: LDS attribute failed\n"); return; }
    int dev = 0, cus = 0, per_cu = 0;
    (void)hipGetDevice(&dev);
    (void)hipDeviceGetAttribute(&cus, hipDeviceAttributeMultiprocessorCount, dev);
    (void)hipOccupancyMaxActiveBlocksPerMultiprocessor(&per_cu, megakernel, 512, SMEM_BYTES);
    if (per_cu < 1) { fprintf(stderr, "kernel_launch: occupancy query returned %d\n", per_cu); return; }
    grid_blocks = (cus * (per_cu > 1 ? 1 : per_cu)) / 8 * 8;
  }
#if MK_LAUNCHES == 1
  (void)hipMemsetAsync(p.bar, 0, (size_t)XCD_BAR_WORDS * 4, stream);
  p.p0 = 0; p.p1 = N_PHASES;
  void* args[] = {&p};
  hipError_t e = hipLaunchCooperativeKernel((void*)megakernel, dim3(grid_blocks), dim3(512), args, SMEM_BYTES, stream);
  if (e != hipSuccess) fprintf(stderr, "cooperative launch failed: %s (grid %d)\n", hipGetErrorString(e), grid_blocks);
#else
  for (int ph = 0; ph < N_PHASES; ++ph) { p.p0 = ph; p.p1 = ph + 1; hipLaunchKernelGGL(megakernel, dim3(grid_blocks), dim3(512), SMEM_BYTES, stream, p); }
#endif
}
```

```cpp
#include <hip/hip_runtime.h>
#include <hip/hip_bf16.h>
#include <hip/hip_cooperative_groups.h>
#include <stdint.h>
#include <cstdio>
namespace cg = cooperative_groups;

typedef unsigned short u16;
using bf16 = __hip_bfloat16;
using bf16x8 = __attribute__((ext_vector_type(8))) short;
using s16x4  = __attribute__((ext_vector_type(4))) short;
using f32x16 = __attribute__((ext_vector_type(16))) float;
using f32x8  = __attribute__((ext_vector_type(8))) float;
using f32x4  = __attribute__((ext_vector_type(4))) float;
using f32x2  = __attribute__((ext_vector_type(2))) float;
using u32x4  = __attribute__((ext_vector_type(4))) unsigned;

constexpr int NB = 16, T = 4096, TC = 256, SB = T + TC;
constexpr int R = NB * SB;
constexpr int DM = 1024, DIN = 8480, DINP = 8576;
constexpr int LDP = 5408;
constexpr int NT_P = 43;
constexpr int C_GQ = 0, C_GK = 256, C_GV = 512, C_GG = 1024, C_GWF = 1536;
constexpr int C_AQ = 1568, C_AK = 2080, C_AV = 2336, C_AG = 2592;
constexpr int C_RW = 3104;
constexpr int C_MG = 5408;
constexpr int C_HRE = C_AK;
constexpr int C_M = C_RW;
constexpr int SMEM_BYTES = 147456;

struct Params {
  const float *x, *c, *ctx, *c_ctx, *w_mod, *b_mod, *g_pre, *w_in, *gla_wup_f, *gla_b_f, *gla_wup_b, *gla_b_b, *gla_norm, *att_qnorm, *att_knorm,
      *rwkv_mu, *rwkv_w0_f, *rwkv_wup_f, *rwkv_w0_b, *rwkv_wup_b, *rwkv_a0_f, *rwkv_aup_f, *rwkv_a0_b, *rwkv_aup_b, *rwkv_kk, *rwkv_ka, *rwkv_rk,
      *rwkv_ln_g, *rwkv_ln_b, *w_o_gla, *w_o_att, *w_o_rwkv, *w_out, *g_post;
  float* out; u16* Wt_in; u16* Wt_o; u16* Wt_out; float* mod; float* bon; float* xc1; u16* SH; u16* P; unsigned* tmp; unsigned* bar;
  int p0, p1;
};
typedef const __attribute__((address_space(4))) Params* KParams;

__device__ __forceinline__ int tidx() { int t = threadIdx.x; asm volatile("" : "+v"(t)); return t; }
__device__ __forceinline__ float bf2f(u16 v) { return __uint_as_float(((unsigned)v) << 16); }
typedef __bf16 bf16v2_t __attribute__((ext_vector_type(2)));
__device__ __forceinline__ unsigned cvtpk_bf16(float lo, float hi) { const f32x2 v = {lo, hi}; return __builtin_bit_cast(unsigned, __builtin_convertvector(v, bf16v2_t)); }
__device__ __forceinline__ u16 f2bf(float x) { return __builtin_bit_cast(u16, (__bf16)x); }
__device__ __forceinline__ float shfl_xor_f(float v, int m) { const int lane = tidx() & 63; return __builtin_bit_cast(float, __builtin_amdgcn_ds_bpermute((lane ^ m) << 2, __builtin_bit_cast(int, v))); }
__device__ __forceinline__ float wave_sum(float v);
__device__ __forceinline__ float sigmoidf_(float x) { return __builtin_amdgcn_rcpf(1.f + __expf(-x)); }
__device__ __forceinline__ float siluf_(float x) { return x * __builtin_amdgcn_rcpf(1.f + __expf(-x)); }
__device__ __forceinline__ int crow(int r, int hi) { return (r & 3) + 8 * (r >> 2) + 4 * hi; }
__device__ __forceinline__ void unpack8(uint4 u, float* f) {
  f[0] = __uint_as_float(u.x << 16); f[1] = __uint_as_float(u.x & 0xffff0000u); f[2] = __uint_as_float(u.y << 16); f[3] = __uint_as_float(u.y & 0xffff0000u);
  f[4] = __uint_as_float(u.z << 16); f[5] = __uint_as_float(u.z & 0xffff0000u); f[6] = __uint_as_float(u.w << 16); f[7] = __uint_as_float(u.w & 0xffff0000u);
}
__device__ __forceinline__ unsigned pack2(float a, float b) { return cvtpk_bf16(a, b); }
template <int CTRL> __device__ __forceinline__ float dpp_f(float x) {
  return __builtin_bit_cast(float, __builtin_amdgcn_update_dpp(0, __builtin_bit_cast(int, x), CTRL, 0xF, 0xF, true));
}
__device__ __forceinline__ float red4(float x) { x += dpp_f<0xB1>(x); x += dpp_f<0x4E>(x); return x; }
__device__ __forceinline__ float red8(float x) { x = red4(x); x += dpp_f<0x141>(x); return x; }
__device__ __forceinline__ float red16(float x) { x += dpp_f<0xB1>(x); x += dpp_f<0x4E>(x); x += dpp_f<0x141>(x); x += dpp_f<0x140>(x); return x; }
__device__ __forceinline__ float wave_sum(float v) {
  v = red16(v);
  { auto r1 = __builtin_amdgcn_permlane16_swap(__float_as_uint(v), __float_as_uint(v), false, false); v = __uint_as_float(r1[0]) + __uint_as_float(r1[1]); }
  { auto r2 = __builtin_amdgcn_permlane32_swap(__float_as_uint(v), __float_as_uint(v), false, false); v = __uint_as_float(r2[0]) + __uint_as_float(r2[1]); }
  return v;
}
__device__ __forceinline__ void red16x4(float& a, float& b, float& c, float& d) {
#define DPPA(r, ctl) "v_add_f32_dpp " r ", " r ", " r " " ctl " row_mask:0xf bank_mask:0xf bound_ctrl:1\n\t"
  asm volatile("s_nop 1\n\t"
               DPPA("%0", "quad_perm:[1,0,3,2]") DPPA("%1", "quad_perm:[1,0,3,2]") DPPA("%2", "quad_perm:[1,0,3,2]") DPPA("%3", "quad_perm:[1,0,3,2]")
               DPPA("%0", "quad_perm:[2,3,0,1]") DPPA("%1", "quad_perm:[2,3,0,1]") DPPA("%2", "quad_perm:[2,3,0,1]") DPPA("%3", "quad_perm:[2,3,0,1]")
               DPPA("%0", "row_half_mirror") DPPA("%1", "row_half_mirror") DPPA("%2", "row_half_mirror") DPPA("%3", "row_half_mirror")
               DPPA("%0", "row_mirror") DPPA("%1", "row_mirror") DPPA("%2", "row_mirror") DPPA("%3", "row_mirror")
               "s_nop 1"
               : "+v"(a), "+v"(b), "+v"(c), "+v"(d));
#undef DPPA
}

constexpr int GLS = 72;
constexpr int GEMM_SMEM = 2 * (256 * GLS + 128 * GLS) * 2;
__device__ __forceinline__ void gemm_kloop(const u16* __restrict__ A, int lda, const u16* __restrict__ Bt, int ldb, int K, char* smem, f32x16 (&acc)[2][2]) {
  u16* As = (u16*)smem; u16* Bs = As + 2 * 256 * GLS;
  const int tid = tidx(), wid = tid >> 6, lane = tid & 63, r32 = lane & 31, hi = lane >> 5;
  const int wm = wid >> 1, wn = wid & 1;
#pragma unroll
  for (int mi = 0; mi < 2; ++mi)
#pragma unroll
    for (int ni = 0; ni < 2; ++ni)
#pragma unroll
      for (int r = 0; r < 16; ++r) acc[mi][ni][r] = 0.f;
  uint4 xa0, xa1, xa2, xa3, xb0, xb1, ya0, ya1, ya2, ya3, yb0, yb1;
  const int nk = K / 64;
  const int lrow = tid >> 3, lkc = tid & 7;
  const u16* gA = A + (size_t)lrow * lda + lkc * 8;
  const u16* gB = Bt + (size_t)lrow * ldb + lkc * 8;
  const size_t sA = (size_t)64 * lda, sB = (size_t)64 * ldb;
  u16* wA = As + lrow * GLS + lkc * 8; u16* wB = Bs + lrow * GLS + lkc * 8;
#define GLOAD(R, kt) do { const u16* pa_ = gA + (kt) * 64; const u16* pb_ = gB + (kt) * 64; \
    R##a0 = *(const uint4*)(pa_); R##a1 = *(const uint4*)(pa_ + sA); R##a2 = *(const uint4*)(pa_ + 2 * sA); R##a3 = *(const uint4*)(pa_ + 3 * sA); \
    R##b0 = *(const uint4*)(pb_); R##b1 = *(const uint4*)(pb_ + sB); } while (0)
#define SWRITE(R, buf) do { u16* qa_ = wA + (buf) * 256 * GLS; u16* qb_ = wB + (buf) * 128 * GLS; \
    *(uint4*)(qa_) = R##a0; *(uint4*)(qa_ + 64 * GLS) = R##a1; *(uint4*)(qa_ + 128 * GLS) = R##a2; *(uint4*)(qa_ + 192 * GLS) = R##a3; \
    *(uint4*)(qb_) = R##b0; *(uint4*)(qb_ + 64 * GLS) = R##b1; } while (0)
#define COMPUTE(buf) do { const u16* Ab = As + (buf) * 256 * GLS + (wm * 64 + r32) * GLS + hi * 8; const u16* Bb = Bs + (buf) * 128 * GLS + (wn * 64 + r32) * GLS + hi * 8; \
    _Pragma("unroll") for (int ks = 0; ks < 4; ++ks) { \
      bf16x8 a0 = *(const bf16x8*)(Ab + ks * 16), a1 = *(const bf16x8*)(Ab + 32 * GLS + ks * 16); \
      bf16x8 b0 = *(const bf16x8*)(Bb + ks * 16), b1 = *(const bf16x8*)(Bb + 32 * GLS + ks * 16); \
      acc[0][0] = __builtin_amdgcn_mfma_f32_32x32x16_bf16(a0, b0, acc[0][0], 0, 0, 0); \
      acc[0][1] = __builtin_amdgcn_mfma_f32_32x32x16_bf16(a0, b1, acc[0][1], 0, 0, 0); \
      acc[1][0] = __builtin_amdgcn_mfma_f32_32x32x16_bf16(a1, b0, acc[1][0], 0, 0, 0); \
      acc[1][1] = __builtin_amdgcn_mfma_f32_32x32x16_bf16(a1, b1, acc[1][1], 0, 0, 0); } } while (0)
  GLOAD(x, 0); GLOAD(y, 1);
  SWRITE(x, 0); GLOAD(x, 2);
  __syncthreads();
  for (int kt = 0; kt < nk; kt += 2) {
    COMPUTE(0);
    SWRITE(y, 1);
    if (kt + 3 < nk) GLOAD(y, kt + 3);
    __syncthreads();
    COMPUTE(1);
    if (kt + 2 < nk) { SWRITE(x, 0); if (kt + 4 < nk) GLOAD(x, kt + 4); }
    __syncthreads();
  }
#undef COMPUTE
#undef GLOAD
#undef SWRITE
}
template <int NB>
__device__ __forceinline__ void gemm_kloop64(const u16* __restrict__ A, int lda, const u16* __restrict__ Bt, int ldb, size_t bstride, int K, char* smem, f32x16 (&acc)[NB][2]) {
  u16* As = (u16*)smem; u16* Bs = As + 2 * 256 * GLS;
  const int tid = tidx(), wid = tid >> 6, lane = tid & 63, r32 = lane & 31, hi = lane >> 5;
  const int wm = wid >> 1, wn = wid & 1;
#pragma unroll
  for (int ib = 0; ib < NB; ++ib)
#pragma unroll
    for (int mi = 0; mi < 2; ++mi)
#pragma unroll
      for (int r = 0; r < 16; ++r) acc[ib][mi][r] = 0.f;
  uint4 xa0, xa1, xa2, xa3, xb0, xb1, xb2, ya0, ya1, ya2, ya3, yb0, yb1, yb2;
  const int nk = K / 64;
  const int lrow = tid >> 3, lkc = tid & 7;
  const u16* gA = A + (size_t)lrow * lda + lkc * 8;
  const u16* gB = Bt + (size_t)lrow * ldb + lkc * 8;
  const size_t sA = (size_t)64 * lda;
  u16* wA = As + lrow * GLS + lkc * 8; u16* wB = Bs + lrow * GLS + lkc * 8;
#define GLOAD(R, kt) do { const u16* pa_ = gA + (kt) * 64; const u16* pb_ = gB + (kt) * 64; \
    R##a0 = *(const uint4*)(pa_); R##a1 = *(const uint4*)(pa_ + sA); R##a2 = *(const uint4*)(pa_ + 2 * sA); R##a3 = *(const uint4*)(pa_ + 3 * sA); \
    R##b0 = *(const uint4*)(pb_); if (NB > 1) R##b1 = *(const uint4*)(pb_ + bstride); if (NB > 2) R##b2 = *(const uint4*)(pb_ + 2 * bstride); } while (0)
#define SWRITE(R, buf) do { u16* qa_ = wA + (buf) * 256 * GLS; u16* qb_ = wB + (buf) * NB * 64 * GLS; \
    *(uint4*)(qa_) = R##a0; *(uint4*)(qa_ + 64 * GLS) = R##a1; *(uint4*)(qa_ + 128 * GLS) = R##a2; *(uint4*)(qa_ + 192 * GLS) = R##a3; \
    *(uint4*)(qb_) = R##b0; if (NB > 1) *(uint4*)(qb_ + 64 * GLS) = R##b1; if (NB > 2) *(uint4*)(qb_ + 128 * GLS) = R##b2; } while (0)
#define COMPUTE(buf) do { const u16* Ab = As + (buf) * 256 * GLS + (wm * 64 + r32) * GLS + hi * 8; const u16* Bb = Bs + (buf) * NB * 64 * GLS + (wn * 32 + r32) * GLS + hi * 8; \
    _Pragma("unroll") for (int ks = 0; ks < 4; ++ks) { \
      const bf16x8 fa0 = *(const bf16x8*)(Ab + ks * 16), fa1 = *(const bf16x8*)(Ab + 32 * GLS + ks * 16); \
      _Pragma("unroll") for (int ib = 0; ib < NB; ++ib) { \
        const bf16x8 fb = *(const bf16x8*)(Bb + ib * 64 * GLS + ks * 16); \
        acc[ib][0] = __builtin_amdgcn_mfma_f32_32x32x16_bf16(fa0, fb, acc[ib][0], 0, 0, 0); \
        acc[ib][1] = __builtin_amdgcn_mfma_f32_32x32x16_bf16(fa1, fb, acc[ib][1], 0, 0, 0); } } } while (0)
  GLOAD(x, 0); GLOAD(y, 1);
  SWRITE(x, 0); GLOAD(x, 2);
  __syncthreads();
  for (int kt = 0; kt < nk; kt += 2) {
    COMPUTE(0);
    SWRITE(y, 1);
    if (kt + 3 < nk) GLOAD(y, kt + 3);
    __syncthreads();
    COMPUTE(1);
    if (kt + 2 < nk) { SWRITE(x, 0); if (kt + 4 < nk) GLOAD(x, kt + 4); }
    __syncthreads();
  }
#undef COMPUTE
#undef GLOAD
#undef SWRITE
}
__device__ __forceinline__ void gemm_kloop256(const u16* __restrict__ A, int lda, const u16* __restrict__ Bt, int ldb, int K, char* smem, f32x16 (&acc)[4][2]) {
  u16* As = (u16*)smem; u16* Bs = As + 2 * 256 * GLS;
  const int tid = tidx(), wid = tid >> 6, lane = tid & 63, r32 = lane & 31, hi = lane >> 5;
  const int wm = wid >> 2, wn = wid & 3;
#pragma unroll
  for (int mi = 0; mi < 4; ++mi)
#pragma unroll
    for (int ni = 0; ni < 2; ++ni)
#pragma unroll
      for (int r = 0; r < 16; ++r) acc[mi][ni][r] = 0.f;
  uint4 a0, a1, a2, a3, b0, b1, b2, b3;
  const int nk = K / 64;
  const int lrow = tid >> 3, lkc = tid & 7;
  const u16* gA = A + (size_t)lrow * lda + lkc * 8;
  const u16* gB = Bt + (size_t)lrow * ldb + lkc * 8;
  const size_t sA = (size_t)64 * lda, sB = (size_t)64 * ldb;
  u16* wA = As + lrow * GLS + lkc * 8; u16* wB = Bs + lrow * GLS + lkc * 8;
#define GLOAD(kt) do { const u16* pa_ = gA + (kt) * 64; const u16* pb_ = gB + (kt) * 64; \
    a0 = *(const uint4*)(pa_); a1 = *(const uint4*)(pa_ + sA); a2 = *(const uint4*)(pa_ + 2 * sA); a3 = *(const uint4*)(pa_ + 3 * sA); \
    b0 = *(const uint4*)(pb_); b1 = *(const uint4*)(pb_ + sB); b2 = *(const uint4*)(pb_ + 2 * sB); b3 = *(const uint4*)(pb_ + 3 * sB); } while (0)
#define SWRITE(buf) do { u16* qa_ = wA + (buf) * 256 * GLS; u16* qb_ = wB + (buf) * 256 * GLS; \
    *(uint4*)(qa_) = a0; *(uint4*)(qa_ + 64 * GLS) = a1; *(uint4*)(qa_ + 128 * GLS) = a2; *(uint4*)(qa_ + 192 * GLS) = a3; \
    *(uint4*)(qb_) = b0; *(uint4*)(qb_ + 64 * GLS) = b1; *(uint4*)(qb_ + 128 * GLS) = b2; *(uint4*)(qb_ + 192 * GLS) = b3; } while (0)
  GLOAD(0); SWRITE(0); GLOAD(1);
  __syncthreads();
  for (int kt = 0; kt < nk; ++kt) {
    const int buf = kt & 1;
    const u16* Ab = As + buf * 256 * GLS + (wm * 128 + r32) * GLS + hi * 8;
    const u16* Bb = Bs + buf * 256 * GLS + (wn * 64 + r32) * GLS + hi * 8;
#pragma unroll
    for (int ks = 0; ks < 4; ++ks) {
      const bf16x8 fb0 = *(const bf16x8*)(Bb + ks * 16), fb1 = *(const bf16x8*)(Bb + 32 * GLS + ks * 16);
#pragma unroll
      for (int mi = 0; mi < 4; ++mi) {
        const bf16x8 fa = *(const bf16x8*)(Ab + mi * 32 * GLS + ks * 16);
        acc[mi][0] = __builtin_amdgcn_mfma_f32_32x32x16_bf16(fa, fb0, acc[mi][0], 0, 0, 0);
        acc[mi][1] = __builtin_amdgcn_mfma_f32_32x32x16_bf16(fa, fb1, acc[mi][1], 0, 0, 0);
      }
    }
    if (kt + 1 < nk) { SWRITE(buf ^ 1); if (kt + 2 < nk) GLOAD(kt + 2); }
    __syncthreads();
  }
#undef GLOAD
#undef SWRITE
}
__device__ __forceinline__ void store_tile256_bf16(const f32x16 (&acc)[4][2], u16* __restrict__ C, int ldc, int ncols) {
  const int wid = tidx() >> 6, lane = tidx() & 63, r32 = lane & 31, hi = lane >> 5, wm = wid >> 2, wn = wid & 3;
#pragma unroll
  for (int mi = 0; mi < 4; ++mi)
#pragma unroll
    for (int ni = 0; ni < 2; ++ni) {
      const int col = wn * 64 + ni * 32 + r32;
      if (col < ncols) {
#pragma unroll
        for (int r = 0; r < 16; ++r) C[(size_t)(wm * 128 + mi * 32 + crow(r, hi)) * ldc + col] = f2bf(acc[mi][ni][r]);
      }
    }
}
__device__ __forceinline__ void store_tile_bf16(const f32x16 (&acc)[2][2], u16* __restrict__ C, int ldc, int ncols) {
  const int wid = tidx() >> 6, lane = tidx() & 63, r32 = lane & 31, hi = lane >> 5, wm = wid >> 1, wn = wid & 1;
#pragma unroll
  for (int mi = 0; mi < 2; ++mi)
#pragma unroll
    for (int ni = 0; ni < 2; ++ni) {
      const int col = wn * 64 + ni * 32 + r32;
      if (col < ncols) {
#pragma unroll
        for (int r = 0; r < 16; ++r) C[(size_t)(wm * 64 + mi * 32 + crow(r, hi)) * ldc + col] = f2bf(acc[mi][ni][r]);
      }
    }
}

namespace att {
constexpr int D = 128, NW = 8, QBLK = 32, KVBLK = 64;
constexpr float SCALE = 0.088388347648318440f;
constexpr float THR = 8.f;
constexpr int LDQ = LDP, LDK = LDP;
constexpr size_t SHM_V = KVBLK * D * 2, SHM_K = KVBLK * D * 2, SHM_ATTN = 2 * SHM_V + 2 * SHM_K + NW * 64 * 4;
#define KSWZ(row, colB) ((row) * 256 + ((colB) ^ (((row) & 7) << 4)))
#define SBAR() __builtin_amdgcn_sched_barrier(0)
__device__ __forceinline__ unsigned cvtpk(float lo, float hi) {
  unsigned r; asm volatile("v_cvt_pk_bf16_f32 %0, %1, %2" : "=v"(r) : "v"(lo), "v"(hi)); return r;
}
__device__ __forceinline__ bf16x8 ld8(const bf16* p) { return *reinterpret_cast<const bf16x8*>(p); }
__device__ __forceinline__ void partialSM(f32x16& p0, f32x16& p1, float& m_reg, float& mn, float& alpha) {
  constexpr float C = SCALE * 1.4426950408889634f;
  float pmax = p0[0]; for (int r = 1; r < 16; ++r) pmax = fmaxf(pmax, p0[r]); for (int r = 0; r < 16; ++r) pmax = fmaxf(pmax, p1[r]);
  { auto rr = __builtin_amdgcn_permlane32_swap(__float_as_uint(pmax), __float_as_uint(pmax), false, false);
    pmax = fmaxf(__uint_as_float(rr[0]), __uint_as_float(rr[1])); }
  if (__builtin_expect(__all(pmax - m_reg <= THR / SCALE), 1)) { mn = m_reg; alpha = 1.f; }
  else { mn = fmaxf(m_reg, pmax); alpha = __builtin_amdgcn_exp2f((m_reg - mn) * C); m_reg = mn; }
  float mnC = -mn * C;
  for (int r = 0; r < 16; ++r) p0[r] = fmaf(p0[r], C, mnC); for (int r = 0; r < 16; ++r) p1[r] = fmaf(p1[r], C, mnC);
  for (int r = 0; r < 16; ++r) p0[r] = __builtin_amdgcn_exp2f(p0[r]);
}
__device__ __forceinline__ void finishSM(f32x16& p0, f32x16& p1, float alpha, float& l_reg, bf16x8& pa0, bf16x8& pa1, bf16x8& pa2, bf16x8& pa3) {
  for (int r = 0; r < 16; ++r) p1[r] = __builtin_amdgcn_exp2f(p1[r]);
  float ps = 0; for (int r = 0; r < 16; ++r) ps += p0[r]; for (int r = 0; r < 16; ++r) ps += p1[r];
  { auto rr = __builtin_amdgcn_permlane32_swap(__float_as_uint(ps), __float_as_uint(ps), false, false);
    ps = __uint_as_float(rr[0]) + __uint_as_float(rr[1]); }
  l_reg = l_reg * alpha + ps;
#define PK4(P, BASE, OUT) do { unsigned a0 = cvtpk(P[BASE + 0], P[BASE + 1]), a1 = cvtpk(P[BASE + 2], P[BASE + 3]);   \
    unsigned b0 = cvtpk(P[BASE + 4], P[BASE + 5]), b1 = cvtpk(P[BASE + 6], P[BASE + 7]);                              \
    auto r0 = __builtin_amdgcn_permlane32_swap(a0, b0, false, false); auto r1 = __builtin_amdgcn_permlane32_swap(a1, b1, false, false); \
    u32x4 w = {r0[0], r1[0], r0[1], r1[1]}; OUT = *reinterpret_cast<bf16x8*>(&w); } while (0)
  PK4(p0, 0, pa0); PK4(p0, 8, pa1); PK4(p1, 0, pa2); PK4(p1, 8, pa3);
#undef PK4
}
__device__ __forceinline__ void qkt(f32x16& p0, f32x16& p1, const bf16* Ks, const bf16x8* qr, int r32, int hi) {
  p0 = f32x16{}; p1 = f32x16{};
  for (int d0 = 0; d0 < 8; ++d0) { int cb = (d0 * 16 + hi * 8) * 2;
    bf16x8 b0 = *reinterpret_cast<const bf16x8*>((const char*)Ks + KSWZ(r32, cb));
    bf16x8 b1 = *reinterpret_cast<const bf16x8*>((const char*)Ks + KSWZ(32 + r32, cb));
    p0 = __builtin_amdgcn_mfma_f32_32x32x16_bf16(b0, qr[d0], p0, 0, 0, 0);
    p1 = __builtin_amdgcn_mfma_f32_32x32x16_bf16(b1, qr[d0], p1, 0, 0, 0); }
}
__device__ __forceinline__ int v_st(int k, int c) { const int kk = (k & ~0xC) | ((k & 4) << 1) | ((k & 8) >> 1); return ((kk >> 3) * 4 + (c >> 5)) * 512 + ((kk & 7) * 32 + (c & 31)) * 2; }
__device__ __forceinline__ int v_rd_base(int lane) { return ((lane & 3) << 3) | (((lane >> 2) & 3) << 6) | (((lane >> 4) & 1) << 5) | (((lane >> 5) & 1) << 8); }
constexpr int v_rd_off(int d0, int ks, int half) { return d0 * 512 + ks * 4096 + half * 2048; }
template <int OFF> __device__ __forceinline__ s16x4 tr_read(int vb) {
  s16x4 r; asm volatile("ds_read_b64_tr_b16 %0, %1 offset:%2" : "=&v"(r) : "v"(vb), "i"(OFF) : "memory"); return r;
}
template <int D0> __device__ __forceinline__ void pv_one(f32x16& od, int vb, bf16x8 pa0, bf16x8 pa1, bf16x8 pa2, bf16x8 pa3) {
  const s16x4 l0 = tr_read<v_rd_off(D0, 0, 0)>(vb), h0 = tr_read<v_rd_off(D0, 0, 1)>(vb), l1 = tr_read<v_rd_off(D0, 1, 0)>(vb), h1 = tr_read<v_rd_off(D0, 1, 1)>(vb);
  const s16x4 l2 = tr_read<v_rd_off(D0, 2, 0)>(vb), h2 = tr_read<v_rd_off(D0, 2, 1)>(vb), l3 = tr_read<v_rd_off(D0, 3, 0)>(vb), h3 = tr_read<v_rd_off(D0, 3, 1)>(vb);
  asm volatile("s_waitcnt lgkmcnt(0)" ::: "memory"); SBAR();
#define PK(L, H) (bf16x8){L[0], L[1], L[2], L[3], H[0], H[1], H[2], H[3]}
  od = __builtin_amdgcn_mfma_f32_32x32x16_bf16(pa0, PK(l0, h0), od, 0, 0, 0);
  od = __builtin_amdgcn_mfma_f32_32x32x16_bf16(pa1, PK(l1, h1), od, 0, 0, 0);
  od = __builtin_amdgcn_mfma_f32_32x32x16_bf16(pa2, PK(l2, h2), od, 0, 0, 0);
  od = __builtin_amdgcn_mfma_f32_32x32x16_bf16(pa3, PK(l3, h3), od, 0, 0, 0);
#undef PK
}
__device__ __forceinline__ void pv_d0(f32x16* o, int vb, bf16x8 pa0, bf16x8 pa1, bf16x8 pa2, bf16x8 pa3) {
  pv_one<0>(o[0], vb, pa0, pa1, pa2, pa3); pv_one<1>(o[1], vb, pa0, pa1, pa2, pa3); pv_one<2>(o[2], vb, pa0, pa1, pa2, pa3); pv_one<3>(o[3], vb, pa0, pa1, pa2, pa3);
}
__device__ __forceinline__ void attn_dense_body(const bf16* Qb, const bf16* __restrict__ Kh, const bf16* __restrict__ Vh,
                                                const u16* __restrict__ Gb, u16* Yb, int seq, char* lds) {
  const int tid = tidx(), wid = tid >> 6, lane = tid & 63, r32 = lane & 31, hi = lane >> 5;
  bf16* V_lds = (bf16*)lds; bf16* K_lds = (bf16*)(lds + 2 * SHM_V);
  float* ws = (float*)(lds + 2 * SHM_V + 2 * SHM_K) + wid * 64; float* li_l = ws; float* al_l = ws + 32;
  float m_reg = -1e30f, l_reg = 0; f32x16 o[4] = {}; bf16x8 qr[8];
  const bf16* Qw = Qb + (long)(wid * QBLK + r32) * LDQ + hi * 8;
#pragma unroll
  for (int d0 = 0; d0 < 8; ++d0) qr[d0] = ld8(Qw + d0 * 16);
  const int sr = tid >> 4, sc = (tid & 15) * 8, vst0 = v_st(sr, sc), vst1 = v_st(32 + sr, sc);
  const int vb0 = (int)(uintptr_t)V_lds + v_rd_base(lane);
  struct { bf16x8 vs0, vs1, ks0, ks1; } sr_[2];
#define SLOAD(i, k0) do { sr_[i].vs0 = ld8(&Vh[(long)((k0) + sr) * LDK + sc]); sr_[i].vs1 = ld8(&Vh[(long)((k0) + 32 + sr) * LDK + sc]); \
    sr_[i].ks0 = ld8(&Kh[(long)((k0) + sr) * LDK + sc]); sr_[i].ks1 = ld8(&Kh[(long)((k0) + 32 + sr) * LDK + sc]); } while (0)
#define SWRITE(b, i) do { *(bf16x8*)((char*)V_lds + (b) * SHM_V + vst0) = sr_[i].vs0;          \
    *(bf16x8*)((char*)V_lds + (b) * SHM_V + vst1) = sr_[i].vs1; int kc = sc * 2;               \
    *(bf16x8*)((char*)K_lds + (b) * SHM_K + KSWZ(sr, kc)) = sr_[i].ks0;                       \
    *(bf16x8*)((char*)K_lds + (b) * SHM_K + KSWZ(32 + sr, kc)) = sr_[i].ks1; } while (0)
#define SWAIT() do { asm volatile("s_waitcnt vmcnt(4)" ::: "memory"); } while (0)
#define RESC(a) do { if (__any((a) < 1.f)) { if (hi == 0) al_l[r32] = (a); asm volatile("s_waitcnt lgkmcnt(0)" ::: "memory"); \
    for (int d = 0; d < 4; ++d) for (int r = 0; r < 16; ++r) o[d][r] *= al_l[crow(r, hi)]; } } while (0)
  f32x16 pA0, pA1, pB0, pB1; float mnA, mnB, alA, alB; bf16x8 pa0, pa1, pa2, pa3; const int NT = seq / KVBLK;
  constexpr int SE = 0, SO = 1;
  SLOAD(SE, 0); asm volatile("s_waitcnt vmcnt(0)" ::: "memory"); SWRITE(0, SE); __syncthreads();
  qkt(pA0, pA1, K_lds, qr, r32, hi); partialSM(pA0, pA1, m_reg, mnA, alA);
  SLOAD(SO, KVBLK); if (2 < NT) SLOAD(SE, 2 * KVBLK);
  SWAIT(); SWRITE(1, SO); __syncthreads();
  for (int j = 1; j + 1 < NT; j += 2) {
    SBAR(); qkt(pB0, pB1, (bf16*)((char*)K_lds + SHM_K), qr, r32, hi);
    finishSM(pA0, pA1, alA, l_reg, pa0, pa1, pa2, pa3); SBAR();
    SLOAD(SO, (j + 2) * KVBLK); SBAR();
    pv_d0(o, vb0, pa0, pa1, pa2, pa3); partialSM(pB0, pB1, m_reg, mnB, alB);
    __syncthreads(); SWAIT(); SWRITE(0, SE);
    RESC(alB); __syncthreads();
    SBAR(); qkt(pA0, pA1, K_lds, qr, r32, hi);
    finishSM(pB0, pB1, alB, l_reg, pa0, pa1, pa2, pa3); SBAR();
    if (j + 3 < NT) SLOAD(SE, (j + 3) * KVBLK); SBAR();
    pv_d0(o, vb0 + (int)SHM_V, pa0, pa1, pa2, pa3); partialSM(pA0, pA1, m_reg, mnA, alA);
    __syncthreads(); SWAIT(); SWRITE(1, SO);
    RESC(alA); __syncthreads();
  }
  SBAR(); qkt(pB0, pB1, (bf16*)((char*)K_lds + SHM_K), qr, r32, hi);
  finishSM(pA0, pA1, alA, l_reg, pa0, pa1, pa2, pa3); SBAR();
  pv_d0(o, vb0, pa0, pa1, pa2, pa3); partialSM(pB0, pB1, m_reg, mnB, alB);
  __syncthreads(); RESC(alB);
  finishSM(pB0, pB1, alB, l_reg, pa0, pa1, pa2, pa3); SBAR();
  pv_d0(o, vb0 + (int)SHM_V, pa0, pa1, pa2, pa3);
  if (hi == 0) li_l[r32] = l_reg; asm volatile("s_waitcnt lgkmcnt(0)" ::: "memory");
  float rli[16];
#pragma unroll
  for (int r = 0; r < 16; ++r) rli[r] = __builtin_amdgcn_rcpf(li_l[crow(r, hi)]);
#pragma unroll
  for (int r = 0; r < 16; ++r) { const long orow = wid * QBLK + crow(r, hi);
#pragma unroll
    for (int d0 = 0; d0 < 4; ++d0) {
      const float gt = bf2f(Gb[orow * LDQ + d0 * 32 + r32]);
      Yb[orow * LDQ + d0 * 32 + r32] = f2bf(o[d0][r] * rli[r] * siluf_(gt));
    } }
  __syncthreads();
#undef SLOAD
#undef SWRITE
#undef SWAIT
#undef RESC
}
}

__device__ __forceinline__ const float* xrow_ptr(KParams p, int l, int r) {
  const int b = r / SB, s = r % SB;
  if (s < T) return (l == 0 ? p->x : (const float*)p->out) + ((size_t)b * T + s) * DM;
  return (l == 0 ? p->ctx : (const float*)p->xc1) + ((size_t)b * TC + (s - T)) * DM;
}
__device__ __forceinline__ void hrow_write(const float4 (&v)[4], const float* __restrict__ g_pre, const float* __restrict__ md, u16* dst, int lane) {
  float ss = 0.f;
#pragma unroll
  for (int i = 0; i < 4; ++i) ss += v[i].x * v[i].x + v[i].y * v[i].y + v[i].z * v[i].z + v[i].w * v[i].w;
  ss = wave_sum(ss);
  const float rstd = rsqrtf(ss * (1.f / 1024.f) + 1e-6f);
#pragma unroll
  for (int i = 0; i < 4; ++i) {
    const int col = i * 256 + lane * 4;
    const float4 g = *(const float4*)(g_pre + col), sc = *(const float4*)(md + 1024 + col), sh = *(const float4*)(md + col);
    ushort4 o;
    o.x = f2bf(v[i].x * rstd * g.x * (1.f + sc.x) + sh.x); o.y = f2bf(v[i].y * rstd * g.y * (1.f + sc.y) + sh.y);
    o.z = f2bf(v[i].z * rstd * g.z * (1.f + sc.z) + sh.z); o.w = f2bf(v[i].w * rstd * g.w * (1.f + sc.w) + sh.w);
    *(ushort4*)(dst + col) = o;
  }
}

__device__ __forceinline__ void transpose_tile(const float* __restrict__ src, u16* __restrict__ dst, int K, int N, int nt, int kt, char* smem) {
  float* tile = (float*)smem;
  const int n0 = nt * 64, k0 = kt * 64, tx = tidx() & 63, ty = tidx() >> 6;
  __syncthreads();
#pragma unroll
  for (int i = 0; i < 8; ++i) { const int k = i * 8 + ty, n = n0 + tx; tile[k * 65 + tx] = (n < N) ? src[(size_t)(k0 + k) * N + n] : 0.f; }
  __syncthreads();
#pragma unroll
  for (int i = 0; i < 8; ++i) { const int n = i * 8 + ty; dst[(size_t)(n0 + n) * K + k0 + tx] = f2bf(tile[tx * 65 + n]); }
}
__device__ __forceinline__ void mod_item(KParams p, int item, char* smem) {
  float* sc = (float*)smem;
  float* red = sc + 17 * 512;
  const int l = item / 48, cgp = item % 48, tid = tidx(), kg = tid >> 6, jl = tid & 63, j = cgp * 64 + jl;
  const float* W = p->w_mod + (size_t)l * 1024 * 3072;
  float acc[17];
#pragma unroll
  for (int i = 0; i < 17; ++i) acc[i] = 0.f;
  for (int half = 0; half < 2; ++half) {
    __syncthreads();
    for (int e = tid; e < 17 * 512; e += 512) { const int i = e >> 9, k = e & 511; const float v = (i < 16) ? p->c[i * 1024 + half * 512 + k] : p->c_ctx[half * 512 + k]; sc[e] = siluf_(v); }
    __syncthreads();
    for (int kk = 0; kk < 64; ++kk) {
      const int k = kg * 64 + kk;
      const float w = W[(size_t)(half * 512 + k) * 3072 + j];
#pragma unroll
      for (int i = 0; i < 17; ++i) acc[i] += sc[i * 512 + k] * w;
    }
  }
#pragma unroll
  for (int i = 0; i < 17; ++i) red[(kg * 17 + i) * 64 + jl] = acc[i];
  __syncthreads();
  for (int e = tid; e < 17 * 64; e += 512) { const int i = e >> 6, jj = e & 63;
    float v = p->b_mod[l * 3072 + cgp * 64 + jj];
#pragma unroll
    for (int g = 0; g < 8; ++g) v += red[(g * 17 + i) * 64 + jj];
    p->mod[((size_t)l * 17 + i) * 3072 + cgp * 64 + jj] = v; }
}
__device__ __forceinline__ void phase_prologue(KParams p, char* smem) {
  constexpr int N_IN = 2 * 134 * 16, N_O = 2 * 3 * 16 * 8, N_OUT = 2 * 16 * 16, N_MOD = 96;
  for (int it = blockIdx.x; it < N_IN + N_O + N_OUT + N_MOD; it += gridDim.x) {
    if (it < N_MOD) mod_item(p, it, smem);
    else if (it < N_MOD + N_IN) { const int u = it - N_MOD, l = u / (134 * 16), v = u % (134 * 16);
      transpose_tile(p->w_in + (size_t)l * 1024 * DIN, p->Wt_in + (size_t)l * DINP * 1024, 1024, DIN, v % 134, v / 134, smem); }
    else if (it < N_MOD + N_IN + N_O) { const int u = it - N_MOD - N_IN, li = u / 128, v = u % 128, l = li / 3, i = li % 3;
      const float* src = (i == 0 ? p->w_o_gla : i == 1 ? p->w_o_att : p->w_o_rwkv) + (size_t)l * 512 * 1024;
      transpose_tile(src, p->Wt_o + (size_t)li * 1024 * 512, 512, 1024, v % 16, v / 16, smem); }
    else { const int u = it - N_MOD - N_IN - N_O, l = u / 256, v = u % 256;
      transpose_tile(p->w_out + (size_t)l * 1024 * 1024, p->Wt_out + (size_t)l * 1024 * 1024, 1024, 1024, v % 16, v / 16, smem); }
  }
}

__device__ __forceinline__ void phase_a0(KParams p) {
  const int wid = tidx() >> 6, lane = tidx() & 63;
  for (int r = blockIdx.x * 8 + wid; r < R; r += gridDim.x * 8) {
    const int b = r / SB, s = r % SB;
    const float* src = xrow_ptr(p, 0, r);
    float4 v[4];
#pragma unroll
    for (int i = 0; i < 4; ++i) v[i] = *(const float4*)(src + i * 256 + lane * 4);
    hrow_write(v, p->g_pre, p->mod + (size_t)((s < T) ? b : 16) * 3072, p->SH + (size_t)r * 1024, lane);
  }
}

namespace pg8 {
#define PG8_LAS __attribute__((address_space(3)))
typedef unsigned short bf16_t;
typedef short bf16x8 __attribute__((ext_vector_type(8)));
typedef float f32x4 __attribute__((ext_vector_type(4)));
typedef unsigned u32x4 __attribute__((ext_vector_type(4)));
constexpr int BM = 256, BK = 64, HALF = 128, HTB = HALF * BK * 2  , STAGE_BYTES = 8 * HTB, NXCD = 8, WGM = 8;

__host__ __device__ __forceinline__ int lds_byte(int r, int c) { const int st = (r >> 4) * 2 + (c >> 5), rr = r & 15, cc = c & 31, ob = rr * 64 + cc * 2; return st * 1024 + (ob ^ (((ob >> 9) & 1) << 5)); }
__host__ __device__ __forceinline__ void stage_rc(int b, int& R, int& C) { const int st = b / 1024, sb = b % 1024, swz = sb ^ (((sb >> 9) & 1) << 5); R = (st >> 1) * 16 + swz / 64; C = (st & 1) * 32 + (swz % 64) / 2; }
__host__ __device__ __forceinline__ int perm32(int rho) { const int n = rho >> 4, i = rho & 15; return 8 * (i >> 2) + 4 * n + (i & 3); }

struct Unit { int pm, pn; };
struct Gemm { const bf16_t* A; const bf16_t* Bt; int M, N, K; };

struct StaticOrder {
    int nM, nN, nwg, G, c;
    __host__ __device__ void init(int M, int N, int G_, int c_) { nM = M / BM; nN = N / BM; nwg = nM * nN; G = G_; c = c_; }
    __host__ __device__ bool next(int i, Unit& u) const {
        const long L = (long)i * G + c; if (L >= nwg) return false;
        int wgid = (int)L; { const int q = nwg / NXCD, r = nwg % NXCD, xcd = wgid % NXCD, off = wgid / NXCD; wgid = (xcd < r ? xcd * (q + 1) : r * (q + 1) + (xcd - r) * q) + off; }
        const int nig = WGM * nN, gid = wgid / nig, fm = gid * WGM, gsz = (nM - fm) < WGM ? (nM - fm) : WGM;
        u.pm = fm + ((wgid % nig) % gsz); u.pn = (wgid % nig) / gsz; return true;
    }
    __device__ __forceinline__ void a_ready(const Unit&) const {}
    __device__ __forceinline__ void done(const Unit&) const {}
};
struct EpiProj {
    static constexpr bool PERM = true, AFTER_DRAIN = false;
    bf16_t* O; int ldc; int ncols;
    __device__ __forceinline__ void operator()(const f32x4 (&acc)[2][2][4][2], const Unit& u, int wr, int wc, int fr, int fq) const {
        const int row0 = u.pm * BM + wr * 64 + fr, col0 = u.pn * BM + wc * 32 + 8 * fq;
#pragma unroll
        for (int ai = 0; ai < 2; ++ai)
#pragma unroll
            for (int m = 0; m < 4; ++m) { bf16_t* rowp = O + (size_t)(row0 + ai * HALF + m * 16) * ldc + col0;
#pragma unroll
                for (int bj = 0; bj < 2; ++bj) if (col0 + bj * HALF < ncols) { const f32x4 v0 = acc[ai][bj][m][0], v1 = acc[ai][bj][m][1];
                    u32x4 w; w.x = pack2(v0[0], v0[1]); w.y = pack2(v0[2], v0[3]); w.z = pack2(v1[0], v1[1]); w.w = pack2(v1[2], v1[3]);
                    *(u32x4*)(rowp + bj * HALF) = w; } }
    }
};
template <class Epi, class Sched, bool STAMP = false>
__device__ __forceinline__ void gemm_phase(PG8_LAS unsigned char* lds, const Gemm g, const Sched& S, const Epi& E, unsigned long long* stamps) {
    const int tid = tidx(), wid = __builtin_amdgcn_readfirstlane(tid >> 6), lane = tid & 63, wr = wid >> 2, wc = wid & 3, fr = lane & 15, fq = lane >> 4;
    const int K = g.K, nt = K / BK;
    int ts_lo = 0, ts_hi = 0, nts = 0; const unsigned long long rt_entry = STAMP ? (unsigned long long)wall_clock64() : 0ull;
#define PG8_STAMP() do { if (STAMP && wid == 0 && nts < 64) { const unsigned long long _c = (unsigned long long)clock64(); \
        ts_lo = (lane == nts) ? (int)(unsigned)_c : ts_lo; ts_hi = (lane == nts) ? (int)(unsigned)(_c >> 32) : ts_hi; ++nts; } } while (0)
    PG8_STAMP();
    unsigned voffA[2], voffB[2];
#pragma unroll
    for (int i = 0; i < 2; ++i) { int R, C; stage_rc(tid * 16 + i * 8192, R, C); const int Rb = Epi::PERM ? ((R & ~31) + perm32(R & 31)) : R;
        voffA[i] = (unsigned)(R * K + C) * 2u; voffB[i] = (unsigned)(Rb * K + C) * 2u; }
    const size_t kstep = (size_t)(BK * 2);
    const size_t hstep = (size_t)HALF * K * 2;
    const size_t tstep = 2 * hstep;
    const unsigned ldsw = (unsigned)wid * 1024u;
    const int aoff = lds_byte(wr * 64 + fr, fq * 8), boff = lds_byte(wc * 32 + fr, fq * 8);
#define PG8_SA(b, h) (((b) * 2 + (h)) * HTB)
#define PG8_SB(b, h) ((4 + (b) * 2 + (h)) * HTB)
#define PG8_STAGE(bufoff, gbase, voff) do { _Pragma("unroll") for (int _i = 0; _i < 2; ++_i) \
        __builtin_amdgcn_global_load_lds((const unsigned*)((const char*)(gbase) + (voff)[_i]), (PG8_LAS unsigned*)(lds + (bufoff) + ldsw + _i * 8192), 16, 0, 0); } while (0)
#define PG8_LDA(dst, b, h) do { _Pragma("unroll") for (int m = 0; m < 4; ++m) _Pragma("unroll") for (int k = 0; k < 2; ++k) dst[m][k] = *(const PG8_LAS bf16x8*)(lds + PG8_SA(b, h) + aoff + m * 2048 + k * 1024); } while (0)
#define PG8_LDB(dst, b, h) do { _Pragma("unroll") for (int n = 0; n < 2; ++n) _Pragma("unroll") for (int k = 0; k < 2; ++k) dst[n][k] = *(const PG8_LAS bf16x8*)(lds + PG8_SB(b, h) + boff + n * 2048 + k * 1024); } while (0)
#define PG8_MMA(ai, bj, At, Bt) do { __builtin_amdgcn_s_setprio(1); _Pragma("unroll") for (int m = 0; m < 4; ++m) _Pragma("unroll") for (int n = 0; n < 2; ++n) _Pragma("unroll") for (int k = 0; k < 2; ++k) \
        acc[ai][bj][m][n] = __builtin_amdgcn_mfma_f32_16x16x32_bf16(Bt[n][k], At[m][k], acc[ai][bj][m][n], 0, 0, 0); __builtin_amdgcn_s_setprio(0); } while (0)
#define PG8_WAIT_V(n) asm volatile("s_waitcnt vmcnt(" #n ")" ::: "memory")
#define PG8_WAIT_L(n) asm volatile("s_waitcnt lgkmcnt(" #n ")" ::: "memory")
#define PG8_BAR __builtin_amdgcn_s_barrier()
#define PG8_SCHED __builtin_amdgcn_sched_barrier(0)
    Unit cur, nxt; int ui = 0;
    if (!S.next(0, cur)) return;
    f32x4 acc[2][2][4][2];
#pragma unroll
    for (int a = 0; a < 2; ++a)
#pragma unroll
        for (int b = 0; b < 2; ++b)
#pragma unroll
            for (int m = 0; m < 4; ++m)
#pragma unroll
                for (int n = 0; n < 2; ++n) acc[a][b][m][n] = (f32x4){0.f, 0.f, 0.f, 0.f};
    bf16x8 At[4][2], B0[2][2], B1[2][2];
    const char* cA = (const char*)g.A + (size_t)cur.pm * tstep; const char* cB = (const char*)g.Bt + (size_t)cur.pn * tstep;
    S.a_ready(cur);
    PG8_STAGE(PG8_SB(0, 0), cB, voffB); PG8_STAGE(PG8_SA(0, 0), cA, voffA); PG8_STAGE(PG8_SB(0, 1), cB + hstep, voffB); PG8_STAGE(PG8_SA(0, 1), cA + hstep, voffA);
    if (wr == 1) PG8_BAR;
    PG8_WAIT_V(4); PG8_BAR;
    PG8_STAGE(PG8_SB(1, 0), cB + kstep, voffB); PG8_STAGE(PG8_SA(1, 0), cA + kstep, voffA); PG8_STAGE(PG8_SB(1, 1), cB + hstep + kstep, voffB);
    PG8_WAIT_V(6); PG8_BAR;
    PG8_STAMP();
    for (;;) {
        const bool has_next = S.next(ui + 1, nxt);
        const char* nA = has_next ? (const char*)g.A + (size_t)nxt.pm * tstep : cA; const char* nB = has_next ? (const char*)g.Bt + (size_t)nxt.pn * tstep : cB;
        for (int t = 0; t < nt; t += 2) {
            const bool last = (t == nt - 2);
            const char* a1 = cA + (size_t)(t + 1) * kstep;
            const char* a2 = last ? nA : cA + (size_t)(t + 2) * kstep; const char* b2 = last ? nB : cB + (size_t)(t + 2) * kstep;
            const char* a3 = a2 + kstep; const char* b3 = b2 + kstep;
            if (last && has_next) S.a_ready(nxt);
            PG8_LDB(B0, 0, 0); PG8_SCHED; PG8_LDA(At, 0, 0); PG8_STAGE(PG8_SA(1, 1), a1 + hstep, voffA);
            PG8_WAIT_L(8); PG8_BAR; PG8_WAIT_L(0); PG8_MMA(0, 0, At, B0); PG8_BAR; PG8_SCHED;
            PG8_LDB(B1, 0, 1); PG8_STAGE(PG8_SB(0, 0), b2, voffB);
            PG8_BAR; PG8_WAIT_L(0); PG8_MMA(0, 1, At, B1); PG8_BAR;
            PG8_LDA(At, 0, 1); PG8_STAGE(PG8_SA(0, 0), a2, voffA);
            PG8_BAR; PG8_WAIT_L(0); PG8_MMA(1, 0, At, B0); PG8_BAR; PG8_SCHED;
            PG8_STAGE(PG8_SB(0, 1), b2 + hstep, voffB);
            PG8_WAIT_V(6); PG8_BAR; PG8_MMA(1, 1, At, B1); PG8_BAR;
            PG8_LDB(B0, 1, 0); PG8_SCHED; PG8_LDA(At, 1, 0); PG8_STAGE(PG8_SA(0, 1), a2 + hstep, voffA);
            PG8_WAIT_L(8); PG8_BAR; PG8_WAIT_L(0); PG8_MMA(0, 0, At, B0); PG8_BAR; PG8_SCHED;
            PG8_LDB(B1, 1, 1); PG8_STAGE(PG8_SB(1, 0), b3, voffB);
            PG8_BAR; PG8_WAIT_L(0); PG8_MMA(0, 1, At, B1); PG8_BAR;
            PG8_LDA(At, 1, 1); PG8_STAGE(PG8_SA(1, 0), a3, voffA);
            PG8_BAR; PG8_WAIT_L(0); PG8_MMA(1, 0, At, B0); PG8_BAR; PG8_SCHED;
            PG8_STAGE(PG8_SB(1, 1), b3 + hstep, voffB);
            PG8_WAIT_V(6); PG8_BAR; PG8_MMA(1, 1, At, B1); PG8_BAR;
        }
        PG8_STAMP();
        if constexpr (!Epi::AFTER_DRAIN) { E(acc, cur, wr, wc, fr, fq); S.done(cur); }
        PG8_STAMP();
        if (!has_next) break;
#pragma unroll
        for (int a = 0; a < 2; ++a)
#pragma unroll
            for (int b = 0; b < 2; ++b)
#pragma unroll
                for (int m = 0; m < 4; ++m)
#pragma unroll
                    for (int n = 0; n < 2; ++n) acc[a][b][m][n] = (f32x4){0.f, 0.f, 0.f, 0.f};
        cur = nxt; cA = nA; cB = nB; ++ui;
    }
    PG8_WAIT_V(0);
    if (wr == 0) PG8_BAR;
    PG8_BAR;
    if constexpr (Epi::AFTER_DRAIN) { E.fused(acc, cur, wr, wc, fr, fq, lds, wid, lane); S.done(cur); }
    PG8_STAMP();
    if (STAMP && wid == 0) { stamps[lane] = lane < nts ? (((unsigned long long)(unsigned)ts_hi << 32) | (unsigned)ts_lo) : 0ull;
        if (lane == 62) stamps[62] = rt_entry; if (lane == 63) stamps[63] = (unsigned long long)wall_clock64(); }
#undef PG8_STAMP
#undef PG8_SA
#undef PG8_SB
#undef PG8_STAGE
#undef PG8_LDA
#undef PG8_LDB
#undef PG8_MMA
#undef PG8_WAIT_V
#undef PG8_WAIT_L
#undef PG8_BAR
#undef PG8_SCHED
}
}
__device__ __forceinline__ bool xcd_tile(int i, int nrt, int nnt, int& rt, int& nt) {
  const int x = blockIdx.x & 7, j = blockIdx.x >> 3, nb = gridDim.x >> 3;
  const int rpx = nrt >> 3;
  const int q = i * nb + j;
  if (q >= rpx * nnt) return false;
  const int g = q / (4 * nnt), r = q % (4 * nnt);
  const int gs = (rpx - g * 4) < 4 ? (rpx - g * 4) : 4;
  rt = x * rpx + g * 4 + r % gs; nt = r / gs;
  return true;
}
__device__ __forceinline__ void phase_a1(KParams p, int l, char* smem) {
  pg8::Gemm g; g.A = p->SH; g.Bt = p->Wt_in + (size_t)l * DINP * 1024; g.M = R; g.N = 22 * 256; g.K = 1024;
  pg8::StaticOrder S; S.init(g.M, g.N, (int)gridDim.x, (int)blockIdx.x);
  pg8::EpiProj E; E.O = p->P; E.ldc = LDP; E.ncols = LDP;
  pg8::gemm_phase<pg8::EpiProj, pg8::StaticOrder, false>((PG8_LAS unsigned char*)smem, g, S, E, nullptr);
}

__device__ __forceinline__ void attn_prep_all(KParams p, int l) {
  const float* qn = p->att_qnorm + l * 128; const float* kn = p->att_knorm + l * 128;
  const int tid = tidx(), k = tid & 15;
  const float inv0 = exp2f(-(float)(2 * k) * (13.287712379549449f / 32.f)), inv1 = exp2f(-(float)(2 * k + 1) * (13.287712379549449f / 32.f));
  for (long item = (long)blockIdx.x * 32 + (tid >> 4); item < (long)R * 6; item += (long)gridDim.x * 32) {
    const int r = (int)(item / 6), hh = (int)(item % 6), s = r % SB;
    const int col = (hh < 4) ? C_AQ + hh * 128 : C_AK + (hh - 4) * 128;
    const float* gw = (hh < 4) ? qn : kn;
    unsigned* pp = (unsigned*)(p->P + (size_t)r * LDP + col);
    const unsigned w0 = pp[k], w1 = pp[16 + k], w2 = pp[32 + k], w3 = pp[48 + k];
    float a0 = __uint_as_float(w0 << 16), a1 = __uint_as_float(w0 & 0xffff0000u), b0 = __uint_as_float(w1 << 16), b1 = __uint_as_float(w1 & 0xffff0000u);
    float c0 = __uint_as_float(w2 << 16), c1 = __uint_as_float(w2 & 0xffff0000u), d0 = __uint_as_float(w3 << 16), d1 = __uint_as_float(w3 & 0xffff0000u);
    const float ss = red16(a0 * a0 + a1 * a1 + b0 * b0 + b1 * b1 + c0 * c0 + c1 * c1 + d0 * d0 + d1 * d1);
    const float rstd = rsqrtf(ss * (1.f / 128.f) + 1e-6f);
    const float2 ga = *(const float2*)(gw + 2 * k), gb = *(const float2*)(gw + 32 + 2 * k), gc = *(const float2*)(gw + 64 + 2 * k), gd = *(const float2*)(gw + 96 + 2 * k);
    a0 *= rstd * ga.x; a1 *= rstd * ga.y; b0 *= rstd * gb.x; b1 *= rstd * gb.y; c0 *= rstd * gc.x; c1 *= rstd * gc.y; d0 *= rstd * gd.x; d1 *= rstd * gd.y;
    if (s < T) {
      const float pr = (float)(s >> 6), pc = (float)(s & 63);
      const float cr0 = __cosf(pr * inv0), sr0 = __sinf(pr * inv0), cr1 = __cosf(pr * inv1), sr1 = __sinf(pr * inv1);
      const float cc0 = __cosf(pc * inv0), sc0 = __sinf(pc * inv0), cc1 = __cosf(pc * inv1), sc1 = __sinf(pc * inv1);
      const float na0 = a0 * cr0 - b0 * sr0, nb0 = b0 * cr0 + a0 * sr0, na1 = a1 * cr1 - b1 * sr1, nb1 = b1 * cr1 + a1 * sr1;
      const float nc0 = c0 * cc0 - d0 * sc0, nd0 = d0 * cc0 + c0 * sc0, nc1 = c1 * cc1 - d1 * sc1, nd1 = d1 * cc1 + c1 * sc1;
      a0 = na0; b0 = nb0; a1 = na1; b1 = nb1; c0 = nc0; d0 = nd0; c1 = nc1; d1 = nd1;
    }
    pp[k] = pack2(a0, a1); pp[16 + k] = pack2(b0, b1); pp[32 + k] = pack2(c0, c1); pp[48 + k] = pack2(d0, d1);
  }
}

__device__ __forceinline__ float logsig16(float x) { return (fminf(x, 0.f) - __logf(1.f + __expf(-fabsf(x)))) * (1.f / 16.f); }
__device__ __forceinline__ void gla_state_unit(KParams p, int l, int unit, char* smem) {
  const int dir = unit & 1, h = (unit >> 1) & 3, b = unit >> 3;
  float* gc = (float*)smem;
  float* segtot = gc + 4096;
  float* lr = segtot + 512;
  float* dec = lr + 1024;
  float* edec = dec + 64;
  u16* KT = (u16*)(edec + 64);
  u16* VT = KT + 64 * 72;
  const int tid = tidx(), wid = tid >> 6, lane = tid & 63, r32 = lane & 31, hi = lane >> 5, mi = wid >> 2, ni = wid & 3;
  const int dd = tid & 63, seg = tid >> 6;
  const int ts = tid >> 3, td0 = (tid & 7) * 8;
  const float* wup = (dir ? p->gla_wup_b : p->gla_wup_f) + l * 16 * 256 + h * 64 + dd;
  float wu[16];
#pragma unroll
  for (int i = 0; i < 16; ++i) wu[i] = wup[i * 256];
  const float bia = ((dir ? p->gla_b_b : p->gla_b_f) + l * 256 + h * 64)[dd];
  f32x16 acc;
#pragma unroll
  for (int r = 0; r < 16; ++r) acc[r] = 0.f;
  uint4 kreg, vreg0, vreg1, lreg = make_uint4(0, 0, 0, 0);
#define GS_BASE(pi) (dir == 0 ? ((pi) < 4 ? T + 64 * (pi) : 64 * ((pi) - 4)) : ((pi) < 4 ? T + 64 * (3 - (pi)) : 64 * (67 - (pi))))
#define GS_LOAD(pi) do { const u16* Pr_ = p->P + (size_t)(b * SB + GS_BASE(pi) + ts) * LDP; \
    kreg = *(const uint4*)(Pr_ + C_GK + h * 64 + td0); vreg0 = *(const uint4*)(Pr_ + C_GV + h * 128 + td0); vreg1 = *(const uint4*)(Pr_ + C_GV + h * 128 + 64 + td0); \
    if (tid < 128) lreg = *(const uint4*)(p->P + (size_t)(b * SB + GS_BASE(pi) + (tid >> 1)) * LDP + C_GWF + dir * 16 + (tid & 1) * 8); } while (0)
  GS_LOAD(0);
  __syncthreads();
  for (int pi = 0; pi < 68; ++pi) {
    const int cid = GS_BASE(pi) >> 6;
    if (tid < 128) unpack8(lreg, lr + (tid >> 1) * 16 + (tid & 1) * 8);
    { const u16* v0 = (const u16*)&vreg0; const u16* v1 = (const u16*)&vreg1;
#pragma unroll
      for (int j = 0; j < 8; ++j) { VT[(td0 + j) * 72 + ts] = v0[j]; VT[(64 + td0 + j) * 72 + ts] = v1[j]; } }
    __syncthreads();
    float gv[8]; float run = 0.f;
#pragma unroll
    for (int j = 0; j < 8; ++j) { const int i = seg * 8 + j, c = dir ? 63 - i : i;
      float x = bia;
#pragma unroll
      for (int q = 0; q < 16; ++q) x += lr[c * 16 + q] * wu[q];
      run += logsig16(x); gv[j] = run; }
    segtot[seg * 64 + dd] = run;
    __syncthreads();
    { float offs = 0.f, tot = 0.f;
#pragma unroll
      for (int q = 0; q < 8; ++q) { const float t_ = segtot[q * 64 + dd]; tot += t_; if (q < seg) offs += t_; }
#pragma unroll
      for (int j = 0; j < 8; ++j) { const int i = seg * 8 + j, c = dir ? 63 - i : i; gc[c * 64 + dd] = gv[j] + offs; }
      if (seg == 0) { dec[dd] = tot; edec[dd] = __expf(tot); } }
    __syncthreads();
    { float kf[8]; unpack8(kreg, kf);
      const float4 g0 = *(const float4*)(gc + ts * 64 + td0), g1 = *(const float4*)(gc + ts * 64 + td0 + 4);
      const float4 t0 = *(const float4*)(dec + td0), t1 = *(const float4*)(dec + td0 + 4);
      const float gg[8] = {g0.x, g0.y, g0.z, g0.w, g1.x, g1.y, g1.z, g1.w}, tt[8] = {t0.x, t0.y, t0.z, t0.w, t1.x, t1.y, t1.z, t1.w};
#pragma unroll
      for (int j = 0; j < 8; ++j) KT[(td0 + j) * 72 + ts] = f2bf(kf[j] * __expf(tt[j] - gg[j])); }
    if (pi + 1 < 68) GS_LOAD(pi + 1);
    __syncthreads();
    { u16* ST = p->SH + ((((size_t)(b * 4 + h) * 2 + dir) * 68 + cid) * 128 + 32 * ni + r32) * 64 + 32 * mi + 4 * hi;
#pragma unroll
      for (int rg = 0; rg < 4; ++rg) *(uint2*)(ST + 8 * rg) = make_uint2(pack2(acc[4 * rg], acc[4 * rg + 1]), pack2(acc[4 * rg + 2], acc[4 * rg + 3]));
#pragma unroll
      for (int r = 0; r < 16; ++r) acc[r] *= edec[32 * mi + crow(r, hi)];
#pragma unroll
      for (int ks = 0; ks < 4; ++ks) {
        const bf16x8 a = *(const bf16x8*)(KT + (32 * mi + r32) * 72 + ks * 16 + hi * 8), bb = *(const bf16x8*)(VT + (32 * ni + r32) * 72 + ks * 16 + hi * 8);
        acc = __builtin_amdgcn_mfma_f32_32x32x16_bf16(a, bb, acc, 0, 0, 0);
      } }
    __syncthreads();
  }
#undef GS_LOAD
#undef GS_BASE
}
__device__ __forceinline__ void gla_out_tile(KParams p, int l, int b, int h, int cid, char* smem) {
  u16* X = (u16*)smem;
  u16* VT = X + 64 * 200;
  char* U = smem + 76800;
  float* Gf = (float*)U; float* Gb = Gf + 4096; float* segtot = Gb + 4096;
  u16* KI = (u16*)(U + 36864);
  float* O = (float*)U;
  float* lr = (float*)(smem + 76800 + 55296);
  const int tid = tidx(), wid = tid >> 6, lane = tid & 63, r32 = lane & 31, hi = lane >> 5;
  const int dd = tid & 63, seg = tid >> 6, ts = tid >> 3, td0 = (tid & 7) * 8;
  u16* Pr = p->P + (size_t)(b * SB + cid * 64) * LDP;
  const uint4 qreg = *(const uint4*)(Pr + (size_t)ts * LDP + C_GQ + h * 64 + td0), kreg = *(const uint4*)(Pr + (size_t)ts * LDP + C_GK + h * 64 + td0);
  const uint4 vreg0 = *(const uint4*)(Pr + (size_t)ts * LDP + C_GV + h * 128 + td0), vreg1 = *(const uint4*)(Pr + (size_t)ts * LDP + C_GV + h * 128 + 64 + td0);
  uint4 lreg = make_uint4(0, 0, 0, 0);
  if (tid < 256) lreg = *(const uint4*)(Pr + (size_t)(tid >> 2) * LDP + C_GWF + (tid & 3) * 8);
  const u16* STf = p->SH + ((((size_t)(b * 4 + h) * 2 + 0) * 68 + cid) * 128) * 64;
  const u16* STb = p->SH + ((((size_t)(b * 4 + h) * 2 + 1) * 68 + cid) * 128) * 64;
  const uint4 sf0 = *(const uint4*)(STf + (size_t)tid * 8), sf1 = *(const uint4*)(STf + (size_t)(tid + 512) * 8);
  const uint4 sb0 = *(const uint4*)(STb + (size_t)tid * 8), sb1 = *(const uint4*)(STb + (size_t)(tid + 512) * 8);
  float wuf[16], wub[16];
  { const float* wf = p->gla_wup_f + l * 4096 + h * 64 + dd; const float* wb = p->gla_wup_b + l * 4096 + h * 64 + dd;
#pragma unroll
    for (int i = 0; i < 16; ++i) { wuf[i] = wf[i * 256]; wub[i] = wb[i * 256]; } }
  const float biaf = p->gla_b_f[l * 256 + h * 64 + dd], biab = p->gla_b_b[l * 256 + h * 64 + dd];
  __syncthreads();
  if (tid < 256) unpack8(lreg, lr + (tid >> 2) * 32 + (tid & 3) * 8);
  { const u16* v0 = (const u16*)&vreg0; const u16* v1 = (const u16*)&vreg1;
#pragma unroll
    for (int j = 0; j < 8; ++j) { VT[(td0 + j) * 200 + ts] = v0[j]; VT[(64 + td0 + j) * 200 + ts] = v1[j]; } }
  *(uint4*)(VT + (tid >> 3) * 200 + 64 + (tid & 7) * 8) = sf0; *(uint4*)(VT + (64 + (tid >> 3)) * 200 + 64 + (tid & 7) * 8) = sf1;
  *(uint4*)(VT + (tid >> 3) * 200 + 128 + (tid & 7) * 8) = sb0; *(uint4*)(VT + (64 + (tid >> 3)) * 200 + 128 + (tid & 7) * 8) = sb1;
  __syncthreads();
  { float gfv[8], gbv[8];
#pragma unroll
    for (int j = 0; j < 8; ++j) { const int c = seg * 8 + j; float xf = biaf, xb = biab;
#pragma unroll
      for (int q = 0; q < 16; ++q) { xf += lr[c * 32 + q] * wuf[q]; xb += lr[c * 32 + 16 + q] * wub[q]; }
      gfv[j] = logsig16(xf); gbv[j] = logsig16(xb); }
#pragma unroll
    for (int j = 1; j < 8; ++j) gfv[j] += gfv[j - 1];
#pragma unroll
    for (int j = 6; j >= 0; --j) gbv[j] += gbv[j + 1];
    segtot[seg * 64 + dd] = gfv[7]; segtot[512 + seg * 64 + dd] = gbv[0];
    __syncthreads();
    float of = 0.f, ob = 0.f;
#pragma unroll
    for (int q = 0; q < 8; ++q) { if (q < seg) of += segtot[q * 64 + dd]; if (q > seg) ob += segtot[512 + q * 64 + dd]; }
#pragma unroll
    for (int j = 0; j < 8; ++j) { Gf[(seg * 8 + j) * 64 + dd] = gfv[j] + of; Gb[(seg * 8 + j) * 64 + dd] = gbv[j] + ob; } }
  __syncthreads();
  { float qf[8], kf[8]; unpack8(qreg, qf); unpack8(kreg, kf);
    const float4 a0 = *(const float4*)(Gf + ts * 64 + td0), a1 = *(const float4*)(Gf + ts * 64 + td0 + 4), c0 = *(const float4*)(Gb + ts * 64 + td0), c1 = *(const float4*)(Gb + ts * 64 + td0 + 4);
    const float gf8[8] = {a0.x, a0.y, a0.z, a0.w, a1.x, a1.y, a1.z, a1.w}, gb8[8] = {c0.x, c0.y, c0.z, c0.w, c1.x, c1.y, c1.z, c1.w};
    unsigned o0[4], o1[4], o2[4], o3[4];
#pragma unroll
    for (int j = 0; j < 8; j += 2) { const float q0 = qf[j] * 0.125f, q1 = qf[j + 1] * 0.125f;
      o0[j >> 1] = pack2(q0 * __expf(gf8[j]), q1 * __expf(gf8[j + 1])); o1[j >> 1] = pack2(q0 * __expf(gb8[j]), q1 * __expf(gb8[j + 1]));
      o2[j >> 1] = pack2(kf[j] * __expf(-gf8[j]), kf[j + 1] * __expf(-gf8[j + 1])); o3[j >> 1] = pack2(kf[j] * __expf(-gb8[j]), kf[j + 1] * __expf(-gb8[j + 1])); }
    *(uint4*)(X + ts * 200 + 64 + td0) = make_uint4(o0[0], o0[1], o0[2], o0[3]); *(uint4*)(X + ts * 200 + 128 + td0) = make_uint4(o1[0], o1[1], o1[2], o1[3]);
    *(uint4*)(KI + ts * 72 + td0) = make_uint4(o2[0], o2[1], o2[2], o2[3]); *(uint4*)(KI + 64 * 72 + ts * 72 + td0) = make_uint4(o3[0], o3[1], o3[2], o3[3]); }
  __syncthreads();
  if (wid < 4) {
    const int mi = wid >> 1, ni = wid & 1;
    f32x16 af, ab;
#pragma unroll
    for (int r = 0; r < 16; ++r) { af[r] = 0.f; ab[r] = 0.f; }
#pragma unroll
    for (int ks = 0; ks < 4; ++ks) {
      const bf16x8 qa = *(const bf16x8*)(X + (32 * mi + r32) * 200 + 64 + ks * 16 + hi * 8), qb = *(const bf16x8*)(X + (32 * mi + r32) * 200 + 128 + ks * 16 + hi * 8);
      const bf16x8 ka = *(const bf16x8*)(KI + (32 * ni + r32) * 72 + ks * 16 + hi * 8), kb = *(const bf16x8*)(KI + 64 * 72 + (32 * ni + r32) * 72 + ks * 16 + hi * 8);
      af = __builtin_amdgcn_mfma_f32_32x32x16_bf16(qa, ka, af, 0, 0, 0);
      ab = __builtin_amdgcn_mfma_f32_32x32x16_bf16(qb, kb, ab, 0, 0, 0);
    }
    const int sidx = 32 * ni + r32;
#pragma unroll
    for (int r = 0; r < 16; ++r) { const int c = 32 * mi + crow(r, hi); X[c * 200 + sidx] = f2bf((sidx <= c ? af[r] : 0.f) + (sidx >= c ? ab[r] : 0.f)); }
  }
  __syncthreads();
  { const int mi = wid >> 2, ni = wid & 3;
    f32x16 acc;
#pragma unroll
    for (int r = 0; r < 16; ++r) acc[r] = 0.f;
#pragma unroll
    for (int ks = 0; ks < 12; ++ks) {
      const bf16x8 a = *(const bf16x8*)(X + (32 * mi + r32) * 200 + ks * 16 + hi * 8), bb = *(const bf16x8*)(VT + (32 * ni + r32) * 200 + ks * 16 + hi * 8);
      acc = __builtin_amdgcn_mfma_f32_32x32x16_bf16(a, bb, acc, 0, 0, 0);
    }
#pragma unroll
    for (int r = 0; r < 16; ++r) O[(32 * mi + crow(r, hi)) * 132 + 32 * ni + r32] = acc[r]; }
  __syncthreads();
  { const int c = tid >> 3, e0 = (tid & 7) * 16;
    float ov[16];
#pragma unroll
    for (int j = 0; j < 16; j += 4) { const float4 t4 = *(const float4*)(O + c * 132 + e0 + j); ov[j] = t4.x; ov[j + 1] = t4.y; ov[j + 2] = t4.z; ov[j + 3] = t4.w; }
    float ss = 0.f;
#pragma unroll
    for (int j = 0; j < 16; ++j) ss += ov[j] * ov[j];
    ss = red8(ss);
    const float rstd = rsqrtf(ss * (1.f / 128.f) + 1e-6f);
    float gt[16];
    unpack8(*(const uint4*)(Pr + (size_t)c * LDP + C_GG + h * 128 + e0), gt); unpack8(*(const uint4*)(Pr + (size_t)c * LDP + C_GG + h * 128 + e0 + 8), gt + 8);
    const float* gn = p->gla_norm + l * 512 + h * 128 + e0;
    unsigned ow[8];
#pragma unroll
    for (int j = 0; j < 16; j += 2) ow[j >> 1] = pack2(ov[j] * rstd * gn[j] * siluf_(gt[j]), ov[j + 1] * rstd * gn[j + 1] * siluf_(gt[j + 1]));
    u16* dst = Pr + (size_t)c * LDP + C_GV + h * 128 + e0;
    *(uint4*)dst = make_uint4(ow[0], ow[1], ow[2], ow[3]); *(uint4*)(dst + 8) = make_uint4(ow[4], ow[5], ow[6], ow[7]); }
}

constexpr int RCH = 32, RNCH = (TC + T) / RCH;
__device__ __forceinline__ float fast_tanh(float x) { const float e = __expf(2.f * x); return 1.f - 2.f * __builtin_amdgcn_rcpf(e + 1.f); }
__device__ __forceinline__ int rwkv_gcol(int gidx, int h, int dir) { return gidx == 0 ? h * 64 : gidx == 1 ? 512 + h * 64 : gidx == 2 ? 1024 + h * 64 : gidx == 3 ? 2048 + dir * 64 : 2176 + dir * 64; }
__device__ __forceinline__ void rwkv_scan_unit(KParams p, int l, int unit, char* smem) {
  const int dir = unit & 1, h = (unit >> 1) & 7, b = unit >> 4;
  const int tid = tidx(), lane = tid & 63;
  const int wid = __builtin_amdgcn_readfirstlane(tid >> 6);
  constexpr int SETF = 6 * 2048 + 64;
  float* setb = (float*)smem;
  float* sY = setb + 2 * SETF;
  u16* tTW = (u16*)(sY + 2048); u16* tAD = tTW + 32 * 72; u16* wupT = tAD + 32 * 72; u16* aupT = wupT + 64 * 72;
  float* smu = (float*)(aupT + 64 * 72);
  float* sZ = smu + 320;
  float* sPK = sZ + 64;
  const float* wup = (dir ? p->rwkv_wup_b : p->rwkv_wup_f) + l * 64 * 512; const float* aup = (dir ? p->rwkv_aup_b : p->rwkv_aup_f) + l * 64 * 512;
  const float* w0 = (dir ? p->rwkv_w0_b : p->rwkv_w0_f) + l * 512 + h * 64; const float* a0 = (dir ? p->rwkv_a0_b : p->rwkv_a0_f) + l * 512 + h * 64;
  const float* kkw = p->rwkv_kk + l * 512 + h * 64; const float* kaw = p->rwkv_ka + l * 512 + h * 64; const float* rkw = p->rwkv_rk + l * 512 + h * 64;
  const u16* Pb = p->P + (size_t)b * SB * LDP + C_RW;
  __syncthreads();
  for (int e = tid; e < 4096; e += 512) { const int n = e & 63, i = e >> 6; wupT[n * 72 + i] = f2bf(wup[i * 512 + h * 64 + n]); aupT[n * 72 + i] = f2bf(aup[i * 512 + h * 64 + n]); }
  if (tid < 320) smu[tid] = p->rwkv_mu[l * 2304 + rwkv_gcol(tid >> 6, h, dir) + (tid & 63)];
  if (tid < 64) { sZ[tid] = 0.f; sPK[tid] = kaw[tid]; sPK[64 + tid] = kkw[tid]; sPK[128 + tid] = rkw[tid]; }
#define RW_T0(c, base, len, t0) do { const int ci_ = (c) < 8 ? (c) : (c) - 8; base = (c) < 8 ? T : 0; len = (c) < 8 ? TC : T; t0 = dir ? base + len - (ci_ + 1) * RCH : base + ci_ * RCH; } while (0)
  __syncthreads();
  if (wid < 4) {
    const int sj = lane & 15, sg_ = lane >> 4;
    f32x4 S[4];
#pragma unroll
    for (int j = 0; j < 4; ++j) S[j] = f32x4{0.f, 0.f, 0.f, 0.f};
    const float* gp = p->g_pre + l * 1024;
    for (int c = -1; c < RNCH; ++c) {
      if (c >= 0) {
        int base, len, t0; RW_T0(c, base, len, t0);
        const size_t row0 = (size_t)b * SB + t0;
        const float* st = setb + (c & 1) * SETF;
        const float* sR = st, *sK = st + 2048, *sV = st + 4096, *sW = st + 6144, *sA = st + 8192, *sKK = st + 10240, *sSC = st + 12288;
        const float* abase = (sg_ == 0) ? sK : (sg_ == 1) ? sA : sZ; const int astr = (sg_ < 2) ? 64 : 0;
        const int hrow = unit * 272 + c * 2 + wid, hs = hrow % SB;
        const bool hdo = (wid < 2) && !(l == 1 && hs >= T);
        float4 hx0, hx1, hx2, hx3, hg0, hg1, hg2, hg3, hc0, hc1, hc2, hc3, hh0, hh1, hh2, hh3;
        if (hdo) { const float* src = xrow_ptr(p, l, hrow); const float* md = p->mod + ((size_t)l * 17 + (hs < T ? hrow / SB : 16)) * 3072;
          hx0 = *(const float4*)(src + lane * 4); hx1 = *(const float4*)(src + 256 + lane * 4); hx2 = *(const float4*)(src + 512 + lane * 4); hx3 = *(const float4*)(src + 768 + lane * 4);
          hg0 = *(const float4*)(gp + lane * 4); hg1 = *(const float4*)(gp + 256 + lane * 4); hg2 = *(const float4*)(gp + 512 + lane * 4); hg3 = *(const float4*)(gp + 768 + lane * 4);
          hc0 = *(const float4*)(md + 1024 + lane * 4); hc1 = *(const float4*)(md + 1280 + lane * 4); hc2 = *(const float4*)(md + 1536 + lane * 4); hc3 = *(const float4*)(md + 1792 + lane * 4);
          hh0 = *(const float4*)(md + lane * 4); hh1 = *(const float4*)(md + 256 + lane * 4); hh2 = *(const float4*)(md + 512 + lane * 4); hh3 = *(const float4*)(md + 768 + lane * 4); }
#define RW_LDV(tl_, K, W, Rr, A4, VV, SC) do { const int o_ = (tl_) * 64 + 4 * sg_; \
          _Pragma("unroll") for (int kt = 0; kt < 4; ++kt) { K[kt] = *(const f32x4*)(sKK + o_ + 16 * kt); W[kt] = *(const f32x4*)(sW + o_ + 16 * kt); Rr[kt] = *(const f32x4*)(sR + o_ + 16 * kt); \
 } \
          { const f32x4 a4_ = *(const f32x4*)(abase + (tl_) * astr + 4 * sj); A4[0] = a4_[0]; A4[1] = a4_[1]; A4[2] = a4_[2]; A4[3] = a4_[3]; } \
          VV = sV[(tl_) * 64 + 16 * wid + sj]; SC = *(const f32x2*)(sSC + (tl_) * 2); } while (0)
#define RW_STEP(tlc_, K, W, Rr, A4, VV, SC) do { \
          f32x4 ps = S[0] * K[0] + S[1] * K[1] + S[2] * K[2] + S[3] * K[3]; \
          f32x4 py = S[0] * Rr[0] + S[1] * Rr[1] + S[2] * Rr[2] + S[3] * Rr[3]; \
          float sa_ = (ps[0] + ps[1]) + (ps[2] + ps[3]), yp_ = (py[0] + py[1]) + (py[2] + py[3]); \
            \
          { auto r1 = __builtin_amdgcn_permlane16_swap(__float_as_uint(sa_), __float_as_uint(yp_), false, false); float c_ = __uint_as_float(r1[0]) + __uint_as_float(r1[1]); \
            auto r2 = __builtin_amdgcn_permlane32_swap(__float_as_uint(c_), __float_as_uint(c_), false, false); c_ = __uint_as_float(r2[0]) + __uint_as_float(r2[1]); \
            auto r3 = __builtin_amdgcn_permlane16_swap(__float_as_uint(c_), __float_as_uint(c_), false, false); sa_ = __uint_as_float(r3[0]); yp_ = __uint_as_float(r3[1]); } \
          if (sg_ == 0) sY[(tlc_) * 64 + 16 * wid + sj] = yp_ + VV * SC.x - sa_ * SC.y; \
          const float bop_ = (sg_ == 0) ? VV : sa_; \
          _Pragma("unroll") for (int kt = 0; kt < 4; ++kt) S[kt] = __builtin_amdgcn_mfma_f32_16x16x4f32(A4[kt], bop_, S[kt] * W[kt], 0, 0, 0); } while (0)
        f32x4 pK[4], pW[4], pR[4], qK[4], qW[4], qR[4]; float pA[4], qA[4], pvv, qvv; f32x2 psc, qsc;
        RW_LDV((dir ? RCH - 1 : 0), pK, pW, pR, pA, pvv, psc);
        for (int i = 0; i < RCH; i += 2) {
          const int ta = dir ? RCH - 1 - i : i, tb = dir ? RCH - 2 - i : i + 1;
          RW_LDV(tb, qK, qW, qR, qA, qvv, qsc);
          RW_STEP(ta, pK, pW, pR, pA, pvv, psc);
          if (i + 2 < RCH) { const int tn = dir ? RCH - 3 - i : i + 2; RW_LDV(tn, pK, pW, pR, pA, pvv, psc); }
          RW_STEP(tb, qK, qW, qR, qA, qvv, qsc);
          if (i == 14 || i == 20 || i == 28) __syncthreads();
        }
#undef RW_STEP
#undef RW_LDV
        { const int tl = lane >> 1, hf = lane & 1; const float* yp = sY + tl * 64 + 16 * wid + hf * 8;
          const float4 y0 = *(const float4*)yp, y1 = *(const float4*)(yp + 4);
          *(uint4*)(p->SH + (row0 + tl) * 1024 + dir * 512 + h * 64 + 16 * wid + hf * 8) = make_uint4(pack2(y0.x, y0.y), pack2(y0.z, y0.w), pack2(y1.x, y1.y), pack2(y1.z, y1.w)); }
        if (hdo) {
          float ss = hx0.x * hx0.x + hx0.y * hx0.y + hx0.z * hx0.z + hx0.w * hx0.w + hx1.x * hx1.x + hx1.y * hx1.y + hx1.z * hx1.z + hx1.w * hx1.w
                   + hx2.x * hx2.x + hx2.y * hx2.y + hx2.z * hx2.z + hx2.w * hx2.w + hx3.x * hx3.x + hx3.y * hx3.y + hx3.z * hx3.z + hx3.w * hx3.w;
          ss = wave_sum(ss);
          const float rstd = rsqrtf(ss * (1.f / 1024.f) + 1e-6f);
          u16* dst = p->P + (size_t)hrow * LDP + C_HRE + lane * 4;
#define HW(v, g_, c_, s_, off) *(uint2*)(dst + (off)) = make_uint2(pack2(v.x * rstd * g_.x * (1.f + c_.x) + s_.x, v.y * rstd * g_.y * (1.f + c_.y) + s_.y), pack2(v.z * rstd * g_.z * (1.f + c_.z) + s_.z, v.w * rstd * g_.w * (1.f + c_.w) + s_.w))
          HW(hx0, hg0, hc0, hh0, 0); HW(hx1, hg1, hc1, hh1, 256); HW(hx2, hg2, hc2, hh2, 512); HW(hx3, hg3, hc3, hh3, 768);
#undef HW
        }
      } else { __syncthreads(); __syncthreads(); __syncthreads(); }
      __syncthreads();
    }
  } else {
    const int ptid = tid - 256, pw = wid - 4;
    const float w0n_ = w0[(pw & 1) * 32 + (lane & 31)], a0n_ = a0[(pw & 1) * 32 + (lane & 31)];
    uint4 rg[5][3];
#define RW_LOAD(c) do { int base_, len_, t0_; RW_T0(c, base_, len_, t0_); \
      _Pragma("unroll") for (int it = 0; it < 5; ++it) { const int e = ptid + it * 256; \
        { const int tl = e / 40, v = e % 40; const int t = t0_ + tl; const u16* src = Pb + (size_t)t * LDP + rwkv_gcol(v >> 3, h, dir) + (v & 7) * 8; \
          rg[it][1] = *(const uint4*)src; \
          rg[it][0] = (t > base_) ? *(const uint4*)(src - LDP) : make_uint4(0, 0, 0, 0); \
          rg[it][2] = (t + 1 < base_ + len_) ? *(const uint4*)(src + LDP) : make_uint4(0, 0, 0, 0); } } } while (0)
    RW_LOAD(0);
    for (int c = -1; c < RNCH; ++c) {
      const int cn = c + 1;
      if (cn < RNCH) {
        int base, len, t0; RW_T0(cn, base, len, t0);
        const size_t row0 = (size_t)b * SB + t0;
        float* st = setb + (cn & 1) * SETF;
        float* sR = st, *sK = st + 2048, *sV = st + 4096, *sW = st + 6144, *sA = st + 8192, *sKK = st + 10240, *sSC = st + 12288;
#pragma unroll
        for (int it = 0; it < 5; ++it) { const int e = ptid + it * 256;
          { const int tl = e / 40, v = e % 40, gidx = v >> 3, n0 = (v & 7) * 8;
            float cc[8], ll[8], nn[8], val[8];
            unpack8(rg[it][1], cc); unpack8(rg[it][0], ll); unpack8(rg[it][2], nn);
            const float4 m0 = *(const float4*)(smu + gidx * 64 + n0), m1 = *(const float4*)(smu + gidx * 64 + n0 + 4);
            const float mm[8] = {m0.x, m0.y, m0.z, m0.w, m1.x, m1.y, m1.z, m1.w};
#pragma unroll
            for (int j = 0; j < 8; ++j) val[j] = cc[j] + mm[j] * (0.5f * (ll[j] + nn[j]) - cc[j]);
            if (gidx < 3) { float* dst = (gidx == 0 ? sR : gidx == 1 ? sK : sV) + tl * 64 + n0;
              *(float4*)dst = make_float4(val[0], val[1], val[2], val[3]); *(float4*)(dst + 4) = make_float4(val[4], val[5], val[6], val[7]); }
            else { if (gidx == 3) {
#pragma unroll
                for (int j = 0; j < 8; ++j) val[j] = fast_tanh(val[j]); }
              *(uint4*)((gidx == 3 ? tTW : tAD) + tl * 72 + n0) = make_uint4(pack2(val[0], val[1]), pack2(val[2], val[3]), pack2(val[4], val[5]), pack2(val[6], val[7])); } } }
        if (cn + 1 < RNCH) RW_LOAD(cn + 1);
        __syncthreads();
        { const int gsel = pw >> 1, ni = pw & 1, r32 = lane & 31, hi = lane >> 5;
          const u16* At = gsel ? tAD : tTW; const u16* Bt = gsel ? aupT : wupT;
          f32x16 acc;
#pragma unroll
          for (int r = 0; r < 16; ++r) acc[r] = 0.f;
#pragma unroll
          for (int ks = 0; ks < 4; ++ks) {
            const bf16x8 a = *(const bf16x8*)(At + r32 * 72 + ks * 16 + hi * 8), bb = *(const bf16x8*)(Bt + (ni * 32 + r32) * 72 + ks * 16 + hi * 8);
            acc = __builtin_amdgcn_mfma_f32_32x32x16_bf16(a, bb, acc, 0, 0, 0);
          }
          const int n = ni * 32 + r32;
          if (gsel == 0) {
#pragma unroll
            for (int r = 0; r < 16; ++r) sW[crow(r, hi) * 64 + n] = __expf(-0.6065306597f * sigmoidf_(w0n_ + acc[r])); }
          else {
#pragma unroll
            for (int r = 0; r < 16; ++r) sA[crow(r, hi) * 64 + n] = sigmoidf_(a0n_ + acc[r]); } }
        __syncthreads();
#pragma unroll 1
        for (int pass = 0; pass < 2; ++pass) { const int tl = (ptid >> 4) + 16 * pass, n0 = (ptid & 15) * 4;
          const float4 k4 = *(const float4*)(sK + tl * 64 + n0), a4 = *(const float4*)(sA + tl * 64 + n0), r4 = *(const float4*)(sR + tl * 64 + n0), w4 = *(const float4*)(sW + tl * 64 + n0);
          const float4 ka4 = *(const float4*)(sPK + n0), kw4 = *(const float4*)(sPK + 64 + n0), rk4 = *(const float4*)(sPK + 128 + n0);
          const float kk_[4] = {k4.x * kw4.x, k4.y * kw4.y, k4.z * kw4.z, k4.w * kw4.w};
          const float kd[4] = {k4.x * (1.f + (a4.x - 1.f) * ka4.x), k4.y * (1.f + (a4.y - 1.f) * ka4.y), k4.z * (1.f + (a4.z - 1.f) * ka4.z), k4.w * (1.f + (a4.w - 1.f) * ka4.w)};
          const float ss = red16(kk_[0] * kk_[0] + kk_[1] * kk_[1] + kk_[2] * kk_[2] + kk_[3] * kk_[3]);
          const float bs = red16(r4.x * kd[0] * rk4.x + r4.y * kd[1] * rk4.y + r4.z * kd[2] * rk4.z + r4.w * kd[3] * rk4.w);
          const float rn = rsqrtf(ss + 1e-12f);
          const float bq[4] = {kk_[0] * rn * a4.x, kk_[1] * rn * a4.y, kk_[2] * rn * a4.z, kk_[3] * rn * a4.w};
          const float kdr = red16(kd[0] * r4.x + kd[1] * r4.y + kd[2] * r4.z + kd[3] * r4.w);
          const float br = red16(bq[0] * r4.x + bq[1] * r4.y + bq[2] * r4.z + bq[3] * r4.w);
          { const int q_ = ptid & 15; float* tk = sK + tl * 64 + (q_ & 3) * 16 + (q_ >> 2); float* ta = sA + tl * 64 + (q_ & 3) * 16 + (q_ >> 2);
            tk[0] = kd[0]; tk[4] = kd[1]; tk[8] = kd[2]; tk[12] = kd[3]; ta[0] = -bq[0]; ta[4] = -bq[1]; ta[8] = -bq[2]; ta[12] = -bq[3]; }
          *(float4*)(sKK + tl * 64 + n0) = make_float4(kk_[0] * rn, kk_[1] * rn, kk_[2] * rn, kk_[3] * rn);
          *(float4*)(sR + tl * 64 + n0) = make_float4(r4.x * w4.x, r4.y * w4.y, r4.z * w4.z, r4.w * w4.w);
          if ((ptid & 15) == 0) { p->bon[((size_t)dir * R + row0 + tl) * 8 + h] = bs; *(float2*)(sSC + tl * 2) = make_float2(kdr, br); } }
        __syncthreads();
      } else { __syncthreads(); __syncthreads(); __syncthreads(); }
      __syncthreads();
    }
#undef RW_LOAD
  }
#undef RW_T0
}

__device__ __forceinline__ void phase_f0(KParams p, int l) {
  const int tid = tidx(), wid = tid >> 6, lane = tid & 63;
  const float* mu = p->rwkv_mu + l * 2304; const float* lng = p->rwkv_ln_g + l * 512; const float* lnb = p->rwkv_ln_b + l * 512;
  for (int it = blockIdx.x * 8 + wid; it < R * 2; it += gridDim.x * 8) {
    const int r = it >> 1, j = (it & 1) * 256 + lane * 4, s = r % SB;
    if (l == 1 && s >= T) continue;
    const bool first = (s == 0) || (s == T), last = (s == T - 1) || (s == SB - 1);
    const u16* p0 = p->P + (size_t)r * LDP + C_RW;
    u16* yrow = p->SH + (size_t)r * 1024;
    const uint2 yf = *(const uint2*)(yrow + j), yb = *(const uint2*)(yrow + 512 + j);
    const uint2 vc = *(const uint2*)(p0 + 1024 + j), gcn = *(const uint2*)(p0 + 1536 + j);
    uint2 vl = make_uint2(0, 0), vn = make_uint2(0, 0), gl = make_uint2(0, 0), gn = make_uint2(0, 0);
    if (!first) { vl = *(const uint2*)(p0 + 1024 + j - LDP); gl = *(const uint2*)(p0 + 1536 + j - LDP); }
    if (!last) { vn = *(const uint2*)(p0 + 1024 + j + LDP); gn = *(const uint2*)(p0 + 1536 + j + LDP); }
    const float4 muv = *(const float4*)(mu + 1024 + j), mug = *(const float4*)(mu + 1536 + j), lg = *(const float4*)(lng + j), lb = *(const float4*)(lnb + j);
    const int head = j >> 6;
    const float bonus = p->bon[(size_t)r * 8 + head] + p->bon[((size_t)R + r) * 8 + head];
#define U2F(u, i) ((i) == 0 ? __uint_as_float((u).x << 16) : (i) == 1 ? __uint_as_float((u).x & 0xffff0000u) : (i) == 2 ? __uint_as_float((u).y << 16) : __uint_as_float((u).y & 0xffff0000u))
    float y[4], vv[4], gg[4];
    const float mv[4] = {muv.x, muv.y, muv.z, muv.w}, mg[4] = {mug.x, mug.y, mug.z, mug.w};
#pragma unroll
    for (int i = 0; i < 4; ++i) { y[i] = U2F(yf, i) + U2F(yb, i);
      const float c1 = U2F(vc, i); vv[i] = c1 + mv[i] * (0.5f * (U2F(vl, i) + U2F(vn, i)) - c1);
      const float c2 = U2F(gcn, i); gg[i] = c2 + mg[i] * (0.5f * (U2F(gl, i) + U2F(gn, i)) - c2); }
#undef U2F
    const float mean = red16(y[0] + y[1] + y[2] + y[3]) * (1.f / 64.f);
    const float d0 = y[0] - mean, d1 = y[1] - mean, d2 = y[2] - mean, d3 = y[3] - mean;
    const float rs = rsqrtf(red16(d0 * d0 + d1 * d1 + d2 * d2 + d3 * d3) * (1.f / 64.f) + 64e-5f);
    const float o0 = (d0 * rs * lg.x + lb.x + bonus * vv[0]) * siluf_(gg[0]), o1 = (d1 * rs * lg.y + lb.y + bonus * vv[1]) * siluf_(gg[1]);
    const float o2 = (d2 * rs * lg.z + lb.z + bonus * vv[2]) * siluf_(gg[2]), o3 = (d3 * rs * lg.w + lb.w + bonus * vv[3]) * siluf_(gg[3]);
    *(uint2*)(yrow + j) = make_uint2(pack2(o0, o1), pack2(o2, o3));
  }
}

__device__ __forceinline__ int rowtile_row0(int l, int i) { return l == 0 ? i * 256 : ((i >> 4) * 17 + (i & 15)) * 256; }
__device__ __forceinline__ int n_rowtiles(int l) { return l == 0 ? R / 256 : NB * 16; }

__device__ __forceinline__ void phase_f1(KParams p, int l, char* smem) {
  const u16* Wg = p->Wt_in + (size_t)l * DINP * 1024 + (size_t)C_MG * 1024;
  const u16* Wo = p->Wt_o + (size_t)l * 3 * 1024 * 512;
  int rti, nt;
  for (int it = 0; xcd_tile(it, n_rowtiles(l), 16, rti, nt); ++it) {
    const int row0 = rowtile_row0(l, rti);
    unsigned sg[3][2][8];
    {
      f32x16 accg[3][2];
      gemm_kloop64<3>(p->P + (size_t)row0 * LDP + C_HRE, LDP, Wg + (size_t)(nt * 64) * 1024, 1024, (size_t)1024 * 1024, 1024, smem, accg);
#pragma unroll
      for (int i = 0; i < 3; ++i)
#pragma unroll
        for (int mi = 0; mi < 2; ++mi)
#pragma unroll
          for (int r = 0; r < 16; r += 2) sg[i][mi][r >> 1] = pack2(sigmoidf_(accg[i][mi][r]), sigmoidf_(accg[i][mi][r + 1]));
    }
    f32x16 accm[2];
#pragma unroll
    for (int mi = 0; mi < 2; ++mi)
#pragma unroll
      for (int r = 0; r < 16; ++r) accm[mi][r] = 0.f;
#pragma unroll
    for (int i = 0; i < 3; ++i) {
      f32x16 acc[1][2];
      const u16* Ai = (i == 0) ? p->P + (size_t)row0 * LDP + C_GV : (i == 1) ? p->P + (size_t)row0 * LDP + C_AQ : p->SH + (size_t)row0 * 1024;
      gemm_kloop64<1>(Ai, (i == 2) ? 1024 : LDP, Wo + (size_t)(i * 1024 + nt * 64) * 512, 512, 0, 512, smem, acc);
#pragma unroll
      for (int mi = 0; mi < 2; ++mi)
#pragma unroll
        for (int r = 0; r < 16; r += 2) { const unsigned w = sg[i][mi][r >> 1];
          accm[mi][r] += __uint_as_float(w << 16) * acc[0][mi][r]; accm[mi][r + 1] += __uint_as_float(w & 0xffff0000u) * acc[0][mi][r + 1]; }
    }
    { const int tid = tidx(), wid = tid >> 6, lane = tid & 63, r32 = lane & 31, hi = lane >> 5, wm = wid >> 1, wn = wid & 1;
      u16* C = p->P + (size_t)row0 * LDP + C_M + nt * 64 + wn * 32 + r32;
#pragma unroll
      for (int mi = 0; mi < 2; ++mi)
#pragma unroll
        for (int r = 0; r < 16; ++r) C[(size_t)(wm * 64 + mi * 32 + crow(r, hi)) * LDP] = f2bf(accm[mi][r]); }
  }
}
__device__ __forceinline__ void phase_f2(KParams p, int l, char* smem) {
  const u16* W = p->Wt_out + (size_t)l * 1024 * 1024;
  int rti, nt;
  for (int it = 0; xcd_tile(it, n_rowtiles(l), 8, rti, nt); ++it) {
    const int row0 = rowtile_row0(l, rti);
    f32x16 acc[2][2];
    gemm_kloop(p->P + (size_t)row0 * LDP + C_M, LDP, W + (size_t)nt * 128 * 1024, 1024, 1024, smem, acc);
    store_tile_bf16(acc, p->SH + (size_t)row0 * 1024 + nt * 128, 1024, 128);
  }
}
__device__ __forceinline__ void phase_f3(KParams p, int l) {
  const int wid = tidx() >> 6, lane = tidx() & 63;
  const float* g_post = p->g_post + l * 1024; const float* modl = p->mod + (size_t)l * 17 * 3072;
  for (int r = blockIdx.x * 8 + wid; r < R; r += gridDim.x * 8) {
    const int b = r / SB, s = r % SB;
    if (l == 1 && s >= T) continue;
    const float* src = xrow_ptr(p, l, r);
    float* dst = (s < T) ? p->out + ((size_t)b * T + s) * DM : p->xc1 + ((size_t)b * TC + (s - T)) * DM;
    const float* gate = modl + (size_t)((s < T) ? b : 16) * 3072 + 2048;
    u16* zrow = p->SH + (size_t)r * 1024;
    float z[4][4]; float ss = 0.f;
#pragma unroll
    for (int i = 0; i < 4; ++i) { const ushort4 u = *(const ushort4*)(zrow + i * 256 + lane * 4); z[i][0] = bf2f(u.x); z[i][1] = bf2f(u.y); z[i][2] = bf2f(u.z); z[i][3] = bf2f(u.w);
      ss += z[i][0] * z[i][0] + z[i][1] * z[i][1] + z[i][2] * z[i][2] + z[i][3] * z[i][3]; }
    ss = wave_sum(ss);
    const float rstd = rsqrtf(ss * (1.f / 1024.f) + 1e-6f);
    float4 o[4];
#pragma unroll
    for (int i = 0; i < 4; ++i) {
      const int col = i * 256 + lane * 4;
      const float4 g = *(const float4*)(g_post + col), gt = *(const float4*)(gate + col), xv = *(const float4*)(src + col);
      o[i].x = xv.x + gt.x * (z[i][0] * rstd * g.x); o[i].y = xv.y + gt.y * (z[i][1] * rstd * g.y);
      o[i].z = xv.z + gt.z * (z[i][2] * rstd * g.z); o[i].w = xv.w + gt.w * (z[i][3] * rstd * g.w);
      *(float4*)(dst + col) = o[i];
    }
    if (l == 0) hrow_write(o, p->g_pre + 1024, p->mod + (size_t)17 * 3072 + (size_t)((s < T) ? b : 16) * 3072, zrow, lane);
  }
}


#define XB_TMO      128
#define XB_XCNT(j)  (256  + 64 * (j))
#define XB_XSUB(j)  (1280 + 64 * (j))
#define XB_XGEN(j)  (2304 + 64 * (j))
#define XB_TOP      3328
#define XB_TOPGEN   3392
#define XCD_BAR_WORDS 3456
#define XB_SPIN_CAP (1u << 18)
#define LAS __attribute__((address_space(3)))
__device__ __forceinline__ unsigned xb_ld(unsigned* p)              { return __hip_atomic_load(p, __ATOMIC_RELAXED, __HIP_MEMORY_SCOPE_AGENT); }
__device__ __forceinline__ unsigned xb_add(unsigned* p, unsigned v) { return __hip_atomic_fetch_add(p, v, __ATOMIC_RELAXED, __HIP_MEMORY_SCOPE_AGENT); }
__device__ __forceinline__ unsigned xb_xcc_id() { return (unsigned)__builtin_amdgcn_s_getreg((3 << 11) | 20) & 0xFu; }
#define XB_SPIN(cond, bar) do { unsigned _sp = 0; while (cond) { __builtin_amdgcn_s_sleep(1); \
    if ((++_sp & 255u) == 0u) { if (xb_ld(&(bar)[XB_TMO])) break; if (_sp > XB_SPIN_CAP) { atomicAdd(&(bar)[XB_TMO], 1u); break; } } } } while (0)
__device__ __forceinline__ void xcd_barrier_complete(unsigned* bar, unsigned x, unsigned& nloc, unsigned& nx) {
    const unsigned G = gridDim.x * gridDim.y * gridDim.z;
    unsigned sum, cnt, mine, sp = 0u;
    for (;;) {
        sum = 0u; cnt = 0u; mine = 0u;
#pragma unroll
        for (unsigned j = 0; j < 16; ++j) { const unsigned c = xb_ld(&bar[XB_XCNT(j)]); sum += c; cnt += (c > 0u) ? 1u : 0u; mine = (j == x) ? c : mine; }
        if (sum == G) break;
        __builtin_amdgcn_s_sleep(1);
        if ((++sp & 255u) == 0u) { if (xb_ld(&bar[XB_TMO])) break; if (sp > XB_SPIN_CAP) { atomicAdd(&bar[XB_TMO], 1u); break; } }
    }
    nloc = mine > 0u ? mine : 1u; nx = cnt > 0u ? cnt : 1u;
}
__device__ __forceinline__ void xcd_barrier(unsigned* bar, unsigned x, volatile LAS unsigned* st) {
    asm volatile("s_waitcnt vmcnt(0)" ::: "memory");
    __syncthreads();
    if (threadIdx.x == 0) {
        __builtin_amdgcn_s_waitcnt(0);
        unsigned nloc = st[0], nx = st[1];
        if (nloc == 0u) { xcd_barrier_complete(bar, x, nloc, nx); st[0] = nloc; st[1] = nx; }
        const unsigned old = xb_add(&bar[XB_XSUB(x)], 1u);
        const unsigned gen = old / nloc;
        if (old + 1u == (gen + 1u) * nloc) {
            __builtin_amdgcn_fence(__ATOMIC_RELEASE, "agent");
            asm volatile("s_waitcnt vmcnt(0)" ::: "memory");
            const unsigned og = xb_add(&bar[XB_TOP], 1u);
            const unsigned tg = og / nx;
            if (og + 1u == (tg + 1u) * nx) xb_add(&bar[XB_TOPGEN], 1u);
            else XB_SPIN(xb_ld(&bar[XB_TOPGEN]) == tg, bar);
            __builtin_amdgcn_fence(__ATOMIC_ACQUIRE, "agent");
            xb_add(&bar[XB_XGEN(x)], 1u);
            asm volatile("s_waitcnt vmcnt(0)" ::: "memory");
        } else {
            XB_SPIN(xb_ld(&bar[XB_XGEN(x)]) == gen, bar);
            __builtin_amdgcn_fence(__ATOMIC_ACQUIRE, "agent");
            asm volatile("s_waitcnt vmcnt(0)" ::: "memory");
        }
    }
    __syncthreads();
}

constexpr int N_PHASES = 18;
#define LOADP() KParams p = kp; asm volatile("" : "+s"(p))
__global__ __launch_bounds__(512, 1) void megakernel(Params praw) {
  extern __shared__ __attribute__((aligned(16))) char smem[];
  __shared__ __attribute__((aligned(16))) unsigned xb_words[4];
  const KParams kp = (KParams)__builtin_amdgcn_kernarg_segment_ptr();
  const int ph0 = praw.p0, ph1 = praw.p1;
  unsigned* const bar = praw.bar;
  const unsigned xcc = xb_xcc_id();
  if (threadIdx.x < 4) xb_words[threadIdx.x] = 0u;
  __syncthreads();
  if (threadIdx.x == 0) (void)xb_add(&bar[XB_XCNT(xcc)], 1u);
  for (int ph = ph0; ph < ph1; ++ph) {
    const int l = (ph - 2) >> 3, sub = (ph - 2) & 7;
    if (ph == 0) { LOADP(); phase_prologue(p, smem); }
    else if (ph == 1) { LOADP(); phase_a0(p); }
    else if (sub == 0) { LOADP(); phase_a1(p, l, smem); }
    else if (sub == 1 || sub == 2) {
      const int natt = 1024 + (l == 0 ? 64 : 0), nch = (l == 0 ? 68 : 64), G = gridDim.x, half = G >> 1;
      int it0 = 0, it_end = 0, stride = 1;
      if (sub == 1) {
        { LOADP(); attn_prep_all(p, l); }
        xcd_barrier(bar, xcc, (volatile LAS unsigned*)xb_words);
        if ((int)blockIdx.x < half) { LOADP(); for (int u = blockIdx.x; u < 128; u += half) gla_state_unit(p, l, u, smem); }
        else { it0 = blockIdx.x - half; it_end = 256; stride = G - half; }
      } else { it0 = 256 + blockIdx.x; it_end = natt; stride = G; }
      for (int it = it0; it < it_end; it += stride) {
        int b, h, qrow0, krow0, seq;
        if (it < 1024) { b = it >> 6; h = (it >> 4) & 3; qrow0 = (it & 15) * 256; krow0 = 0; seq = SB; }
        else { const int u = it - 1024; b = u >> 2; h = u & 3; qrow0 = T; krow0 = T; seq = TC; }
        const int kvh = h >> 1;
        KParams q_ = kp; asm volatile("" : "+s"(q_)); u16* Pbase = q_->P;
        u16* Pq = Pbase + (size_t)(b * SB + qrow0) * LDP; const u16* Pk = Pbase + (size_t)(b * SB + krow0) * LDP;
        att::attn_dense_body((const bf16*)(Pq + C_AQ + h * 128), (const bf16*)(Pk + C_AK + kvh * 128), (const bf16*)(Pk + C_AV + kvh * 128),
                             Pq + C_AG + h * 128, Pq + C_AQ + h * 128, seq, smem);
      }
      if (sub == 2) { LOADP();
        const int first = 0;
        const int gb = ((int)blockIdx.x >= first) ? (int)blockIdx.x - first : -1, gstride = G - first;
        if (gb >= 0) for (int g = gb; g < NB * 4 * nch; g += gstride) gla_out_tile(p, l, g / (nch * 4), (g / nch) & 3, g % nch, smem);
      }
    } else if (sub == 3) { LOADP(); for (int u = blockIdx.x; u < 256; u += gridDim.x) rwkv_scan_unit(p, l, u, smem); }
    else if (sub == 4) { LOADP(); phase_f0(p, l); }
    else if (sub == 5) { LOADP(); phase_f1(p, l, smem); }
    else if (sub == 6) { LOADP(); phase_f2(p, l, smem); }
    else { LOADP(); phase_f3(p, l); }
    if (ph + 1 < ph1) { if (ph == 0) cg::this_grid().sync(); else xcd_barrier(bar, xcc, (volatile LAS unsigned*)xb_words); }
  }
}

#ifndef MK_LAUNCHES
#define MK_LAUNCHES 1
#endif
static inline size_t al256(size_t x) { return (x + 255) / 256 * 256; }
extern "C" void kernel_launch(void* const* d_in, const int* in_sizes, int n_in, void* d_out, int out_size, void* d_ws, size_t ws_size, hipStream_t stream) {
  Params p{};
  const float** pf = (const float**)&p;
  for (int i = 0; i < 34; ++i) pf[i] = (const float*)d_in[i];
  p.out = (float*)d_out;
  char* ws = (char*)d_ws; size_t off = 0;
  auto take = [&](size_t bytes) { char* q = ws + off; off += al256(bytes); return q; };
  p.Wt_in = (u16*)take((size_t)2 * DINP * 1024 * 2);
  p.Wt_o = (u16*)take((size_t)2 * 3 * 1024 * 512 * 2);
  p.Wt_out = (u16*)take((size_t)2 * 1024 * 1024 * 2);
  p.mod = (float*)take((size_t)2 * 17 * 3072 * 4);
  p.bon = (float*)take((size_t)2 * R * 8 * 4);
  p.xc1 = (float*)take((size_t)NB * TC * DM * 4);
  p.SH = (u16*)take((size_t)R * 1024 * 2);
  p.P = (u16*)take((size_t)R * LDP * 2);
  p.tmp = (unsigned*)take((size_t)512 * 32 * 512 * 4);
  p.bar = (unsigned*)take((size_t)XCD_BAR_WORDS * 4);
  if (off > ws_size) { fprintf(stderr, "kernel_launch: workspace too small (%zu > %zu)\n", off, ws_size); return; }

  static int grid_blocks = 0;
  if (!grid_blocks) {
    if (hipFuncSetAttribute((const void*)megakernel, hipFuncAttributeMaxDynamicSharedMemorySize, SMEM_BYTES) != hipSuccess) { fprintf(stderr, "kernel_launch: LDS attribute failed\n"); return; }
    int dev = 0, cus = 0, per_cu = 0;
    (void)hipGetDevice(&dev);
    (void)hipDeviceGetAttribute(&cus, hipDeviceAttributeMultiprocessorCount, dev);
    (void)hipOccupancyMaxActiveBlocksPerMultiprocessor(&per_cu, megakernel, 512, SMEM_BYTES);
    if (per_cu < 1) { fprintf(stderr, "kernel_launch: occupancy query returned %d\n", per_cu); return; }
    grid_blocks = (cus * (per_cu > 1 ? 1 : per_cu)) / 8 * 8;
  }
#if MK_LAUNCHES == 1
  (void)hipMemsetAsync(p.bar, 0, (size_t)XCD_BAR_WORDS * 4, stream);
  p.p0 = 0; p.p1 = N_PHASES;
  void* args[] = {&p};
  hipError_t e = hipLaunchCooperativeKernel((void*)megakernel, dim3(grid_blocks), dim3(512), args, SMEM_BYTES, stream);
  if (e != hipSuccess) fprintf(stderr, "cooperative launch failed: %s (grid %d)\n", hipGetErrorString(e), grid_blocks);
#else
  for (int ph = 0; ph < N_PHASES; ++ph) { p.p0 = ph; p.p1 = ph + 1; hipLaunchKernelGGL(megakernel, dim3(grid_blocks), dim3(512), SMEM_BYTES, stream, p); }
#endif
}
```
